# Optimizing an MI355X kernel written in HIP

```python
import jax, jax.numpy as jnp
from jax import lax
import numpy as np

D_MODEL = 2048
BATCH = 4
SEQ = 8192
DEPTH = 4

F32 = jnp.float32
NORM_EPS = 1e-6
HALF = D_MODEL // 2
DN_DK = 128
DN_DV = 128
DN_HEADS = HALF // DN_DV
DN_QK = DN_HEADS * DN_DK
DN_V = DN_HEADS * DN_DV
DN_CONV = 4
DN_CHUNK = 64
LRU_WIDTH = HALF
LRU_BLOCKS = 8
LRU_BLK = LRU_WIDTH // LRU_BLOCKS
LRU_CONV = 4
LRU_C = 8.0
SWA_DIM = 128
SWA_HEADS = HALF // SWA_DIM
SWA_W = SWA_HEADS * SWA_DIM
SWA_BRANCHES = ((128, 1), (512, 4), (2048, 16))
SWA_BLOCK = 128
RET_DK = 128
RET_DV = 256
RET_HEADS = HALF // RET_DV
RET_QK = RET_HEADS * RET_DK
RET_V = RET_HEADS * RET_DV
RET_CHUNK = 64
GN_EPS = 1e-5
D_FF = 4 * D_MODEL
PLE_DIM = 256
N_EVEN = (DEPTH + 1) // 2
N_ODD = DEPTH // 2
EV_SPLITS = (2 * DN_QK + DN_V, DN_V, DN_HEADS, DN_HEADS, LRU_WIDTH, LRU_WIDTH)
EV_IN = sum(EV_SPLITS)
EV_OUT = DN_V + LRU_WIDTH
OD_SPLITS = (SWA_W, SWA_W, SWA_W, RET_QK, RET_QK, RET_V, RET_V)
OD_IN = sum(OD_SPLITS)
OD_OUT = SWA_W + RET_V

kernel_name = "hybrid_deltanet_rglru_dilated_retention_trunk"


def rms_norm(x, w, eps=NORM_EPS):
    xf = x.astype(F32)
    y = xf * lax.rsqrt(jnp.mean(xf * xf, axis=-1, keepdims=True) + eps)
    return (y * w.astype(F32)).astype(x.dtype)


def l2_normalize(x, eps=1e-6):
    return x * lax.rsqrt(jnp.sum(x * x, axis=-1, keepdims=True) + eps)


def head_group_norm(x, eps=GN_EPS):
    mu = jnp.mean(x, axis=-1, keepdims=True)
    xc = x - mu
    return xc * lax.rsqrt(jnp.mean(xc * xc, axis=-1, keepdims=True) + eps)


def split_cols(x, sizes):
    return jnp.split(x, np.cumsum(sizes)[:-1].tolist(), axis=-1)


def to_heads(x, n_heads):
    b, t, _ = x.shape
    return x.reshape(b, t, n_heads, -1).transpose(0, 2, 1, 3)


def merge_heads(x):
    b, h, t, d = x.shape
    return x.transpose(0, 2, 1, 3).reshape(b, t, h * d)


def to_chunks(x, c):
    b, h, t = x.shape[:3]
    return jnp.moveaxis(x.reshape(b, h, t // c, c, *x.shape[3:]), 2, 0)


def from_chunks(x):
    n, b, h, c, d = x.shape
    return jnp.moveaxis(x, 0, 2).reshape(b, h, n * c, d)


def causal_dwconv(x, w):
    width, t = w.shape[0], x.shape[1]
    xp = jnp.pad(x, ((0, 0), (width - 1, 0), (0, 0)))
    y = xp[:, 0:t] * w[0]
    for j in range(1, width):
        y = y + xp[:, j:j + t] * w[j]
    return y


def gated_delta_rule(q, k, v, g, beta):
    b, h, _, dk = q.shape
    dv = v.shape[-1]
    c = DN_CHUNK
    q, k, v = to_chunks(q, c), to_chunks(k, c), to_chunks(v, c)
    g, beta = to_chunks(g, c), to_chunks(beta, c)
    gc = jnp.cumsum(g, axis=-1)
    causal = jnp.tril(jnp.ones((c, c), bool))
    strict = jnp.tril(jnp.ones((c, c), bool), -1)
    decay = jnp.exp(jnp.where(causal, gc[..., :, None] - gc[..., None, :], -jnp.inf))
    kb = k * beta[..., None]
    m = jnp.where(strict, jnp.einsum('nbhid,nbhjd->nbhij', kb, k) * decay, 0.0)
    rhs = jnp.concatenate([v * beta[..., None], kb * jnp.exp(gc)[..., None]], axis=-1)
    sol = lax.linalg.triangular_solve(jnp.eye(c, dtype=F32) + m, rhs, left_side=True, lower=True, unit_diagonal=True)
    u, w = sol[..., :dv], sol[..., dv:]
    qk = jnp.einsum('nbhid,nbhjd->nbhij', q, k) * decay
    q_dec = q * jnp.exp(gc)[..., None]
    k_dec = k * jnp.exp(gc[..., -1:] - gc)[..., None]
    g_tot = jnp.exp(gc[..., -1])[..., None, None]

    def step(state, xs):
        u_n, w_n, qk_n, qd_n, kd_n, gt_n = xs
        v_new = u_n - jnp.einsum('bhcd,bhde->bhce', w_n, state)
        o = jnp.einsum('bhcd,bhde->bhce', qd_n, state) + jnp.einsum('bhij,bhje->bhie', qk_n, v_new)
        state = state * gt_n + jnp.einsum('bhcd,bhce->bhde', kd_n, v_new)
        return state, o

    _, o = lax.scan(step, jnp.zeros((b, h, dk, dv), F32), (u, w, qk, q_dec, k_dec, g_tot))
    return from_chunks(o)


def rg_lru_branch(xr, yr, conv_w, conv_b, wa, ba, wx, bx, lam):
    b, t, _ = xr.shape
    xc = (causal_dwconv(xr, conv_w) + conv_b).astype(F32)
    xb = xc.reshape(b, t, LRU_BLOCKS, LRU_BLK)
    r = jax.nn.sigmoid(jnp.einsum('btgi,gij->btgj', xb, wa.astype(F32)).reshape(b, t, -1) + ba.astype(F32))
    i = jax.nn.sigmoid(jnp.einsum('btgi,gij->btgj', xb, wx.astype(F32)).reshape(b, t, -1) + bx.astype(F32))
    log_a = -LRU_C * r * jax.nn.softplus(-lam.astype(F32))
    a = jnp.exp(log_a)
    u = jnp.sqrt(-jnp.expm1(2.0 * log_a)) * (i * xc)

    def combine(e1, e2):
        a1, b1 = e1
        a2, b2 = e2
        return a1 * a2, a2 * b1 + b2

    _, hs = lax.associative_scan(combine, (a, u), axis=1)
    return hs * jax.nn.gelu(yr.astype(F32))


def even_mixer(hn, w_in, w_out, dn_conv_w, dn_a_log, dn_dt_bias, dn_norm_w,
               lru_conv_w, lru_conv_b, lru_wa, lru_ba, lru_wx, lru_bx, lru_lambda):
    proj = hn @ w_in
    qkv, z, b_raw, a_raw, xr, yr = split_cols(proj, EV_SPLITS)
    qkv = jax.nn.silu(causal_dwconv(qkv, dn_conv_w)).astype(F32)
    q, k, v = split_cols(qkv, (DN_QK, DN_QK, DN_V))
    q = l2_normalize(to_heads(q, DN_HEADS)) * (DN_DK ** -0.5)
    k = l2_normalize(to_heads(k, DN_HEADS))
    v = to_heads(v, DN_HEADS)
    beta = jax.nn.sigmoid(b_raw.astype(F32)).transpose(0, 2, 1)
    g = (-jnp.exp(dn_a_log.astype(F32)) * jax.nn.softplus(a_raw.astype(F32) + dn_dt_bias.astype(F32))).transpose(0, 2, 1)
    o = gated_delta_rule(q, k, v, g, beta)
    o = rms_norm(o, dn_norm_w) * jax.nn.silu(to_heads(z.astype(F32), DN_HEADS))
    y_a = merge_heads(o)
    y_b = rg_lru_branch(xr, yr, lru_conv_w, lru_conv_b, lru_wa, lru_ba, lru_wx, lru_bx, lru_lambda)
    return jnp.concatenate([y_a, y_b], axis=-1).astype(hn.dtype) @ w_out


def dilated_branch(q, k, v, slopes, window, dilation):
    b, h, t, dh = q.shape
    d = dilation
    span = window // dilation
    n_len = t // d
    nb = -(-n_len // SWA_BLOCK)
    lp = nb * SWA_BLOCK

    def to_res(x):
        x = x.reshape(b, h, n_len, d, dh).transpose(0, 1, 3, 2, 4)
        x = jnp.pad(x, ((0, 0), (0, 0), (0, 0), (0, lp - n_len), (0, 0)))
        return x.reshape(b, h, d, nb, SWA_BLOCK, dh)

    def with_prev(x):
        prev = jnp.pad(x[:, :, :, :-1], ((0, 0), (0, 0), (0, 0), (1, 0), (0, 0), (0, 0)))
        return jnp.concatenate([prev, x], axis=4)

    def from_res(x):
        x = x.reshape(b, h, d, lp, *x.shape[5:])[:, :, :, :n_len]
        x = jnp.moveaxis(x, 2, 3)
        return x.reshape(b, h, t, *x.shape[4:])

    qr = to_res(q)
    kk, vv = with_prev(to_res(k)), with_prev(to_res(v))
    iq = jnp.arange(SWA_BLOCK)
    ik = jnp.arange(2 * SWA_BLOCK)
    rel = SWA_BLOCK + iq[:, None] - ik[None, :]
    blk = jnp.arange(nb)
    valid = (rel >= 0) & (rel <= span) & ((blk[:, None, None] > 0) | (ik >= SWA_BLOCK)[None, None, :])
    s = jnp.einsum('bhrnqd,bhrnkd->bhrnqk', qr, kk)
    s = s - slopes[:, None, None, None, None] * (rel * d).astype(F32)
    s = jnp.where(valid, s, -jnp.inf)
    mx = jnp.max(s, axis=-1, keepdims=True)
    pr = jnp.exp(s - mx)
    den = jnp.sum(pr, axis=-1, keepdims=True)
    o = jnp.einsum('bhrnqk,bhrnkd->bhrnqd', pr, vv) / den
    lse = (mx + jnp.log(den))[..., 0]
    return from_res(o), from_res(lse)


def retention(q, k, v, log_gamma):
    b, h, _, dk = q.shape
    dv = v.shape[-1]
    c = RET_CHUNK
    idx = jnp.arange(c, dtype=F32)
    rel = idx[:, None] - idx[None, :]
    dmask = jnp.where(rel >= 0, jnp.exp(jnp.maximum(rel, 0.0)[None] * log_gamma[:, None, None]), 0.0)
    qc, kc, vc = to_chunks(q, c), to_chunks(k, c), to_chunks(v, c)
    intra = jnp.einsum('nbhij,nbhje->nbhie', jnp.einsum('nbhid,nbhjd->nbhij', qc, kc) * dmask, vc)
    q_dec = qc * jnp.exp((idx + 1.0)[None, :] * log_gamma[:, None])[:, :, None]
    k_dec = kc * jnp.exp((c - 1.0 - idx)[None, :] * log_gamma[:, None])[:, :, None]
    chunk_decay = jnp.exp(c * log_gamma)[:, None, None]

    def step(state, xs):
        qd, kd, vn = xs
        o = jnp.einsum('bhcd,bhde->bhce', qd, state)
        state = state * chunk_decay + jnp.einsum('bhcd,bhce->bhde', kd, vn)
        return state, o

    _, inter = lax.scan(step, jnp.zeros((b, h, dk, dv), F32), (q_dec, k_dec, vc))
    return from_chunks(intra + inter)


def odd_mixer(hn, w_in, w_out):
    proj = hn @ w_in
    cq, ck, cv, rq, rk, rv, rg = split_cols(proj.astype(F32), OD_SPLITS)
    q = to_heads(cq, SWA_HEADS) * (SWA_DIM ** -0.5)
    k = to_heads(ck, SWA_HEADS)
    v = to_heads(cv, SWA_HEADS)
    slopes = jnp.exp2(-8.0 * jnp.arange(1, SWA_HEADS + 1, dtype=F32) / SWA_HEADS)
    outs, lses = [], []
    for window, dilation in SWA_BRANCHES:
        o_i, lse_i = dilated_branch(q, k, v, slopes, window, dilation)
        outs.append(o_i)
        lses.append(lse_i)
    wts = jax.nn.softmax(jnp.stack(lses), axis=0)
    y_c = merge_heads(jnp.sum(jnp.stack(outs) * wts[..., None], axis=0))
    log_gamma = jnp.log1p(-jnp.exp2(-5.0 - jnp.arange(RET_HEADS, dtype=F32)))
    o_r = retention(to_heads(rq, RET_HEADS), to_heads(rk, RET_HEADS) * (RET_DK ** -0.5), to_heads(rv, RET_HEADS), log_gamma)
    o_r = head_group_norm(o_r) * jax.nn.silu(to_heads(rg, RET_HEADS))
    y_d = merge_heads(o_r)
    return jnp.concatenate([y_c, y_d], axis=-1).astype(hn.dtype) @ w_out


def setup_inputs(seed: int = 0) -> dict:
    key = jax.random.key(seed)
    ks = iter(jax.random.split(key, 32))

    def normal(shape, fan_in):
        return jax.random.normal(next(ks), shape, F32) * (fan_in ** -0.5)

    def gain(shape):
        return 1.0 + 0.02 * jax.random.normal(next(ks), shape, F32)

    def small(shape):
        return 0.02 * jax.random.normal(next(ks), shape, F32)

    x = jax.random.normal(next(ks), (BATCH, SEQ, D_MODEL), F32)
    p = jax.random.normal(next(ks), (DEPTH, BATCH, SEQ, PLE_DIM), F32)
    ln_mix_w = gain((DEPTH, D_MODEL))
    ln_mlp_w = gain((DEPTH, D_MODEL))
    ln_ple_w = gain((DEPTH, D_MODEL))
    w_up = normal((DEPTH, D_MODEL, D_FF), D_MODEL)
    w_down = normal((DEPTH, D_FF, D_MODEL), D_FF)
    w_ple_proj = normal((DEPTH, PLE_DIM, D_MODEL), PLE_DIM)
    w_ple_gate = normal((DEPTH, D_MODEL, D_MODEL), D_MODEL)
    ln_final_w = gain((D_MODEL,))
    ev_w_in = normal((N_EVEN, D_MODEL, EV_IN), D_MODEL)
    ev_w_out = normal((N_EVEN, EV_OUT, D_MODEL), EV_OUT)
    dn_conv_w = normal((N_EVEN, DN_CONV, 2 * DN_QK + DN_V), DN_CONV)
    dn_a_log = jnp.log(jax.random.uniform(next(ks), (N_EVEN, DN_HEADS), F32, 1.0, 16.0))
    dt = jnp.exp(jax.random.uniform(next(ks), (N_EVEN, DN_HEADS), F32, float(np.log(1e-3)), float(np.log(1e-1))))
    dn_dt_bias = dt + jnp.log(-jnp.expm1(-dt))
    dn_norm_w = gain((N_EVEN, DN_DV))
    lru_conv_w = normal((N_EVEN, LRU_CONV, LRU_WIDTH), LRU_CONV)
    lru_conv_b = small((N_EVEN, LRU_WIDTH))
    lru_wa = normal((N_EVEN, LRU_BLOCKS, LRU_BLK, LRU_BLK), LRU_BLK)
    lru_ba = small((N_EVEN, LRU_WIDTH))
    lru_wx = normal((N_EVEN, LRU_BLOCKS, LRU_BLK, LRU_BLK), LRU_BLK)
    lru_bx = small((N_EVEN, LRU_WIDTH))
    a_pow_c = jax.random.uniform(next(ks), (N_EVEN, LRU_WIDTH), F32, 0.9, 0.999)
    log_a = jnp.log(a_pow_c) / LRU_C
    lru_lambda = log_a - jnp.log(-jnp.expm1(log_a))
    od_w_in = normal((N_ODD, D_MODEL, OD_IN), D_MODEL)
    od_w_out = normal((N_ODD, OD_OUT, D_MODEL), OD_OUT)
    return {"x": x, "p": p, "ln_mix_w": ln_mix_w, "ln_mlp_w": ln_mlp_w, "ln_ple_w": ln_ple_w,
            "w_up": w_up, "w_down": w_down, "w_ple_proj": w_ple_proj, "w_ple_gate": w_ple_gate,
            "ln_final_w": ln_final_w, "ev_w_in": ev_w_in, "ev_w_out": ev_w_out, "dn_conv_w": dn_conv_w,
            "dn_a_log": dn_a_log, "dn_dt_bias": dn_dt_bias, "dn_norm_w": dn_norm_w,
            "lru_conv_w": lru_conv_w, "lru_conv_b": lru_conv_b, "lru_wa": lru_wa, "lru_ba": lru_ba,
            "lru_wx": lru_wx, "lru_bx": lru_bx, "lru_lambda": lru_lambda,
            "od_w_in": od_w_in, "od_w_out": od_w_out}


def reference(x, p, ln_mix_w, ln_mlp_w, ln_ple_w, w_up, w_down, w_ple_proj, w_ple_gate, ln_final_w,
              ev_w_in, ev_w_out, dn_conv_w, dn_a_log, dn_dt_bias, dn_norm_w,
              lru_conv_w, lru_conv_b, lru_wa, lru_ba, lru_wx, lru_bx, lru_lambda,
              od_w_in, od_w_out):
    h = x
    for i in range(DEPTH):
        j = i // 2
        hn = rms_norm(h, ln_mix_w[i])
        if i % 2 == 0:
            mix = even_mixer(hn, ev_w_in[j], ev_w_out[j], dn_conv_w[j], dn_a_log[j], dn_dt_bias[j], dn_norm_w[j],
                             lru_conv_w[j], lru_conv_b[j], lru_wa[j], lru_ba[j], lru_wx[j], lru_bx[j], lru_lambda[j])
        else:
            mix = odd_mixer(hn, od_w_in[j], od_w_out[j])
        h = h + mix
        hn = rms_norm(h, ln_mlp_w[i])
        h = h + jnp.square(jax.nn.relu(hn @ w_up[i])) @ w_down[i]
        hn = rms_norm(h, ln_ple_w[i])
        h = h + jax.nn.sigmoid(hn @ w_ple_gate[i]) * (p[i] @ w_ple_proj[i])
    return rms_norm(h, ln_final_w)
```

```cpp
#include <hip/hip_runtime.h>
#include <cstdio>
#include <cstdint>
#include <cmath>

#ifndef ONE_LAUNCH
#define ONE_LAUNCH 1
#endif

namespace pg8 {
#define PG8_LAS __attribute__((address_space(3)))
typedef unsigned short bf16_t;
typedef short bf16x8 __attribute__((ext_vector_type(8)));
typedef float f32x4 __attribute__((ext_vector_type(4)));
typedef unsigned u32x4 __attribute__((ext_vector_type(4)));
constexpr int BM = 256, BK = 64, HALF = 128, HTB = HALF * BK * 2  , STAGE_BYTES = 8 * HTB, NXCD = 8, WGM = 8;

__host__ __device__ __forceinline__ int lds_byte(int r, int c) { const int st = (r >> 4) * 2 + (c >> 5), rr = r & 15, cc = c & 31, ob = rr * 64 + cc * 2; return st * 1024 + (ob ^ (((ob >> 9) & 1) << 5)); }
__host__ __device__ __forceinline__ void stage_rc(int b, int& R, int& C) { const int st = b / 1024, sb = b % 1024, swz = sb ^ (((sb >> 9) & 1) << 5); R = (st >> 1) * 16 + swz / 64; C = (st & 1) * 32 + (swz % 64) / 2; }
__host__ __device__ __forceinline__ int perm32(int rho) { const int n = rho >> 4, i = rho & 15; return 8 * (i >> 2) + 4 * n + (i & 3); }

struct Unit { int pm, pn; };
struct Gemm { const bf16_t* A; const bf16_t* Bt; int M, N, K; };

struct StaticOrder {
    int nM, nN, nwg, G, c;
    __host__ __device__ void init(int M, int N, int G_, int c_) { nM = M / BM; nN = N / BM; nwg = nM * nN; G = G_; c = c_; }
    __host__ __device__ bool next(int i, Unit& u) const {
        const long L = (long)i * G + c; if (L >= nwg) return false;
        int wgid = (int)L; { const int q = nwg / NXCD, r = nwg % NXCD, xcd = wgid % NXCD, off = wgid / NXCD; wgid = (xcd < r ? xcd * (q + 1) : r * (q + 1) + (xcd - r) * q) + off; }
        const int nig = WGM * nN, gid = wgid / nig, fm = gid * WGM, gsz = (nM - fm) < WGM ? (nM - fm) : WGM;
        u.pm = fm + ((wgid % nig) % gsz); u.pn = (wgid % nig) / gsz; return true;
    }
    __device__ __forceinline__ void a_ready(const Unit&) const {}
    __device__ __forceinline__ void done(const Unit&) const {}
};

__device__ __forceinline__ unsigned cvt_pk_bf16(float lo, float hi) { unsigned r; asm volatile("v_cvt_pk_bf16_f32 %0, %1, %2" : "=v"(r) : "v"(lo), "v"(hi)); return r; }

__device__ __forceinline__ float row_rstd32(const float* ssp, int row, int fq) {
    const f32x4 a = *(const f32x4*)(ssp + (size_t)row * 32 + fq * 8), b = *(const f32x4*)(ssp + (size_t)row * 32 + fq * 8 + 4);
    float s = ((a[0] + a[1]) + (a[2] + a[3])) + ((b[0] + b[1]) + (b[2] + b[3]));
    s += __shfl_xor(s, 16); s += __shfl_xor(s, 32);
    return 1.0f / sqrtf(s * (1.0f / 2048.0f) + 1e-6f);
}
__device__ __forceinline__ void rows_rstd32(const float* ssp, int row0, int fq, float (&rs)[2][4]) {
    f32x4 pa[2][4][2];
#pragma unroll
    for (int ai = 0; ai < 2; ++ai)
#pragma unroll
        for (int m = 0; m < 4; ++m) { const float* p = ssp + (size_t)(row0 + ai * HALF + m * 16) * 32 + fq * 8; pa[ai][m][0] = *(const f32x4*)p; pa[ai][m][1] = *(const f32x4*)(p + 4); }
    __builtin_amdgcn_sched_barrier(0);
#pragma unroll
    for (int ai = 0; ai < 2; ++ai)
#pragma unroll
        for (int m = 0; m < 4; ++m) { const f32x4 a = pa[ai][m][0], b = pa[ai][m][1]; float s = ((a[0] + a[1]) + (a[2] + a[3])) + ((b[0] + b[1]) + (b[2] + b[3]));
            s += __shfl_xor(s, 16); s += __shfl_xor(s, 32); rs[ai][m] = 1.0f / sqrtf(s * (1.0f / 2048.0f) + 1e-6f); }
}
template <int ACT> struct EpiB16 {
    static constexpr bool PERM = true, AFTER_DRAIN = false;
    bf16_t* O; int ldc; const float* ss;
    __device__ __forceinline__ void operator()(const f32x4 (&acc)[2][2][4][2], const Unit& u, int wr, int wc, int fr, int fq) const {
        const int row0 = u.pm * BM + wr * 64 + fr; const int col0 = u.pn * BM + wc * 32 + 8 * fq;
        float rs[2][4];
        if (ss) rows_rstd32(ss, row0, fq, rs);
        else {
#pragma unroll
            for (int ai = 0; ai < 2; ++ai)
#pragma unroll
                for (int m = 0; m < 4; ++m) rs[ai][m] = 1.0f; }
#pragma unroll
        for (int ai = 0; ai < 2; ++ai)
#pragma unroll
            for (int m = 0; m < 4; ++m) { bf16_t* rowp = O + (size_t)(row0 + ai * HALF + m * 16) * ldc + col0;
#pragma unroll
                for (int bj = 0; bj < 2; ++bj) { f32x4 v0 = acc[ai][bj][m][0] * rs[ai][m], v1 = acc[ai][bj][m][1] * rs[ai][m];
                    if (ACT == 1) {
#pragma unroll
                        for (int j = 0; j < 4; ++j) { const float a = fmaxf(v0[j], 0.f), b = fmaxf(v1[j], 0.f); v0[j] = a * a; v1[j] = b * b; } }
                    u32x4 w; w.x = cvt_pk_bf16(v0[0], v0[1]); w.y = cvt_pk_bf16(v0[2], v0[3]); w.z = cvt_pk_bf16(v1[0], v1[1]); w.w = cvt_pk_bf16(v1[2], v1[3]);
                    __builtin_nontemporal_store(w, (u32x4*)(rowp + bj * HALF)); } }
    }
};
__device__ __forceinline__ void unpack_bf8(const u32x4 w, f32x4& a, f32x4& b) {
    a = (f32x4){__uint_as_float(w.x << 16), __uint_as_float(w.x & 0xffff0000u), __uint_as_float(w.y << 16), __uint_as_float(w.y & 0xffff0000u)};
    b = (f32x4){__uint_as_float(w.z << 16), __uint_as_float(w.z & 0xffff0000u), __uint_as_float(w.w << 16), __uint_as_float(w.w & 0xffff0000u)};
}
__device__ __forceinline__ u32x4 pack_bf8(const f32x4 a, const f32x4 b) { u32x4 w; w.x = cvt_pk_bf16(a[0], a[1]); w.y = cvt_pk_bf16(a[2], a[3]); w.z = cvt_pk_bf16(b[0], b[1]); w.w = cvt_pk_bf16(b[2], b[3]); return w; }
__device__ __forceinline__ float sumsq4(const f32x4 v) { return (v[0] * v[0] + v[1] * v[1]) + (v[2] * v[2] + v[3] * v[3]); }
struct EpiResid {
    static constexpr bool PERM = true, AFTER_DRAIN = false;
    const float* basef; const bf16_t* baseh; bf16_t* h16; int ldc; float* ss;
    const float* ssin;
    __device__ __forceinline__ void fin(const f32x4 (&acc)[2][2][4][2], const Unit& u, int q, int row0, int col0, int wc, int fq, f32x4 b0, f32x4 b1, f32x4 c0, f32x4 c1, float sc) const {
        const int ai = q >> 2, m = q & 3; const int row = row0 + ai * HALF + m * 16; const size_t off = (size_t)row * ldc + col0;
        const f32x4 v0 = b0 + acc[ai][0][m][0] * sc, v1 = b1 + acc[ai][0][m][1] * sc, v2 = c0 + acc[ai][1][m][0] * sc, v3 = c1 + acc[ai][1][m][1] * sc;
        *(u32x4*)(h16 + off) = pack_bf8(v0, v1); *(u32x4*)(h16 + off + HALF) = pack_bf8(v2, v3);
        if (ss) { float sq = (sumsq4(v0) + sumsq4(v1)) + (sumsq4(v2) + sumsq4(v3)); sq += __shfl_xor(sq, 16); sq += __shfl_xor(sq, 32);
            if (fq == 0) ss[(size_t)row * 32 + u.pn * 4 + wc] = sq; }
    }
    __device__ __forceinline__ void operator()(const f32x4 (&acc)[2][2][4][2], const Unit& u, int wr, int wc, int fr, int fq) const {
        const int row0 = u.pm * BM + wr * 64 + fr, col0 = u.pn * BM + wc * 32 + 8 * fq;
#define ER_OFF(q_) ((size_t)(row0 + ((q_) >> 2) * HALF + ((q_) & 3) * 16) * ldc + col0)
        if (basef) {
            f32x4 b[2][4];
#define ERF_LOAD(q_) do { const float* p_ = basef + ER_OFF(q_); b[(q_) & 1][0] = *(const f32x4*)p_; b[(q_) & 1][1] = *(const f32x4*)(p_ + 4); b[(q_) & 1][2] = *(const f32x4*)(p_ + HALF); b[(q_) & 1][3] = *(const f32x4*)(p_ + HALF + 4); } while (0)
            ERF_LOAD(0); ERF_LOAD(1);
            __builtin_amdgcn_sched_barrier(0);
#pragma unroll
            for (int q = 0; q < 8; ++q) {
                fin(acc, u, q, row0, col0, wc, fq, b[q & 1][0], b[q & 1][1], b[q & 1][2], b[q & 1][3], 1.0f);
                if (q + 2 < 8) ERF_LOAD(q + 2);
                asm volatile("" ::: "memory");
            }
#undef ERF_LOAD
        } else if (ssin) {
            u32x4 b[8][2]; f32x4 pa[2][4][2]; float rs2[2][4];
#define ER_BLOAD(q_) do { const bf16_t* p_ = baseh + ER_OFF(q_); b[q_][0] = *(const u32x4*)p_; b[q_][1] = *(const u32x4*)(p_ + HALF); } while (0)
#define ER_RS_LOAD(ai_) do { _Pragma("unroll") for (int m = 0; m < 4; ++m) { const float* p_ = ssin + (size_t)(row0 + (ai_) * HALF + m * 16) * 32 + fq * 8; pa[ai_][m][0] = *(const f32x4*)p_; pa[ai_][m][1] = *(const f32x4*)(p_ + 4); } } while (0)
#define ER_RS_REDUCE(ai_) do { _Pragma("unroll") for (int m = 0; m < 4; ++m) { const f32x4 a_ = pa[ai_][m][0], b_ = pa[ai_][m][1]; float s_ = ((a_[0] + a_[1]) + (a_[2] + a_[3])) + ((b_[0] + b_[1]) + (b_[2] + b_[3])); \
                s_ += __shfl_xor(s_, 16); s_ += __shfl_xor(s_, 32); rs2[ai_][m] = 1.0f / (s_ * (1.0f / 2048.0f) + 1e-6f); } } while (0)
#define ER_PROC(q_) do { f32x4 b0, b1, c0, c1; unpack_bf8(b[q_][0], b0, b1); unpack_bf8(b[q_][1], c0, c1); fin(acc, u, q_, row0, col0, wc, fq, b0, b1, c0, c1, rs2[(q_) >> 2][(q_) & 3]); asm volatile("" ::: "memory"); } while (0)
            ER_RS_LOAD(0); ER_BLOAD(0); ER_BLOAD(1); ER_BLOAD(2);
            __builtin_amdgcn_sched_barrier(0);
            ER_RS_REDUCE(0);
            ER_PROC(0); ER_RS_LOAD(1); ER_BLOAD(3); asm volatile("" ::: "memory");
            ER_PROC(1); ER_BLOAD(4); ER_BLOAD(5); asm volatile("" ::: "memory");
            ER_PROC(2); ER_BLOAD(6); ER_BLOAD(7); asm volatile("" ::: "memory");
            ER_PROC(3);
            ER_RS_REDUCE(1);
            ER_PROC(4); ER_PROC(5); ER_PROC(6); ER_PROC(7);
#undef ER_PROC
#undef ER_RS_REDUCE
#undef ER_RS_LOAD
#undef ER_BLOAD
        } else {
            u32x4 b[8][2];
#pragma unroll
            for (int q = 0; q < 8; ++q) { const bf16_t* p_ = baseh + ER_OFF(q); b[q][0] = *(const u32x4*)p_; b[q][1] = *(const u32x4*)(p_ + HALF); }
            __builtin_amdgcn_sched_barrier(0);
#pragma unroll
            for (int q = 0; q < 8; ++q) { f32x4 b0, b1, c0, c1; unpack_bf8(b[q][0], b0, b1); unpack_bf8(b[q][1], c0, c1);
                fin(acc, u, q, row0, col0, wc, fq, b0, b1, c0, c1, 1.0f);
                asm volatile("" ::: "memory"); }
        }
#undef ER_OFF
    }
};
struct EpiGate {
    static constexpr bool PERM = true, AFTER_DRAIN = false;
    const bf16_t* hin; bf16_t* h16; const bf16_t* pp; int ldc; const float* ss;
    __device__ __forceinline__ void operator()(const f32x4 (&acc)[2][2][4][2], const Unit& u, int wr, int wc, int fr, int fq) const {
        const int row0 = u.pm * BM + wr * 64 + fr, col0 = u.pn * BM + wc * 32 + 8 * fq;
        u32x4 hw[8][2], pw[8][2];
        f32x4 pa[2][4][2];
        float rsv[2][4];
#define EG_OFF(q_) ((size_t)(row0 + ((q_) >> 2) * HALF + ((q_) & 3) * 16) * ldc + col0)
#define EG_LOAD(q_) do { const size_t off_ = EG_OFF(q_); hw[q_][0] = *(const u32x4*)(hin + off_); hw[q_][1] = *(const u32x4*)(hin + off_ + HALF); pw[q_][0] = *(const u32x4*)(pp + off_); pw[q_][1] = *(const u32x4*)(pp + off_ + HALF); } while (0)
#define EG_RS_LOAD(ai_) do { if (ss) { _Pragma("unroll") for (int m = 0; m < 4; ++m) { const float* p_ = ss + (size_t)(row0 + (ai_) * HALF + m * 16) * 32 + fq * 8; pa[ai_][m][0] = *(const f32x4*)p_; pa[ai_][m][1] = *(const f32x4*)(p_ + 4); } } } while (0)
#define EG_RS_REDUCE(ai_) do { _Pragma("unroll") for (int m = 0; m < 4; ++m) { if (ss) { const f32x4 a_ = pa[ai_][m][0], b_ = pa[ai_][m][1]; float s_ = ((a_[0] + a_[1]) + (a_[2] + a_[3])) + ((b_[0] + b_[1]) + (b_[2] + b_[3])); \
            s_ += __shfl_xor(s_, 16); s_ += __shfl_xor(s_, 32); rsv[ai_][m] = 1.0f / sqrtf(s_ * (1.0f / 2048.0f) + 1e-6f); } else rsv[ai_][m] = 1.0f; } } while (0)
#define EG_PROC(q_) do { const int ai_ = (q_) >> 2, m_ = (q_) & 3; const size_t off = EG_OFF(q_); const float rs = rsv[ai_][m_]; \
            _Pragma("unroll") for (int bj = 0; bj < 2; ++bj) { f32x4 h0, h1, p0, p1; unpack_bf8(hw[q_][bj], h0, h1); unpack_bf8(pw[q_][bj], p0, p1); \
                const f32x4 a0 = acc[ai_][bj][m_][0], a1 = acc[ai_][bj][m_][1]; f32x4 r0, r1; \
                _Pragma("unroll") for (int j = 0; j < 4; ++j) { r0[j] = h0[j] + p0[j] / (1.0f + __expf(-a0[j] * rs)); r1[j] = h1[j] + p1[j] / (1.0f + __expf(-a1[j] * rs)); } \
                *(u32x4*)(h16 + off + bj * HALF) = pack_bf8(r0, r1); } \
            asm volatile("" ::: "memory"); } while (0)
        EG_RS_LOAD(0); EG_LOAD(0); EG_LOAD(1);
        __builtin_amdgcn_sched_barrier(0);
        EG_RS_REDUCE(0);
        EG_PROC(0); EG_LOAD(2); EG_RS_LOAD(1); asm volatile("" ::: "memory");
        EG_PROC(1); EG_LOAD(3); EG_LOAD(4); asm volatile("" ::: "memory");
        EG_RS_REDUCE(1);
        EG_PROC(2); EG_LOAD(5); EG_LOAD(6); asm volatile("" ::: "memory");
        EG_PROC(3); EG_LOAD(7); asm volatile("" ::: "memory");
        EG_PROC(4); EG_PROC(5); EG_PROC(6); EG_PROC(7);
#undef EG_PROC
#undef EG_RS_REDUCE
#undef EG_RS_LOAD
#undef EG_LOAD
#undef EG_OFF
    }
};

template <class Epi, class Sched, bool ALIGN_EPI = false, bool SP2 = false>
__device__ __forceinline__ void gemm_phase(PG8_LAS unsigned char* lds, const Gemm g, const Sched& S, const Epi& E) {
    int tid = threadIdx.x; asm volatile("" : "+v"(tid));
    const int wid = __builtin_amdgcn_readfirstlane(tid >> 6), lane = tid & 63, wr = wid >> 2, wc = wid & 3, fr = lane & 15, fq = lane >> 4;
    const int K = g.K, nt = K / BK;
    unsigned voffA[2], voffB[2];
#pragma unroll
    for (int i = 0; i < 2; ++i) { int R, C; stage_rc(tid * 16 + i * 8192, R, C); const int Rb = Epi::PERM ? ((R & ~31) + perm32(R & 31)) : R;
        voffA[i] = (unsigned)(R * K + C) * 2u; voffB[i] = (unsigned)(Rb * K + C) * 2u; }
    const size_t kstep = (size_t)(BK * 2);
    const size_t hstep = (size_t)HALF * K * 2;
    const size_t tstep = 2 * hstep;
    const unsigned ldsw = (unsigned)wid * 1024u;
    const int aoff = lds_byte(wr * 64 + fr, fq * 8), boff = lds_byte(wc * 32 + fr, fq * 8);
#define PG8_SA(b, h) (((b) * 2 + (h)) * HTB)
#define PG8_SB(b, h) ((4 + (b) * 2 + (h)) * HTB)
#define PG8_STAGE(bufoff, gbase, voff) do { _Pragma("unroll") for (int _i = 0; _i < 2; ++_i) \
        __builtin_amdgcn_global_load_lds((const unsigned*)((const char*)(gbase) + (voff)[_i]), (PG8_LAS unsigned*)(lds + (bufoff) + ldsw + _i * 8192), 16, 0, 0); } while (0)
#define PG8_LDA(dst, b, h) do { _Pragma("unroll") for (int m = 0; m < 4; ++m) _Pragma("unroll") for (int k = 0; k < 2; ++k) dst[m][k] = *(const PG8_LAS bf16x8*)(lds + PG8_SA(b, h) + aoff + m * 2048 + k * 1024); } while (0)
#define PG8_LDB(dst, b, h) do { _Pragma("unroll") for (int n = 0; n < 2; ++n) _Pragma("unroll") for (int k = 0; k < 2; ++k) dst[n][k] = *(const PG8_LAS bf16x8*)(lds + PG8_SB(b, h) + boff + n * 2048 + k * 1024); } while (0)
#define PG8_MMA(ai, bj, At, Bt) do { __builtin_amdgcn_s_setprio(1); _Pragma("unroll") for (int m = 0; m < 4; ++m) _Pragma("unroll") for (int n = 0; n < 2; ++n) _Pragma("unroll") for (int k = 0; k < 2; ++k) \
        acc[ai][bj][m][n] = __builtin_amdgcn_mfma_f32_16x16x32_bf16(Bt[n][k], At[m][k], acc[ai][bj][m][n], 0, 0, 0); __builtin_amdgcn_s_setprio(0); } while (0)
#define PG8_WAIT_V(n) asm volatile("s_waitcnt vmcnt(" #n ")" ::: "memory")
#define PG8_WAIT_V_SEL(t_, ui_) asm volatile("s_cmp_lg_u32 %0, 0\n\ts_cbranch_scc1 1f\n\ts_cmp_eq_u32 %1, 0\n\ts_cbranch_scc1 1f\n\ts_waitcnt vmcnt(24)\n\ts_branch 2f\n1:\n\ts_waitcnt vmcnt(8)\n2:" :: "s"(t_), "s"(ui_) : "memory", "scc")
#define PG8_WAIT_L(n) asm volatile("s_waitcnt lgkmcnt(" #n ")" ::: "memory")
#define PG8_BAR __builtin_amdgcn_s_barrier()
#define PG8_SCHED __builtin_amdgcn_sched_barrier(0)
    Unit cur, nxt; int ui = 0;
    if (!S.next(0, cur)) return;
    f32x4 acc[2][2][4][2];
#pragma unroll
    for (int a = 0; a < 2; ++a)
#pragma unroll
        for (int b = 0; b < 2; ++b)
#pragma unroll
            for (int m = 0; m < 4; ++m)
#pragma unroll
                for (int n = 0; n < 2; ++n) acc[a][b][m][n] = (f32x4){0.f, 0.f, 0.f, 0.f};
    bf16x8 At[4][2], B0[2][2], B1[2][2];
    const char* cA = (const char*)g.A + (size_t)cur.pm * tstep; const char* cB = (const char*)g.Bt + (size_t)cur.pn * tstep;
    S.a_ready(cur);
    if constexpr (SP2) {
        PG8_STAGE(PG8_SB(0, 0), cB, voffB); PG8_STAGE(PG8_SB(0, 1), cB + hstep, voffB); PG8_STAGE(PG8_SA(0, 0), cA, voffA); PG8_STAGE(PG8_SA(0, 1), cA + hstep, voffA);
        if (wr == 1) PG8_BAR;
        PG8_WAIT_V(2); PG8_BAR;
        PG8_STAGE(PG8_SB(1, 0), cB + kstep, voffB); PG8_STAGE(PG8_SA(1, 0), cA + kstep, voffA); PG8_STAGE(PG8_SB(1, 1), cB + hstep + kstep, voffB);
        PG8_WAIT_V(6); PG8_BAR;
    } else {
        PG8_STAGE(PG8_SB(0, 0), cB, voffB); PG8_STAGE(PG8_SA(0, 0), cA, voffA); PG8_STAGE(PG8_SB(0, 1), cB + hstep, voffB); PG8_STAGE(PG8_SA(0, 1), cA + hstep, voffA);
        if (wr == 1) PG8_BAR;
        PG8_WAIT_V(4); PG8_BAR;
        PG8_STAGE(PG8_SB(1, 0), cB + kstep, voffB); PG8_STAGE(PG8_SA(1, 0), cA + kstep, voffA); PG8_STAGE(PG8_SB(1, 1), cB + hstep + kstep, voffB);
        PG8_WAIT_V(6); PG8_BAR;
    }
    for (;;) {
        const bool has_next = S.next(ui + 1, nxt);
        const char* nA = has_next ? (const char*)g.A + (size_t)nxt.pm * tstep : cA; const char* nB = has_next ? (const char*)g.Bt + (size_t)nxt.pn * tstep : cB;
        for (int t = 0; t < nt; t += 2) {
            const bool last = (t == nt - 2);
            const char* a1 = cA + (size_t)(t + 1) * kstep;
            const char* a2 = last ? nA : cA + (size_t)(t + 2) * kstep; const char* b2 = last ? nB : cB + (size_t)(t + 2) * kstep;
            const char* a3 = a2 + kstep; const char* b3 = b2 + kstep;
            if (last && has_next) S.a_ready(nxt);
            if constexpr (SP2) {
            PG8_LDB(B0, 0, 0); PG8_LDB(B1, 0, 1); PG8_SCHED; PG8_LDA(At, 0, 0); PG8_STAGE(PG8_SA(1, 1), a1 + hstep, voffA);
            PG8_WAIT_V_SEL(t, ui);
            PG8_WAIT_L(0); PG8_BAR; PG8_MMA(0, 0, At, B0); PG8_MMA(0, 1, At, B1); PG8_BAR; PG8_SCHED;
            PG8_LDA(At, 0, 1); PG8_STAGE(PG8_SB(0, 0), b2, voffB); PG8_STAGE(PG8_SB(0, 1), b2 + hstep, voffB); PG8_STAGE(PG8_SA(0, 0), a2, voffA);
            PG8_WAIT_V_SEL(t, ui);
            PG8_WAIT_L(0); PG8_BAR; PG8_MMA(1, 0, At, B0); PG8_MMA(1, 1, At, B1); PG8_BAR; PG8_SCHED;
            PG8_LDB(B0, 1, 0); PG8_LDB(B1, 1, 1); PG8_SCHED; PG8_LDA(At, 1, 0); PG8_STAGE(PG8_SA(0, 1), a2 + hstep, voffA);
            PG8_WAIT_V(8); PG8_WAIT_L(0); PG8_BAR; PG8_MMA(0, 0, At, B0); PG8_MMA(0, 1, At, B1); PG8_BAR; PG8_SCHED;
            PG8_LDA(At, 1, 1); PG8_STAGE(PG8_SB(1, 0), b3, voffB); PG8_STAGE(PG8_SB(1, 1), b3 + hstep, voffB); PG8_STAGE(PG8_SA(1, 0), a3, voffA);
            PG8_WAIT_V(8); PG8_WAIT_L(0); PG8_BAR; PG8_MMA(1, 0, At, B0); PG8_MMA(1, 1, At, B1); PG8_BAR; PG8_SCHED;
            } else {
            PG8_LDB(B0, 0, 0); PG8_SCHED; PG8_LDA(At, 0, 0); PG8_STAGE(PG8_SA(1, 1), a1 + hstep, voffA);
            PG8_WAIT_L(8); PG8_BAR; PG8_WAIT_L(0); PG8_MMA(0, 0, At, B0); PG8_BAR; PG8_SCHED;
            PG8_LDB(B1, 0, 1); PG8_STAGE(PG8_SB(0, 0), b2, voffB);
            PG8_BAR; PG8_WAIT_L(0); PG8_MMA(0, 1, At, B1); PG8_BAR;
            PG8_LDA(At, 0, 1); PG8_STAGE(PG8_SA(0, 0), a2, voffA);
            PG8_BAR; PG8_WAIT_L(0); PG8_MMA(1, 0, At, B0); PG8_BAR; PG8_SCHED;
            PG8_STAGE(PG8_SB(0, 1), b2 + hstep, voffB);
            PG8_WAIT_V(6); PG8_BAR; PG8_MMA(1, 1, At, B1); PG8_BAR;
            PG8_LDB(B0, 1, 0); PG8_SCHED; PG8_LDA(At, 1, 0); PG8_STAGE(PG8_SA(0, 1), a2 + hstep, voffA);
            PG8_WAIT_L(8); PG8_BAR; PG8_WAIT_L(0); PG8_MMA(0, 0, At, B0); PG8_BAR; PG8_SCHED;
            PG8_LDB(B1, 1, 1); PG8_STAGE(PG8_SB(1, 0), b3, voffB);
            PG8_BAR; PG8_WAIT_L(0); PG8_MMA(0, 1, At, B1); PG8_BAR;
            PG8_LDA(At, 1, 1); PG8_STAGE(PG8_SA(1, 0), a3, voffA);
            PG8_BAR; PG8_WAIT_L(0); PG8_MMA(1, 0, At, B0); PG8_BAR; PG8_SCHED;
            PG8_STAGE(PG8_SB(1, 1), b3 + hstep, voffB);
            PG8_WAIT_V(6); PG8_BAR; PG8_MMA(1, 1, At, B1); PG8_BAR;
            }
        }
        if constexpr (ALIGN_EPI) { if (wr == 0) PG8_BAR; }
        if constexpr (!Epi::AFTER_DRAIN) { E(acc, cur, wr, wc, fr, fq); S.done(cur); }
        if (!has_next) break;
#pragma unroll
        for (int a = 0; a < 2; ++a)
#pragma unroll
            for (int b = 0; b < 2; ++b)
#pragma unroll
                for (int m = 0; m < 4; ++m)
#pragma unroll
                    for (int n = 0; n < 2; ++n) acc[a][b][m][n] = (f32x4){0.f, 0.f, 0.f, 0.f};
        cur = nxt; cA = nA; cB = nB; ++ui;
        if constexpr (ALIGN_EPI) { if (wr == 1) PG8_BAR; }
    }
    PG8_WAIT_V(0);
    if constexpr (!ALIGN_EPI) { if (wr == 0) PG8_BAR; }
    PG8_BAR;
    if constexpr (Epi::AFTER_DRAIN) { E.fused(acc, cur, wr, wc, fr, fq, lds, wid, lane); S.done(cur); }
#undef PG8_SA
#undef PG8_SB
#undef PG8_STAGE
#undef PG8_LDA
#undef PG8_LDB
#undef PG8_MMA
#undef PG8_WAIT_V
#undef PG8_WAIT_L
#undef PG8_BAR
#undef PG8_SCHED
}
}

constexpr int NB = 4, SEQ = 8192, DM = 2048, DFF = 8192, NPROJ = 6144, PLE = 256, DEPTH = 4;
constexpr int M_TOK = NB * SEQ;
constexpr int EV_IN_W = 6160;
constexpr float RMS_EPS = 1e-6f, GN_EPS = 1e-5f;
constexpr float SC128 = 0.08838834764831845f;
constexpr int NWAVES = 8;
#ifndef LAYER_HI
#define LAYER_HI DEPTH
#endif

constexpr size_t MiB = 1u << 20;
constexpr size_t WS_CTL = 0, CTL_ZERO_BYTES = 1 * MiB;
constexpr size_t WS_WIN = WS_CTL + CTL_ZERO_BYTES;
constexpr size_t WS_WOUT = WS_WIN + (size_t)NPROJ * DM * 2;
constexpr size_t WS_WUP = WS_WOUT + (size_t)DM * DM * 2;
constexpr size_t WS_WDOWN = WS_WUP + (size_t)DFF * DM * 2;
constexpr size_t WS_WGATE = WS_WDOWN + (size_t)DM * DFF * 2;
constexpr size_t WS_WPP = WS_WGATE + (size_t)DM * DM * 2;
constexpr size_t WS_PB = WS_WPP + (size_t)DM * PLE * 2;
constexpr size_t WS_GB = WS_PB + (size_t)M_TOK * PLE * 2;
constexpr size_t WS_HN = WS_GB + (size_t)M_TOK * 16 * 4;
constexpr size_t WS_MIX = WS_HN + (size_t)M_TOK * DM * 2;
constexpr size_t WS_BIG = WS_MIX + (size_t)M_TOK * DM * 2;
constexpr size_t WS_PPB = WS_BIG + (size_t)M_TOK * DFF * 2;
constexpr size_t WS_LSUM = WS_PPB + (size_t)M_TOK * DM * 2;
constexpr size_t WS_LCIN = WS_LSUM + (size_t)NB * 256 * 1024 * 8;
constexpr size_t WS_DQK = WS_LCIN + (size_t)NB * 256 * 1024 * 4;
constexpr size_t WS_DGT = WS_DQK + (size_t)4096 * 64 * 64 * 2;
constexpr size_t WS_WLT = WS_DGT + 4096 * 4;
constexpr size_t WS_PP2 = WS_WLT + 8 * 256 * 128 * 2;
constexpr size_t WS_WIN2 = WS_PP2 + (size_t)M_TOK * DM * 2;
constexpr size_t WS_SS = WS_WIN2 + (size_t)NPROJ * DM * 2;
constexpr size_t WS_END = WS_SS + (size_t)2 * M_TOK * 32 * 4;
static_assert(WS_END <= 1286087808ull, "workspace map exceeds the guaranteed d_ws size (sum of inputs)");
constexpr int CW_BAR = 4096;

constexpr int RING_OFF = 0, RING_BYTES = 131072;
constexpr int LDS_BYTES = 163840;
constexpr int LDSCTL_OFF = LDS_BYTES - 1024, MISC_OFF = LDSCTL_OFF + 320;

#define GAS __attribute__((address_space(1)))
#define LAS __attribute__((address_space(3)))
typedef unsigned short bf16;
typedef unsigned v4u __attribute__((ext_vector_type(4)));
typedef unsigned v2u __attribute__((ext_vector_type(2)));
typedef float f32x4 __attribute__((ext_vector_type(4)));
typedef float f32x2 __attribute__((ext_vector_type(2)));
#define LDS_WAIT() asm volatile("s_waitcnt lgkmcnt(0)" ::: "memory")
#define LDS_BARRIER() do { asm volatile("s_waitcnt lgkmcnt(0)" ::: "memory"); __builtin_amdgcn_s_barrier(); asm volatile("" ::: "memory"); } while (0)
__device__ __forceinline__ unsigned f2bf(float f) { unsigned u = __float_as_uint(f); return (u + 0x7fffu + ((u >> 16) & 1u)) >> 16; }
__device__ __forceinline__ unsigned pk2(float lo, float hi) { return f2bf(lo) | (f2bf(hi) << 16); }
typedef __bf16 bf16v2_t __attribute__((ext_vector_type(2)));
__device__ __forceinline__ unsigned pkbf(float lo, float hi) { const f32x2 v = {lo, hi}; return __builtin_bit_cast(unsigned, __builtin_convertvector(v, bf16v2_t)); }
__device__ __forceinline__ float bflo(unsigned u) { return __uint_as_float(u << 16); }
__device__ __forceinline__ float bfhi(unsigned u) { return __uint_as_float(u & 0xffff0000u); }
__device__ __forceinline__ float bf2f(bf16 b) { return __uint_as_float((unsigned)b << 16); }
__device__ __forceinline__ float sigmoidf_(float x) { return 1.0f / (1.0f + __expf(-x)); }
__device__ __forceinline__ float siluf_(float x) { return x / (1.0f + __expf(-x)); }
__device__ __forceinline__ float softplusf_(float x) { return x > 20.f ? x : log1pf(expf(x)); }
__device__ __forceinline__ float neg_expm1f_(float x) { const float p = x * (1.f + x * 0.5f * (1.f + x * (1.f / 3.f) * (1.f + x * 0.25f * (1.f + x * 0.2f * (1.f + x * (1.f / 6.f) * (1.f + x * (1.f / 7.f))))))); return x > -0.35f ? -p : 1.0f - __expf(x); }
__device__ __forceinline__ float gelu_tanh(float x) { const float z = 0.7978845608028654f * (x + 0.044715f * x * x * x); const float th = 1.0f - 2.0f / (__expf(2.0f * z) + 1.0f); return 0.5f * x * (1.0f + th); }
__device__ __forceinline__ float wave_sum(float v) {
#pragma unroll
    for (int o = 1; o < 64; o <<= 1) v += __shfl_xor(v, o);
    return v;
}
__device__ __forceinline__ float wave_max(float v) {
#pragma unroll
    for (int o = 1; o < 64; o <<= 1) v = fmaxf(v, __shfl_xor(v, o));
    return v;
}
#define DPP_ADD(v, ctrl) ((v) + __int_as_float(__builtin_amdgcn_update_dpp(0, __float_as_int(v), (ctrl), 0xF, 0xF, true)))
__device__ __forceinline__ float row16_sum(float v) {
    v = DPP_ADD(v, 0xB1);
    v = DPP_ADD(v, 0x4E);
    v = DPP_ADD(v, 0x141);
    v = DPP_ADD(v, 0x140);
    return v;
}

__device__ __forceinline__ float row8_sum(float v) { v = DPP_ADD(v, 0xB1); v = DPP_ADD(v, 0x4E); v = DPP_ADD(v, 0x141); return v; }
__device__ __forceinline__ void unpack8(const v4u x, float* o) { o[0] = bflo(x.x); o[1] = bfhi(x.x); o[2] = bflo(x.y); o[3] = bfhi(x.y); o[4] = bflo(x.z); o[5] = bfhi(x.z); o[6] = bflo(x.w); o[7] = bfhi(x.w); }
__device__ __forceinline__ v4u pack8(const float* a) { v4u w; w.x = pkbf(a[0], a[1]); w.y = pkbf(a[2], a[3]); w.z = pkbf(a[4], a[5]); w.w = pkbf(a[6], a[7]); return w; }

#define XB_TMO      128
#define XB_XCNT(j)  (256  + 64 * (j))
#define XB_XSUB(j)  (1280 + 64 * (j))
#define XB_XGEN(j)  (2304 + 64 * (j))
#define XB_TOP      3328
#define XB_TOPGEN   3392
#define XCD_BAR_WORDS 3456
#define XB_SPIN_CAP (1u << 20)

__device__ __forceinline__ unsigned xb_ld(unsigned* p)              { return __hip_atomic_load(p, __ATOMIC_RELAXED, __HIP_MEMORY_SCOPE_AGENT); }
__device__ __forceinline__ unsigned xb_add(unsigned* p, unsigned v) { return __hip_atomic_fetch_add(p, v, __ATOMIC_RELAXED, __HIP_MEMORY_SCOPE_AGENT); }
__device__ __forceinline__ unsigned xb_xcc_id() { return (unsigned)__builtin_amdgcn_s_getreg((3 << 11) | 20) & 0xFu; }
#define XB_SPIN(cond, bar) do { unsigned _sp = 0; while (cond) { __builtin_amdgcn_s_sleep(1); \
    if ((++_sp & 255u) == 0u) { if (xb_ld(&(bar)[XB_TMO])) break; if (_sp > XB_SPIN_CAP) { atomicAdd(&(bar)[XB_TMO], 1u); break; } } } } while (0)

struct XcdBarrier { unsigned* bar; unsigned x; volatile LAS unsigned* st; };

__device__ __forceinline__ XcdBarrier xcd_barrier_post(unsigned* bar, volatile LAS unsigned* st) {
    XcdBarrier b; b.bar = bar; b.x = xb_xcc_id(); b.st = st;
    if (threadIdx.x == 0) (void)xb_add(&bar[XB_XCNT(b.x)], 1u);
    return b;
}
__device__ __forceinline__ void xcd_barrier_complete(unsigned* bar, unsigned x, unsigned& nloc, unsigned& nx) {
    const unsigned G = gridDim.x * gridDim.y * gridDim.z;
    unsigned sum, cnt, mine, sp = 0u;
    for (;;) {
        sum = 0u; cnt = 0u; mine = 0u;
#pragma unroll
        for (unsigned j = 0; j < 16; ++j) { const unsigned c = xb_ld(&bar[XB_XCNT(j)]); sum += c; cnt += (c > 0u) ? 1u : 0u; mine = (j == x) ? c : mine; }
        if (sum == G) break;
        __builtin_amdgcn_s_sleep(1);
        if ((++sp & 255u) == 0u) { if (xb_ld(&bar[XB_TMO])) break; if (sp > XB_SPIN_CAP) { atomicAdd(&bar[XB_TMO], 1u); break; } }
    }
    nloc = mine > 0u ? mine : 1u; nx = cnt > 0u ? cnt : 1u;
}
__device__ __forceinline__ void xcd_barrier(const XcdBarrier& b) {
    asm volatile("s_waitcnt vmcnt(0)" ::: "memory");
    __syncthreads();
    if (threadIdx.x == 0) {
        unsigned* bar = b.bar;
        __builtin_amdgcn_s_waitcnt(0);
        unsigned nloc = b.st[0], nx = b.st[1];
        if (nloc == 0u) { xcd_barrier_complete(bar, b.x, nloc, nx); b.st[0] = nloc; b.st[1] = nx; }
        const unsigned old = xb_add(&bar[XB_XSUB(b.x)], 1u);
        const unsigned gen = old / nloc;
        if (old + 1u == (gen + 1u) * nloc) {
            __builtin_amdgcn_fence(__ATOMIC_RELEASE, "agent");
            asm volatile("s_waitcnt vmcnt(0)" ::: "memory");
            const unsigned og = xb_add(&bar[XB_TOP], 1u);
            const unsigned tg = og / nx;
            if (og + 1u == (tg + 1u) * nx) xb_add(&bar[XB_TOPGEN], 1u);
            else XB_SPIN(xb_ld(&bar[XB_TOPGEN]) == tg, bar);
            __builtin_amdgcn_fence(__ATOMIC_ACQUIRE, "agent");
            xb_add(&bar[XB_XGEN(b.x)], 1u);
            asm volatile("s_waitcnt vmcnt(0)" ::: "memory");
        } else {
            XB_SPIN(xb_ld(&bar[XB_XGEN(b.x)]) == gen, bar);
            __builtin_amdgcn_fence(__ATOMIC_ACQUIRE, "agent");
            asm volatile("s_waitcnt vmcnt(0)" ::: "memory");
        }
    }
    __syncthreads();
}

struct Args { const float* in[25]; float* out; unsigned char* ws; int ph_lo, ph_hi; };
struct Frame {
    LAS unsigned char* lds;
    int tid, lane, wave, bx, G;
    const float* const* in;
    float* out;
    bf16 *WIN, *WOUT, *WUP, *WDOWN, *WGATE, *WPP, *PB, *HN, *MIX, *BIG, *PPB;
    float* GB; unsigned char* ws; bf16* PP2; bf16* H16;
};

__device__ __forceinline__ void tr_item(const float* W, int ldw, int c0, int K, bf16* WT, int r0, int nblk, LAS float* scr, int item, int lane, const float* kscale) {
    const int kb = item / nblk, nb = item % nblk, k0 = 64 * kb, n0 = 32 * nb;
    {   float wv[32];
#pragma unroll
        for (int i = 0; i < 32; ++i) wv[i] = W[(size_t)(k0 + 2 * i + (lane >> 5)) * ldw + c0 + n0 + (lane & 31)];
        __builtin_amdgcn_sched_barrier(0);
#pragma unroll
        for (int i = 0; i < 32; ++i) { const int kk = 2 * i + (lane >> 5); const float sc = kscale ? kscale[k0 + kk] : 1.0f; scr[kk * 33 + (lane & 31)] = wv[i] * sc; } }
    LDS_WAIT(); asm volatile("" ::: "memory");
    const int c = lane & 7;
#pragma unroll
    for (int j = 0; j < 4; ++j) { const int n = (lane >> 3) + 8 * j; const LAS float* s = scr + (8 * c) * 33 + n;
        v4u o; o.x = pk2(s[0 * 33], s[1 * 33]); o.y = pk2(s[2 * 33], s[3 * 33]); o.z = pk2(s[4 * 33], s[5 * 33]); o.w = pk2(s[6 * 33], s[7 * 33]);
        *(v4u*)(WT + (size_t)(r0 + n0 + n) * K + k0 + 8 * c) = o; }
    LDS_WAIT(); asm volatile("" ::: "memory");
}
__device__ __forceinline__ void tr_matrix(Frame& F, const float* W, int ldw, int c0, int K, bf16* WT, int r0, int ncols, int wg0 = 0, const float* kscale = nullptr) {
    LAS float* scr = (LAS float*)(F.lds + RING_OFF + F.wave * 16384);
    const int gw = (F.bx - wg0) * NWAVES + F.wave, NGW = (F.G - wg0) * NWAVES, nblk = ncols / 32, nitems = (K / 64) * nblk;
    for (int it = gw; it < nitems; it += NGW) tr_item(W, ldw, c0, K, WT, r0, nblk, scr, it, F.lane, kscale);
}

template <bool GBV, bool SRC16>
__device__ __forceinline__ void rms_rows(Frame& F, const void* hsrcv, const float* lnw, bf16* HN, float* GB) {
    const float* hsrc = (const float*)hsrcv; const bf16* hsrc16 = (const bf16*)hsrcv;
    const int gw = F.bx * NWAVES + F.wave, NGW = F.G * NWAVES, lane = F.lane;
    const LAS float* wabT = (const LAS float*)(F.lds + RING_OFF);
    f32x4 lw[8];
#pragma unroll
    for (int j = 0; j < 8; ++j) lw[j] = ((const f32x4*)lnw)[lane + 64 * j];
    for (int pi = gw; pi < M_TOK / 2; pi += NGW) {
        f32x4 y[2][8];
        if (SRC16) { v2u w_[2][8];
#pragma unroll
            for (int r = 0; r < 2; ++r)
#pragma unroll
                for (int j = 0; j < 8; ++j) w_[r][j] = ((const v2u*)(hsrc16 + ((size_t)2 * pi + r) * DM))[lane + 64 * j];
            __builtin_amdgcn_sched_barrier(0);
#pragma unroll
            for (int r = 0; r < 2; ++r)
#pragma unroll
                for (int j = 0; j < 8; ++j) y[r][j] = (f32x4){bflo(w_[r][j].x), bfhi(w_[r][j].x), bflo(w_[r][j].y), bfhi(w_[r][j].y)};
        } else {
#pragma unroll
            for (int r = 0; r < 2; ++r)
#pragma unroll
                for (int j = 0; j < 8; ++j) y[r][j] = ((const f32x4*)(hsrc + ((size_t)2 * pi + r) * DM))[lane + 64 * j];
            __builtin_amdgcn_sched_barrier(0);
        }
#pragma unroll
        for (int r = 0; r < 2; ++r) {
            const size_t row = (size_t)2 * pi + r;
            float ss = 0.f;
#pragma unroll
            for (int j = 0; j < 8; ++j) ss += (y[r][j].x * y[r][j].x + y[r][j].y * y[r][j].y) + (y[r][j].z * y[r][j].z + y[r][j].w * y[r][j].w);
            ss = wave_sum(ss);
            const float rstd = 1.0f / sqrtf(ss * (1.0f / DM) + RMS_EPS);
            v2u* dst = (v2u*)(HN + row * DM) + lane;
#pragma unroll
            for (int j = 0; j < 8; ++j) { y[r][j] = y[r][j] * rstd * lw[j];
                v2u o; o.x = pkbf(y[r][j].x, y[r][j].y); o.y = pkbf(y[r][j].z, y[r][j].w); dst[64 * j] = o; }
        }
        if (GBV) {
            float keep0 = 0.f, keep1 = 0.f;
#pragma unroll 1
            for (int c = 0; c < 16; ++c) {
                float a0 = 0.f, a1 = 0.f;
                const LAS f32x4* wp = (const LAS f32x4*)(wabT + c * DM) + lane;
#pragma unroll
                for (int j = 0; j < 8; ++j) { const f32x4 w = wp[64 * j];
                    a0 += (y[0][j].x * w.x + y[0][j].y * w.y) + (y[0][j].z * w.z + y[0][j].w * w.w);
                    a1 += (y[1][j].x * w.x + y[1][j].y * w.y) + (y[1][j].z * w.z + y[1][j].w * w.w); }
                a0 = wave_sum(a0); a1 = wave_sum(a1);
                if (lane == c) { keep0 = a0; keep1 = a1; }
            }
            if (lane < 16) { GB[((size_t)2 * pi) * 16 + lane] = keep0; GB[((size_t)2 * pi + 1) * 16 + lane] = keep1; }
        }
    }
}

__device__ __forceinline__ void convert_w_in(Frame& F, int layer, int wg0) {
    const int j = layer >> 1; bf16* dst = (layer & 1) ? (bf16*)(F.ws + WS_WIN2) : F.WIN;
    if ((layer & 1) == 0) { const float* w = F.in[10] + (size_t)j * DM * EV_IN_W;
        tr_matrix(F, w, EV_IN_W, 0, DM, dst, 0, 4096, wg0); tr_matrix(F, w, EV_IN_W, 4112, DM, dst, 4096, 2048, wg0);
    } else tr_matrix(F, F.in[23] + (size_t)j * DM * NPROJ, NPROJ, 0, DM, dst, 0, NPROJ, wg0);
}
__device__ __forceinline__ void convert_w_rest(Frame& F, int layer, int wg0) {
    const int j = layer >> 1;
    tr_matrix(F, ((layer & 1) ? F.in[24] : F.in[11]) + (size_t)j * DM * DM, DM, 0, DM, F.WOUT, 0, DM, wg0);
    tr_matrix(F, F.in[5] + (size_t)layer * DM * DFF, DFF, 0, DM, F.WUP, 0, DFF, wg0, F.in[3] + (size_t)layer * DM);
    tr_matrix(F, F.in[6] + (size_t)layer * DFF * DM, DM, 0, DFF, F.WDOWN, 0, DM, wg0);
    tr_matrix(F, F.in[8] + (size_t)layer * DM * DM, DM, 0, DM, F.WGATE, 0, DM, wg0, F.in[4] + (size_t)layer * DM);
}
__device__ __forceinline__ void phase_t1(Frame& F, int layer) {
    const int j = layer >> 1; const bool even = (layer & 1) == 0;
    if (layer == 0) convert_w_in(F, 0, 0);
    tr_matrix(F, F.in[7] + (size_t)layer * PLE * DM, DM, 0, PLE, F.WPP, 0, DM);
    if (even) {
        bf16* WLT = (bf16*)(F.ws + WS_WLT); const float* wa = F.in[18] + (size_t)j * 8 * 128 * 128; const float* wx = F.in[20] + (size_t)j * 8 * 128 * 128;
        for (int i = F.bx * 512 + F.tid; i < 8 * 256 * 16; i += F.G * 512) { const int o = i & 255, gi = i >> 8; const int gg = gi >> 4, in0 = (gi & 15) * 8;
            const float* src = (o < 128 ? wa : wx) + ((size_t)gg * 128 + in0) * 128 + (o & 127);
            v4u w; w.x = pk2(src[0], src[128]); w.y = pk2(src[256], src[384]); w.z = pk2(src[512], src[640]); w.w = pk2(src[768], src[896]);
            *(v4u*)(WLT + ((size_t)gg * 256 + o) * 128 + in0) = w; }
    }
    {
        const f32x4* src = (const f32x4*)(F.in[1] + (size_t)layer * M_TOK * PLE);
        const size_t n8 = (size_t)M_TOK * PLE / 8, stride = (size_t)F.G * 512;
        for (size_t i = (size_t)F.bx * 512 + F.tid; i < n8; i += 4 * stride) { f32x4 a[4], b[4];
#pragma unroll
            for (int u = 0; u < 4; ++u) { a[u] = src[2 * (i + u * stride)]; b[u] = src[2 * (i + u * stride) + 1]; }
            __builtin_amdgcn_sched_barrier(0);
#pragma unroll
            for (int u = 0; u < 4; ++u) { v4u o; o.x = pkbf(a[u].x, a[u].y); o.y = pkbf(a[u].z, a[u].w); o.z = pkbf(b[u].x, b[u].y); o.w = pkbf(b[u].z, b[u].w); ((v4u*)F.PB)[i + u * stride] = o; } }
    }
    const void* hsrc = (layer == 0) ? (const void*)F.in[0] : (const void*)F.H16;
    const float* lnw = F.in[2] + (size_t)layer * DM;
    if (even) {
        __syncthreads();
        LAS float* wabT = (LAS float*)(F.lds + RING_OFF);
        const float* w = F.in[10] + (size_t)j * DM * EV_IN_W + 4096;
        for (int i = F.tid; i < 16 * DM; i += 512) { const int k = i >> 4, c = i & 15; wabT[c * DM + k] = w[(size_t)k * EV_IN_W + c]; }
        __syncthreads();
        if (layer == 0) rms_rows<true, false>(F, hsrc, lnw, F.HN, F.GB); else rms_rows<true, true>(F, hsrc, lnw, F.HN, F.GB);
        __syncthreads();
    } else rms_rows<false, true>(F, hsrc, lnw, F.HN, nullptr);
}

__device__ __forceinline__ void lru_carry(Frame& F, int id) {
    const int b = id >> 10, ch = id & 1023;
    const f32x2* LSUM = (const f32x2*)(F.ws + WS_LSUM) + (size_t)b * 128 * 1024 + ch; float* LCIN = (float*)(F.ws + WS_LCIN) + (size_t)b * 128 * 1024 + ch;
    float carry = 0.f;
    for (int t0 = 0; t0 < 128; t0 += 8) { f32x2 s[8];
#pragma unroll
        for (int i = 0; i < 8; ++i) s[i] = LSUM[(size_t)(t0 + i) * 1024];
#pragma unroll
        for (int i = 0; i < 8; ++i) { LCIN[(size_t)(t0 + i) * 1024] = carry; carry = s[i].x * carry + s[i].y; } }
}

__device__ __forceinline__ void lru_final(Frame& F) {
    const bf16* HL = F.HN; const bf16* PC = F.HN + (size_t)M_TOK * 1024; const bf16* PROJ = F.BIG; const float* LCIN = (const float*)(F.ws + WS_LCIN);
    const size_t n8 = (size_t)M_TOK * 1024 / 8, stride = (size_t)F.G * 512;
    for (size_t i = (size_t)F.bx * 512 + F.tid; i < n8; i += stride) {
        const size_t m = i >> 7; const int c0 = (int)(i & 127) * 8; const size_t tile = m >> 6;
        const v4u hw = *(const v4u*)(HL + m * 1024 + c0), pw = *(const v4u*)(PC + m * 1024 + c0), yw = *(const v4u*)(PROJ + m * NPROJ + 5120 + c0);
        const f32x4 ca = *(const f32x4*)(LCIN + tile * 1024 + c0), cb = *(const f32x4*)(LCIN + tile * 1024 + c0 + 4); __builtin_amdgcn_sched_barrier(0);
        v4u o;
        o.x = pk2((bflo(hw.x) + bflo(pw.x) * ca.x) * gelu_tanh(bflo(yw.x)), (bfhi(hw.x) + bfhi(pw.x) * ca.y) * gelu_tanh(bfhi(yw.x)));
        o.y = pk2((bflo(hw.y) + bflo(pw.y) * ca.z) * gelu_tanh(bflo(yw.y)), (bfhi(hw.y) + bfhi(pw.y) * ca.w) * gelu_tanh(bfhi(yw.y)));
        o.z = pk2((bflo(hw.z) + bflo(pw.z) * cb.x) * gelu_tanh(bflo(yw.z)), (bfhi(hw.z) + bfhi(pw.z) * cb.y) * gelu_tanh(bfhi(yw.z)));
        o.w = pk2((bflo(hw.w) + bflo(pw.w) * cb.z) * gelu_tanh(bflo(yw.w)), (bfhi(hw.w) + bfhi(pw.w) * cb.w) * gelu_tanh(bfhi(yw.w)));
        *(v4u*)(F.MIX + m * DM + 1024 + c0) = o;
    }
}

__device__ __forceinline__ void dn_final(Frame& F, int j) {
    const int gw = F.bx * NWAVES + F.wave, NGW = F.G * NWAVES, lane = F.lane; const int h = lane >> 3, c0 = (lane & 7) * 16;
    const bf16* PROJ = F.BIG; const float* nw = F.in[15] + j * 128 + c0;
    float wv[16];
#pragma unroll
    for (int i = 0; i < 4; ++i) { const f32x4 w4 = *(const f32x4*)(nw + 4 * i); wv[4 * i] = w4.x; wv[4 * i + 1] = w4.y; wv[4 * i + 2] = w4.z; wv[4 * i + 3] = w4.w; }
    for (int m = gw; m < M_TOK; m += NGW) {
        v4u* op = (v4u*)(F.MIX + (size_t)m * DM + h * 128 + c0); const v4u* zp = (const v4u*)(PROJ + (size_t)m * NPROJ + 3072 + h * 128 + c0);
        const v4u o0 = op[0], o1 = op[1], z0 = zp[0], z1 = zp[1]; __builtin_amdgcn_sched_barrier(0);
        float o[16], z[16]; unpack8(o0, o); unpack8(o1, o + 8); unpack8(z0, z); unpack8(z1, z + 8);
        float ss = 0.f;
#pragma unroll
        for (int i = 0; i < 16; ++i) ss += o[i] * o[i];
        ss = row8_sum(ss); const float r = 1.0f / sqrtf(ss * (1.0f / 128.0f) + RMS_EPS);
#pragma unroll
        for (int i = 0; i < 16; ++i) o[i] = o[i] * r * wv[i] * siluf_(z[i]);
        op[0] = pack8(o); op[1] = pack8(o + 8);
    }
}
typedef short bf16x8 __attribute__((ext_vector_type(8)));
typedef short s16x4 __attribute__((ext_vector_type(4)));
typedef float f32x16 __attribute__((ext_vector_type(16)));
#define MFMA32(a, b, c) __builtin_amdgcn_mfma_f32_32x32x16_bf16((a), (b), (c), 0, 0, 0)
#define TR16(p) __builtin_amdgcn_ds_read_tr16_b64_v4i16((LAS s16x4*)(p))
__device__ __forceinline__ bf16x8 pack_acc8(const f32x16& x, int s) {
    v4u p; p.x = pkbf(x[8 * s + 0], x[8 * s + 1]); p.y = pkbf(x[8 * s + 2], x[8 * s + 3]); p.z = pkbf(x[8 * s + 4], x[8 * s + 5]); p.w = pkbf(x[8 * s + 6], x[8 * s + 7]);
    return __builtin_bit_cast(bf16x8, p);
}
__device__ __forceinline__ v4u scale8(v4u x, float sc) {
    v4u o; o.x = pkbf(bflo(x.x) * sc, bfhi(x.x) * sc); o.y = pkbf(bflo(x.y) * sc, bfhi(x.y) * sc); o.z = pkbf(bflo(x.z) * sc, bfhi(x.z) * sc); o.w = pkbf(bflo(x.w) * sc, bfhi(x.w) * sc); return o;
}
constexpr int RT_QS = 272, RT_VS = 320, RT_S8 = 264;
constexpr int RT_QL = 0, RT_KL = 64 * RT_QS, RT_QD = 2 * 64 * RT_QS, RT_KT = RT_QD + 64 * RT_S8, RT_VL = RT_KT + 64 * RT_VS, RT_VSC = RT_VL + 64 * RT_VS;
__device__ __forceinline__ void ret_chunk(Frame& F, int wg) {
    const int tid = F.tid, lane = F.lane, wave = F.wave;
    const int bh = wg >> 1, b = bh >> 2, h = bh & 3, half = wg & 1;
    const bf16* PROJ = F.BIG; float* ORET = (float*)F.HN;
    LAS unsigned char* L = F.lds + RING_OFF;
    const float lg = log2f(1.0f - exp2f(-5.0f - (float)h));
    const float g64 = exp2f(64.0f * lg);
    const int r = lane & 31, hh = lane >> 5, q4 = (lane & 15) >> 2, p4 = lane & 3, cb = (lane >> 4) & 1;
    const int srow = (tid & 255) >> 4, sch = tid & 15;
    v4u pq[2][4], pk[2][4], pv[2][4];
    const size_t mrow0 = (size_t)b * SEQ;
#define RT_ISSUE(SET_, n_) do { _Pragma("unroll") for (int u = 0; u < 4; ++u) { const bf16* rp = PROJ + (mrow0 + (size_t)(n_) * 64 + srow + 16 * u) * NPROJ; \
            pq[SET_][u] = *(const v4u*)(rp + 3072 + h * 128 + sch * 8); pk[SET_][u] = *(const v4u*)(rp + 3584 + h * 128 + sch * 8); pv[SET_][u] = *(const v4u*)(rp + 4096 + h * 256 + half * 128 + sch * 8); } } while (0)
#define RT_COMMIT_A(SET_) do { _Pragma("unroll") for (int u = 0; u < 4; ++u) { const int row = srow + 16 * u; \
            *(LAS v4u*)(L + RT_QL + row * RT_QS + sch * 16) = pq[SET_][u]; *(LAS v4u*)(L + RT_KL + row * RT_QS + sch * 16) = pk[SET_][u]; } } while (0)
#define RT_COMMIT_B(SET_) do { _Pragma("unroll") for (int u = 0; u < 4; ++u) { const int row = srow + 16 * u; \
            { const v4u qd_ = scale8(pq[SET_][u], exp2f((float)(row + 1) * lg)); *(LAS v2u*)(L + RT_QD + row * RT_S8 + sch * 16) = (v2u){qd_.x, qd_.y}; *(LAS v2u*)(L + RT_QD + row * RT_S8 + sch * 16 + 8) = (v2u){qd_.z, qd_.w}; } \
            *(LAS v4u*)(L + RT_KT + row * RT_VS + sch * 16) = pk[SET_][u]; \
            *(LAS v4u*)(L + RT_VL + row * RT_VS + sch * 16) = pv[SET_][u]; \
            *(LAS v4u*)(L + RT_VSC + row * RT_VS + sch * 16) = scale8(pv[SET_][u], exp2f((float)(63 - row) * lg) * SC128); } } while (0)
    f32x16 S[4];
#pragma unroll
    for (int t = 0; t < 4; ++t)
#pragma unroll
        for (int e = 0; e < 16; ++e) S[t][e] = 0.f;
    if (wave >= 4) {
        RT_ISSUE(0, 0); RT_COMMIT_A(0); RT_COMMIT_B(0); RT_ISSUE(1, 1); RT_ISSUE(0, 2);
        LDS_BARRIER();
        for (int n = 0; n < SEQ / 64; n += 2) {
            LDS_BARRIER(); RT_COMMIT_A(1);
            LDS_BARRIER(); RT_COMMIT_B(1); if (n + 3 < SEQ / 64) RT_ISSUE(1, n + 3);
            LDS_BARRIER(); if (n + 2 < SEQ / 64) RT_COMMIT_A(0);
            LDS_BARRIER(); if (n + 2 < SEQ / 64) { RT_COMMIT_B(0); if (n + 4 < SEQ / 64) RT_ISSUE(0, n + 4); }
        }
    } else {
    __builtin_amdgcn_s_setprio(3);
    LDS_BARRIER();
    for (int n = 0; n < SEQ / 64; ++n) {
        {
            const int w = wave;
            f32x16 pt00, pt01, pt11;
#pragma unroll
            for (int e = 0; e < 16; ++e) { pt00[e] = 0.f; pt01[e] = 0.f; pt11[e] = 0.f; }
#pragma unroll
            for (int s = 0; s < 8; ++s) {
                const bf16x8 k0 = *(const LAS bf16x8*)(L + RT_KL + r * RT_QS + (16 * s + 8 * hh) * 2), k1 = *(const LAS bf16x8*)(L + RT_KL + (32 + r) * RT_QS + (16 * s + 8 * hh) * 2);
                const bf16x8 q0 = *(const LAS bf16x8*)(L + RT_QL + r * RT_QS + (16 * s + 8 * hh) * 2), q1 = *(const LAS bf16x8*)(L + RT_QL + (32 + r) * RT_QS + (16 * s + 8 * hh) * 2);
                pt00 = MFMA32(k0, q0, pt00); pt01 = MFMA32(k0, q1, pt01); pt11 = MFMA32(k1, q1, pt11);
            }
            LDS_BARRIER();
#pragma unroll
            for (int e = 0; e < 16; ++e) { const int jr = (e & 3) + 8 * (e >> 2) + 4 * hh;
                const int dd = r - jr;
                const float fd = dd >= 0 ? exp2f((float)dd * lg) * SC128 : 0.f;
                pt00[e] *= fd; pt11[e] *= fd; pt01[e] *= exp2f((float)(dd + 32) * lg) * SC128; }
            f32x16 o0, o1;
#pragma unroll
            for (int e = 0; e < 16; ++e) { o0[e] = 0.f; o1[e] = 0.f; }
            const LAS unsigned char* vb = L + RT_VL + (4 * hh + q4) * RT_VS + (32 * w + 16 * cb + 4 * p4) * 2;
#pragma unroll
            for (int s = 0; s < 2; ++s) {
                const s16x4 l0 = TR16(vb + (16 * s) * RT_VS), h0 = TR16(vb + (16 * s + 8) * RT_VS);
                const bf16x8 v0 = __builtin_shufflevector(l0, h0, 0, 1, 2, 3, 4, 5, 6, 7);
                const s16x4 l1 = TR16(vb + (32 + 16 * s) * RT_VS), h1 = TR16(vb + (32 + 16 * s + 8) * RT_VS);
                const bf16x8 v1 = __builtin_shufflevector(l1, h1, 0, 1, 2, 3, 4, 5, 6, 7);
                o0 = MFMA32(pack_acc8(pt00, s), v0, o0);
                o1 = MFMA32(pack_acc8(pt01, s), v0, o1);
                o1 = MFMA32(pack_acc8(pt11, s), v1, o1);
            }
#pragma unroll
            for (int t = 0; t < 4; ++t)
#pragma unroll
                for (int s = 0; s < 2; ++s) {
                    const bf16x8 sb = pack_acc8(S[t], s);
                    const LAS unsigned char* qa = L + RT_QD + r * RT_S8 + (32 * t + 16 * s + 4 * hh) * 2;
                    const s16x4 a0l = *(const LAS s16x4*)(qa), a0h = *(const LAS s16x4*)(qa + 16);
                    const s16x4 a1l = *(const LAS s16x4*)(qa + 32 * RT_S8), a1h = *(const LAS s16x4*)(qa + 32 * RT_S8 + 16);
                    o0 = MFMA32(__builtin_shufflevector(a0l, a0h, 0, 1, 2, 3, 4, 5, 6, 7), sb, o0);
                    o1 = MFMA32(__builtin_shufflevector(a1l, a1h, 0, 1, 2, 3, 4, 5, 6, 7), sb, o1);
                }
            {   float* op = ORET + (mrow0 + (size_t)n * 64) * 1024 + h * 256 + half * 128 + 32 * w + r;
#pragma unroll
                for (int e = 0; e < 16; ++e) { const int ir = (e & 3) + 8 * (e >> 2) + 4 * hh; op[(size_t)ir * 1024] = o0[e]; op[(size_t)(32 + ir) * 1024] = o1[e]; } }
#pragma unroll
            for (int t = 0; t < 4; ++t)
#pragma unroll
                for (int e = 0; e < 16; ++e) S[t][e] *= g64;
            const LAS unsigned char* kb = L + RT_KT + (8 * hh + q4) * RT_VS + (16 * cb + 4 * p4) * 2;
            const LAS unsigned char* sb2 = L + RT_VSC + (8 * hh + q4) * RT_VS + (32 * w + 16 * cb + 4 * p4) * 2;
#pragma unroll
            for (int sp = 0; sp < 4; ++sp) {
                const s16x4 bl = TR16(sb2 + (16 * sp) * RT_VS), bhh = TR16(sb2 + (16 * sp + 4) * RT_VS);
                const bf16x8 bv = __builtin_shufflevector(bl, bhh, 0, 1, 2, 3, 4, 5, 6, 7);
#pragma unroll
                for (int t = 0; t < 4; ++t) {
                    const s16x4 al = TR16(kb + (16 * sp) * RT_VS + 64 * t), ah = TR16(kb + (16 * sp + 4) * RT_VS + 64 * t);
                    S[t] = MFMA32(__builtin_shufflevector(al, ah, 0, 1, 2, 3, 4, 5, 6, 7), bv, S[t]);
                }
            }
        }
        LDS_BARRIER();
    }
    __builtin_amdgcn_s_setprio(0);
    }
#undef RT_ISSUE
#undef RT_COMMIT_A
#undef RT_COMMIT_B
}

constexpr int LG_XA = 0, LG_XF = 64 * 272, LG_LA = LG_XF + 64 * 132 * 4, LG_SUM = LG_LA + 64 * 132 * 4;
__device__ __forceinline__ void lru_gates_mfma(Frame& F, int j) {
    const int lane = F.lane, wave = F.wave; const int r = lane & 31, hh = lane >> 5;
    const bf16* PROJ = F.BIG; bf16* HL = F.HN; bf16* PC = F.HN + (size_t)M_TOK * 1024; f32x2* LSUM = (f32x2*)(F.ws + WS_LSUM);
    LAS unsigned char* L = F.lds + RING_OFF; LAS float* XF = (LAS float*)(L + LG_XF); LAS float* LA = (LAS float*)(L + LG_LA); LAS f32x2* SUMS = (LAS f32x2*)(L + LG_SUM);
    const int g = F.bx & 7; const int it = wave & 1, ct = wave >> 1;
    const bf16* WLT = (const bf16*)(F.ws + WS_WLT) + (size_t)g * 256 * 128;
    const float* convw = F.in[16] + (size_t)j * 4 * 1024 + g * 128; const float* convb = F.in[17] + (size_t)j * 1024 + g * 128;
    bf16x8 waf[8], wxf[8];
#pragma unroll
    for (int s = 0; s < 8; ++s) { waf[s] = *(const bf16x8*)(WLT + (32 * ct + r) * 128 + 16 * s + 8 * hh); wxf[s] = *(const bf16x8*)(WLT + (128 + 32 * ct + r) * 128 + 16 * s + 8 * hh); }
    const int chl = 32 * ct + r, chg = g * 128 + chl;
    const float ba_c = F.in[19][(size_t)j * 1024 + chg], bx_c = F.in[21][(size_t)j * 1024 + chg], sp8 = 8.0f * softplusf_(-F.in[22][(size_t)j * 1024 + chg]);
    for (int tile = F.bx >> 3; tile < M_TOK / 64; tile += F.G >> 3) {
        const int m0 = tile * 64;
        int tid = F.tid; asm volatile("" : "+v"(tid));
        {   const int tok = tid >> 3, c0 = (tid & 7) * 16; const int m = m0 + tok, t = m & (SEQ - 1);
            float a[16];
#pragma unroll
            for (int i = 0; i < 4; ++i) { const f32x4 b4 = *(const f32x4*)(convb + c0 + 4 * i); a[4 * i] = b4.x; a[4 * i + 1] = b4.y; a[4 * i + 2] = b4.z; a[4 * i + 3] = b4.w; }
            v4u xq[4][2];
#pragma unroll
            for (int jj = 0; jj < 4; ++jj) { const bool ok = (t - 3 + jj) >= 0; const v4u* xp = (const v4u*)(PROJ + (size_t)(ok ? m - 3 + jj : m) * NPROJ + 4096 + g * 128 + c0); xq[jj][0] = xp[0]; xq[jj][1] = xp[1]; }
            __builtin_amdgcn_sched_barrier(0);
#pragma unroll
            for (int jj = 0; jj < 4; ++jj) { const float fz = (t - 3 + jj) >= 0 ? 1.0f : 0.0f; const v4u x0 = xq[jj][0], x1 = xq[jj][1];
                const unsigned xw[8] = {x0.x, x0.y, x0.z, x0.w, x1.x, x1.y, x1.z, x1.w};
#pragma unroll
                for (int i = 0; i < 4; ++i) { const f32x4 w4 = *(const f32x4*)(convw + jj * 1024 + c0 + 4 * i) * fz;
                    a[4 * i] += w4.x * bflo(xw[2 * i]); a[4 * i + 1] += w4.y * bfhi(xw[2 * i]); a[4 * i + 2] += w4.z * bflo(xw[2 * i + 1]); a[4 * i + 3] += w4.w * bfhi(xw[2 * i + 1]); } }
            v4u w0, w1; w0.x = pkbf(a[0], a[1]); w0.y = pkbf(a[2], a[3]); w0.z = pkbf(a[4], a[5]); w0.w = pkbf(a[6], a[7]); w1.x = pkbf(a[8], a[9]); w1.y = pkbf(a[10], a[11]); w1.z = pkbf(a[12], a[13]); w1.w = pkbf(a[14], a[15]);
            *(LAS v4u*)(L + LG_XA + tok * 272 + c0 * 2) = w0; *(LAS v4u*)(L + LG_XA + tok * 272 + c0 * 2 + 16) = w1;
#pragma unroll
            for (int i = 0; i < 4; ++i) *(LAS f32x4*)(XF + tok * 132 + c0 + 4 * i) = (f32x4){a[4 * i], a[4 * i + 1], a[4 * i + 2], a[4 * i + 3]};
        }
        LDS_BARRIER();
        {   f32x16 aa, ax;
#pragma unroll
            for (int e = 0; e < 16; ++e) { aa[e] = 0.f; ax[e] = 0.f; }
#pragma unroll
            for (int s = 0; s < 8; ++s) { const bf16x8 af = *(const LAS bf16x8*)(L + LG_XA + (32 * it + r) * 272 + (16 * s + 8 * hh) * 2); aa = MFMA32(af, waf[s], aa); ax = MFMA32(af, wxf[s], ax); }
#pragma unroll
            for (int e = 0; e < 16; ++e) { const int tok = 32 * it + (e & 3) + 8 * (e >> 2) + 4 * hh;
                const float rr = sigmoidf_(aa[e] + ba_c), ii = sigmoidf_(ax[e] + bx_c); const float la = -rr * sp8; const float x = XF[tok * 132 + chl];
                LA[tok * 132 + chl] = la; XF[tok * 132 + chl] = sqrtf(neg_expm1f_(2.0f * la)) * (ii * x); }
        }
        LDS_BARRIER();
        {
            const int ch = tid & 127, seg = tid >> 7; float hl[16], pl[16]; float hs = 0.f, pr = 1.f;
#pragma unroll
            for (int k = 0; k < 16; ++k) { const int tok = 16 * seg + k; const float a = __expf(LA[tok * 132 + ch]); hs = a * hs + XF[tok * 132 + ch]; pr *= a; hl[k] = hs; pl[k] = pr; }
            SUMS[seg * 128 + ch] = (f32x2){pr, hs};
            LDS_BARRIER();
            float carry = 0.f, pp = 1.f;
            for (int s2 = 0; s2 < seg; ++s2) { const f32x2 sv = SUMS[s2 * 128 + ch]; carry = sv.x * carry + sv.y; pp *= sv.x; }
            bf16* hp = HL + (size_t)(m0 + 16 * seg) * 1024 + g * 128 + ch; bf16* pq = PC + (size_t)(m0 + 16 * seg) * 1024 + g * 128 + ch;
#pragma unroll
            for (int k = 0; k < 16; ++k) { hp[(size_t)k * 1024] = (bf16)f2bf(hl[k] + pl[k] * carry); pq[(size_t)k * 1024] = (bf16)f2bf(pl[k] * pp); }
            if (seg == 3) LSUM[(size_t)tile * 1024 + g * 128 + ch] = (f32x2){pl[15] * pp, hl[15] + pl[15] * carry};
        }
        LDS_BARRIER();
    }
}

constexpr int DP_KH = 0, DP_QH = 64 * 272, DP_KB = 2 * 64 * 272, DP_VB = DP_KB + 64 * 320, DP_MT = DP_VB + 64 * 320, DP_TL = DP_MT + 64 * 272, DP_SC = DP_TL + 64 * 144, DP_CW = DP_SC + 1024;
static_assert(DP_CW + 4 * 3072 * 4 <= LDSCTL_OFF, "DeltaNet prep LDS map");
__device__ __forceinline__ void dn_chunk_prep(Frame& F, int j, int n_lo, int n_hi, int wg0) {
    const int wave = F.wave;
    const bf16* PROJ = F.BIG;
    bf16* NWg = F.BIG + (size_t)M_TOK * NPROJ; bf16* QDg = NWg + (size_t)M_TOK * 1024; bf16* KDg = F.PPB; bf16* Ug = F.PPB + (size_t)M_TOK * 1024;
    bf16* QKg = (bf16*)(F.ws + WS_DQK); float* GTg = (float*)(F.ws + WS_DGT);
    const float* cw = F.in[12] + (size_t)j * 4 * 3072; const float* a_log = F.in[13] + j * 8; const float* dtb = F.in[14] + j * 8;
    LAS unsigned char* L = F.lds + RING_OFF;
    LAS float* Mt = (LAS float*)(L + DP_MT);
    LAS float* bet = (LAS float*)(L + DP_SC); LAS float* gl = bet + 64; LAS float* gcl = gl + 64;
    LAS float* cwl = (LAS float*)(L + DP_CW);
    {   f32x4 wq[6];
#pragma unroll
        for (int u = 0; u < 6; ++u) wq[u] = *(const f32x4*)(cw + 4 * (F.tid + 512 * u));
#pragma unroll
        for (int u = 0; u < 6; ++u) *(LAS f32x4*)(cwl + 4 * (F.tid + 512 * u)) = wq[u]; }
    v4u rg[7];
#define DP_RAWLOAD(idx_, tidp_) do { const int bh_ = (idx_) & 31, n_ = n_lo + ((idx_) >> 5); const size_t m0_ = (size_t)(bh_ >> 3) * SEQ + (size_t)n_ * 64; const int h_ = bh_ & 7; \
        _Pragma("unroll") for (int u = 0; u < 7; ++u) { const int id = (tidp_) + 512 * u; const int row = id / 48, ch = id - row * 48; rg[u] = (v4u){0u, 0u, 0u, 0u}; \
            if (id < 67 * 48 && (n_ > 0 || row >= 3)) rg[u] = *(const v4u*)(PROJ + (m0_ + row - 3) * NPROJ + (ch >> 4) * 1024 + h_ * 128 + (ch & 15) * 8); } } while (0)
    if (F.bx - wg0 < 32 * (n_hi - n_lo)) { int tp = F.tid; asm volatile("" : "+v"(tp)); DP_RAWLOAD(F.bx - wg0, tp); }
    for (int idx = F.bx - wg0; idx < 32 * (n_hi - n_lo); idx += F.G - wg0) {
        const int bh = idx & 31, n = n_lo + (idx >> 5); const int chunk = bh * 128 + n; const int b = bh >> 3, h = bh & 7;
        int tid = F.tid; asm volatile("" : "+v"(tid));
        const int lane = tid & 63; const int r = lane & 31, hh = lane >> 5, q4 = (lane & 15) >> 2, p4 = lane & 3, cb = (lane >> 4) & 1;
        const size_t m0 = (size_t)b * SEQ + (size_t)n * 64;
        const int tok = tid >> 3, c0 = (tid & 7) * 16; const size_t m = m0 + tok; const int t = (int)(m & (SEQ - 1));
        float qv[16], kv[16], vv[16];
        LDS_BARRIER();
        {   LAS unsigned char* raw = L + DP_KB;
#pragma unroll
            for (int u = 0; u < 7; ++u) { const int id = tid + 512 * u; const int row = id / 48, ch = id - row * 48; if (id < 67 * 48) *(LAS v4u*)(raw + row * 784 + ch * 16) = rg[u]; }
            LDS_BARRIER();
#pragma unroll
            for (int ten = 0; ten < 3; ++ten) {
                float a[16];
#pragma unroll
                for (int i = 0; i < 16; ++i) a[i] = 0.f;
                const int col = ten * 1024 + h * 128 + c0;
#pragma unroll 2
                for (int jj = 0; jj < 4; ++jj) { const LAS v4u* xp = (const LAS v4u*)(raw + (tok + jj) * 784 + ten * 256 + c0 * 2); const v4u x0 = xp[0], x1 = xp[1];
                    const unsigned xw[8] = {x0.x, x0.y, x0.z, x0.w, x1.x, x1.y, x1.z, x1.w};
#pragma unroll
                    for (int i = 0; i < 4; ++i) { const f32x4 w4 = *(const LAS f32x4*)(cwl + jj * 3072 + col + 4 * i);
                        a[4 * i] += w4.x * bflo(xw[2 * i]); a[4 * i + 1] += w4.y * bfhi(xw[2 * i]); a[4 * i + 2] += w4.z * bflo(xw[2 * i + 1]); a[4 * i + 3] += w4.w * bfhi(xw[2 * i + 1]); } }
#pragma unroll
                for (int i = 0; i < 16; ++i) { const float s = siluf_(a[i]); if (ten == 0) qv[i] = s; else if (ten == 1) kv[i] = s; else vv[i] = s; }
            }
        }
        {   float sq = 0.f, sk = 0.f;
#pragma unroll
            for (int i = 0; i < 16; ++i) { sq += qv[i] * qv[i]; sk += kv[i] * kv[i]; }
            sq += __shfl_xor(sq, 1); sq += __shfl_xor(sq, 2); sq += __shfl_xor(sq, 4);
            sk += __shfl_xor(sk, 1); sk += __shfl_xor(sk, 2); sk += __shfl_xor(sk, 4);
            const float fq = SC128 / sqrtf(sq + 1e-6f), fk = 1.0f / sqrtf(sk + 1e-6f);
#pragma unroll
            for (int i = 0; i < 16; ++i) { qv[i] *= fq; kv[i] *= fk; } }
        LDS_BARRIER();
        if ((tid & 7) == 0) { const float braw = F.GB[m * 16 + h], araw = F.GB[m * 16 + 8 + h];
            bet[tok] = sigmoidf_(braw); gl[tok] = -expf(a_log[h]) * softplusf_(araw + dtb[h]); }
        {
            v4u w0, w1;
            w0.x = pkbf(kv[0], kv[1]); w0.y = pkbf(kv[2], kv[3]); w0.z = pkbf(kv[4], kv[5]); w0.w = pkbf(kv[6], kv[7]); w1.x = pkbf(kv[8], kv[9]); w1.y = pkbf(kv[10], kv[11]); w1.z = pkbf(kv[12], kv[13]); w1.w = pkbf(kv[14], kv[15]);
            *(LAS v4u*)(L + DP_KH + tok * 272 + c0 * 2) = w0; *(LAS v4u*)(L + DP_KH + tok * 272 + c0 * 2 + 16) = w1;
            w0.x = pkbf(qv[0], qv[1]); w0.y = pkbf(qv[2], qv[3]); w0.z = pkbf(qv[4], qv[5]); w0.w = pkbf(qv[6], qv[7]); w1.x = pkbf(qv[8], qv[9]); w1.y = pkbf(qv[10], qv[11]); w1.z = pkbf(qv[12], qv[13]); w1.w = pkbf(qv[14], qv[15]);
            *(LAS v4u*)(L + DP_QH + tok * 272 + c0 * 2) = w0; *(LAS v4u*)(L + DP_QH + tok * 272 + c0 * 2 + 16) = w1; }
        LDS_BARRIER();
        if (wave == 0) { float v = gl[lane];
#pragma unroll
            for (int o = 1; o < 64; o <<= 1) { const float u = __shfl_up(v, o); if (lane >= o) v += u; }
            gcl[lane] = v; }
        LDS_BARRIER();
        {
            const float gct = gcl[tok], gclast = gcl[63], bt = bet[tok]; const float eg = __expf(gct), egl = __expf(gclast - gct), kbs = bt * eg;
            v4u w0, w1;
#define DP_PACK16(arr, sc) do { w0.x = pkbf(arr[0] * (sc), arr[1] * (sc)); w0.y = pkbf(arr[2] * (sc), arr[3] * (sc)); w0.z = pkbf(arr[4] * (sc), arr[5] * (sc)); w0.w = pkbf(arr[6] * (sc), arr[7] * (sc)); \
            w1.x = pkbf(arr[8] * (sc), arr[9] * (sc)); w1.y = pkbf(arr[10] * (sc), arr[11] * (sc)); w1.z = pkbf(arr[12] * (sc), arr[13] * (sc)); w1.w = pkbf(arr[14] * (sc), arr[15] * (sc)); } while (0)
            DP_PACK16(qv, eg); { v4u* gp = (v4u*)(QDg + m * 1024 + h * 128 + c0); gp[0] = w0; gp[1] = w1; }
            DP_PACK16(kv, egl); { v4u* gp = (v4u*)(KDg + m * 1024 + h * 128 + c0); gp[0] = w0; gp[1] = w1; }
            DP_PACK16(kv, kbs); *(LAS v4u*)(L + DP_KB + tok * 320 + c0 * 2) = w0; *(LAS v4u*)(L + DP_KB + tok * 320 + c0 * 2 + 16) = w1;
            DP_PACK16(vv, bt); *(LAS v4u*)(L + DP_VB + tok * 320 + c0 * 2) = w0; *(LAS v4u*)(L + DP_VB + tok * 320 + c0 * 2 + 16) = w1;
#undef DP_PACK16
            if (tid == 0) GTg[chunk] = __expf(gclast);
        }
        if (wave < 3) { const int it = wave == 0 ? 0 : 1, jt = wave == 2 ? 1 : 0;
            f32x16 acc;
#pragma unroll
            for (int e = 0; e < 16; ++e) acc[e] = 0.f;
#pragma unroll
            for (int s = 0; s < 8; ++s) { const bf16x8 a = *(const LAS bf16x8*)(L + DP_KH + (32 * it + r) * 272 + (16 * s + 8 * hh) * 2), bb = *(const LAS bf16x8*)(L + DP_KH + (32 * jt + r) * 272 + (16 * s + 8 * hh) * 2);
                acc = MFMA32(a, bb, acc); }
            const int jg = 32 * jt + r; const float gcj = gcl[jg];
#pragma unroll
            for (int g4 = 0; g4 < 4; ++g4) { f32x4 o;
#pragma unroll
                for (int e = 0; e < 4; ++e) { const int ig = 32 * it + 8 * g4 + 4 * hh + e; o[e] = ig > jg ? bet[ig] * acc[4 * g4 + e] * __expf(gcl[ig] - gcj) : 0.f; }
                *(LAS f32x4*)(Mt + jg * 68 + 32 * it + 8 * g4 + 4 * hh) = o; }
        } else if (wave == 3) {
#pragma unroll
            for (int g4 = 0; g4 < 4; ++g4) *(LAS f32x4*)(Mt + (32 + r) * 68 + 8 * g4 + 4 * hh) = (f32x4){0.f, 0.f, 0.f, 0.f};
        } else if (wave < 7) { const int jt = wave == 6 ? 1 : 0, it = wave == 4 ? 0 : 1;
            f32x16 acc;
#pragma unroll
            for (int e = 0; e < 16; ++e) acc[e] = 0.f;
#pragma unroll
            for (int s = 0; s < 8; ++s) { const bf16x8 a = *(const LAS bf16x8*)(L + DP_KH + (32 * jt + r) * 272 + (16 * s + 8 * hh) * 2), bb = *(const LAS bf16x8*)(L + DP_QH + (32 * it + r) * 272 + (16 * s + 8 * hh) * 2);
                acc = MFMA32(a, bb, acc); }
            const int ig = 32 * it + r; const float gci = gcl[ig];
#pragma unroll
            for (int g4 = 0; g4 < 4; ++g4) { float o[4];
#pragma unroll
                for (int e = 0; e < 4; ++e) { const int jg = 32 * jt + 8 * g4 + 4 * hh + e; o[e] = ig >= jg ? acc[4 * g4 + e] * __expf(gci - gcl[jg]) : 0.f; }
                v2u w; w.x = pkbf(o[0], o[1]); w.y = pkbf(o[2], o[3]);
                *(v2u*)(QKg + (size_t)chunk * 4096 + ig * 64 + 32 * jt + 8 * g4 + 4 * hh) = w; }
        }
        LDS_BARRIER();
        { const int nidx = idx + F.G - wg0; if (nidx < 32 * (n_hi - n_lo)) DP_RAWLOAD(nidx, tid); }
        if (wave == 0) {
            int ln = lane; asm volatile("" : "+v"(ln));
            const LAS float* MtO; { unsigned mo = (unsigned)(size_t)Mt; asm volatile("" : "+v"(mo)); MtO = (const LAS float*)(size_t)mo; }
            float tr[64];
#pragma unroll
            for (int k = 0; k < 64; ++k) tr[k] = (k == ln) ? 1.f : 0.f;
#pragma unroll
            for (int jc = 62; jc >= 0; --jc) {
                float s0 = 0.f, s1 = 0.f, s2 = 0.f, s3 = 0.f;
#pragma unroll
                for (int k4 = ((jc + 1) & ~3); k4 < 64; k4 += 4) { const f32x4 mv = *(const LAS f32x4*)(MtO + jc * 68 + k4);
                    s0 += tr[k4] * mv.x; s1 += tr[k4 + 1] * mv.y; s2 += tr[k4 + 2] * mv.z; s3 += tr[k4 + 3] * mv.w; }
                tr[jc] -= (s0 + s1) + (s2 + s3);
                asm volatile("" : "+v"(tr[jc]));
            }
#pragma unroll
            for (int k8 = 0; k8 < 8; ++k8) { v4u w; w.x = pkbf(tr[8 * k8], tr[8 * k8 + 1]); w.y = pkbf(tr[8 * k8 + 2], tr[8 * k8 + 3]); w.z = pkbf(tr[8 * k8 + 4], tr[8 * k8 + 5]); w.w = pkbf(tr[8 * k8 + 6], tr[8 * k8 + 7]);
                *(LAS v4u*)(L + DP_TL + ln * 144 + k8 * 16) = w; }
        }
        LDS_BARRIER();
#pragma unroll
        for (int jb = 0; jb < 2; ++jb) { const int job = 2 * wave + jb; const int mat = job >> 3, ft = (job >> 1) & 3, it = job & 1;
            f32x16 acc;
#pragma unroll
            for (int e = 0; e < 16; ++e) acc[e] = 0.f;
            const LAS unsigned char* rb = L + (mat ? DP_VB : DP_KB) + (8 * hh + q4) * 320 + (32 * ft + 16 * cb + 4 * p4) * 2;
#pragma unroll
            for (int s = 0; s < 4; ++s) { const s16x4 al = TR16(rb + (16 * s) * 320), ah = TR16(rb + (16 * s + 4) * 320);
                const bf16x8 tb = *(const LAS bf16x8*)(L + DP_TL + (32 * it + r) * 144 + (16 * s + 8 * hh) * 2);
                acc = MFMA32(__builtin_shufflevector(al, ah, 0, 1, 2, 3, 4, 5, 6, 7), tb, acc); }
            const float sg = mat ? 1.f : -1.f; bf16* dst = (mat ? Ug : NWg) + (m0 + 32 * it + r) * 1024 + h * 128 + 32 * ft + 4 * hh;
#pragma unroll
            for (int g4 = 0; g4 < 4; ++g4) { v2u w; w.x = pkbf(sg * acc[4 * g4], sg * acc[4 * g4 + 1]); w.y = pkbf(sg * acc[4 * g4 + 2], sg * acc[4 * g4 + 3]); *(v2u*)(dst + 8 * g4) = w; }
        }
    }
}
#undef DP_RAWLOAD

constexpr int DR_S8 = 264, DR_ST = 320, DR_SQ = 136;
constexpr int DR_NW = 0, DR_QD = 64 * DR_S8, DR_KD = 2 * 64 * DR_S8, DR_QK = DR_KD + 64 * DR_ST, DR_U = DR_QK + 64 * DR_SQ;
constexpr int DN_C1 = 40, DN_C2 = 84;
__device__ __forceinline__ void dn_chunk_recur(Frame& F, int wg, int n_lo, int n_hi) {
    const int tid = F.tid, lane = F.lane, wave = F.wave; const int b = wg >> 3, h = wg & 7;
    const bf16* NWg = F.BIG + (size_t)M_TOK * NPROJ; const bf16* QDg = NWg + (size_t)M_TOK * 1024; const bf16* KDg = F.PPB; const bf16* Ug = F.PPB + (size_t)M_TOK * 1024;
    const bf16* QKg = (const bf16*)(F.ws + WS_DQK) + (size_t)wg * 128 * 4096; const float* GTg = (const float*)(F.ws + WS_DGT) + wg * 128;
    LAS unsigned char* L = F.lds + RING_OFF;
    const int r = lane & 31, hh = lane >> 5, q4 = (lane & 15) >> 2, p4 = lane & 3, cb = (lane >> 4) & 1;
    const size_t mrow0 = (size_t)b * SEQ;
    const int srow = (tid & 255) >> 4, sch = tid & 15;
    v4u pa[2][4], pb[2][4], pc[2][4], pd[2][4], pe[2][2];
#define DR_ISSUE(SET_, n_) do { _Pragma("unroll") for (int u = 0; u < 4; ++u) { const size_t o = (mrow0 + (size_t)(n_) * 64 + srow + 16 * u) * 1024 + h * 128 + sch * 8; \
            pa[SET_][u] = *(const v4u*)(NWg + o); pb[SET_][u] = *(const v4u*)(QDg + o); pc[SET_][u] = *(const v4u*)(KDg + o); pd[SET_][u] = *(const v4u*)(Ug + o); } \
        _Pragma("unroll") for (int u = 0; u < 2; ++u) pe[SET_][u] = *(const v4u*)(QKg + (size_t)(n_) * 4096 + ((tid & 255) + 256 * u) * 8); } while (0)
#define DR_COMMIT_A(SET_) do { _Pragma("unroll") for (int u = 0; u < 4; ++u) { const int row = srow + 16 * u; \
            *(LAS v2u*)(L + DR_NW + row * DR_S8 + sch * 16) = (v2u){pa[SET_][u].x, pa[SET_][u].y}; *(LAS v2u*)(L + DR_NW + row * DR_S8 + sch * 16 + 8) = (v2u){pa[SET_][u].z, pa[SET_][u].w}; \
            *(LAS v2u*)(L + DR_QD + row * DR_S8 + sch * 16) = (v2u){pb[SET_][u].x, pb[SET_][u].y}; *(LAS v2u*)(L + DR_QD + row * DR_S8 + sch * 16 + 8) = (v2u){pb[SET_][u].z, pb[SET_][u].w}; \
            *(LAS v4u*)(L + DR_U + row * DR_ST + sch * 16) = pd[SET_][u]; } } while (0)
#define DR_COMMIT_B(SET_) do { _Pragma("unroll") for (int u = 0; u < 4; ++u) { const int row = srow + 16 * u; *(LAS v4u*)(L + DR_KD + row * DR_ST + sch * 16) = pc[SET_][u]; } \
        _Pragma("unroll") for (int u = 0; u < 2; ++u) { const int id = (tid & 255) + 256 * u; *(LAS v2u*)(L + DR_QK + (id >> 3) * DR_SQ + (id & 7) * 16) = (v2u){pe[SET_][u].x, pe[SET_][u].y}; *(LAS v2u*)(L + DR_QK + (id >> 3) * DR_SQ + (id & 7) * 16 + 8) = (v2u){pe[SET_][u].z, pe[SET_][u].w}; } } while (0)
    if (wave >= 4) {
        DR_ISSUE(0, n_lo); DR_COMMIT_A(0); DR_COMMIT_B(0); DR_ISSUE(1, n_lo + 1); if (n_lo + 2 < n_hi) DR_ISSUE(0, n_lo + 2);
        LDS_BARRIER();
        for (int n = n_lo; n < n_hi; n += 2) {
            LDS_BARRIER(); DR_COMMIT_A(1);
            LDS_BARRIER(); DR_COMMIT_B(1); if (n + 3 < n_hi) DR_ISSUE(1, n + 3);
            LDS_BARRIER(); if (n + 2 < n_hi) DR_COMMIT_A(0);
            LDS_BARRIER(); if (n + 2 < n_hi) { DR_COMMIT_B(0); if (n + 4 < n_hi) DR_ISSUE(0, n + 4); }
        }
    } else {
        __builtin_amdgcn_s_setprio(3);
        const int w = wave;
        f32x16 S[4];
        float* ssave = (float*)(F.ws + WS_LSUM) + (size_t)1024 * 1024 + ((size_t)(wg * 4 + w) * 64) * 64 + lane;
#pragma unroll
        for (int t = 0; t < 4; ++t)
#pragma unroll
            for (int e = 0; e < 16; ++e) S[t][e] = n_lo > 0 ? ssave[(t * 16 + e) * 64] : 0.f;
        const float gtl = GTg[lane], gth = GTg[64 + lane];
        LDS_BARRIER();
        for (int n = n_lo; n < n_hi; ++n) {
            const float gt = __int_as_float(__builtin_amdgcn_readlane(__float_as_int(n < 64 ? gtl : gth), n & 63));
#define DR_AFR(dst_, base_) do { const LAS unsigned char* p_ = (base_); const s16x4 l0_ = *(const LAS s16x4*)(p_), h0_ = *(const LAS s16x4*)(p_ + 16), l1_ = *(const LAS s16x4*)(p_ + 32 * DR_S8), h1_ = *(const LAS s16x4*)(p_ + 32 * DR_S8 + 16); \
                dst_[0] = __builtin_shufflevector(l0_, h0_, 0, 1, 2, 3, 4, 5, 6, 7); dst_[1] = __builtin_shufflevector(l1_, h1_, 0, 1, 2, 3, 4, 5, 6, 7); } while (0)
            const LAS unsigned char* wbase = L + DR_NW + r * DR_S8 + (4 * hh) * 2; const LAS unsigned char* qbase = L + DR_QD + r * DR_S8 + (4 * hh) * 2;
            bf16x8 fw[2][2], fq[2][2];
            DR_AFR(fw[0], wbase); DR_AFR(fq[0], qbase);
            f32x16 vn0, vn1;
            {   const LAS unsigned char* ub = L + DR_U + (4 * hh + q4) * DR_ST + (32 * w + 16 * cb + 4 * p4) * 2;
                s16x4 u0[4], u1[4];
#pragma unroll
                for (int g4 = 0; g4 < 4; ++g4) { u0[g4] = TR16(ub + (8 * g4) * DR_ST); u1[g4] = TR16(ub + (32 + 8 * g4) * DR_ST); }
#pragma unroll
                for (int g4 = 0; g4 < 4; ++g4)
#pragma unroll
                    for (int e = 0; e < 4; ++e) { vn0[4 * g4 + e] = bf2f((bf16)u0[g4][e]); vn1[4 * g4 + e] = bf2f((bf16)u1[g4][e]); } }
            f32x16 o0, o1;
#pragma unroll
            for (int e = 0; e < 16; ++e) { o0[e] = 0.f; o1[e] = 0.f; }
#pragma unroll
            for (int i = 0; i < 8; ++i) { const int t = i >> 1, s = i & 1;
                if (i + 1 < 8) { const int off = (32 * ((i + 1) >> 1) + 16 * ((i + 1) & 1)) * 2; DR_AFR(fw[(i + 1) & 1], wbase + off); DR_AFR(fq[(i + 1) & 1], qbase + off); }
                const bf16x8 sbv = pack_acc8(S[t], s);
                __builtin_amdgcn_sched_barrier(0);
                vn0 = MFMA32(fw[i & 1][0], sbv, vn0); vn1 = MFMA32(fw[i & 1][1], sbv, vn1);
                o0 = MFMA32(fq[i & 1][0], sbv, o0); o1 = MFMA32(fq[i & 1][1], sbv, o1);
                __builtin_amdgcn_sched_barrier(0);
            }
            LDS_BARRIER();
            bf16x8 qk00[2], qk10[2], qk11[2];
#pragma unroll
            for (int s = 0; s < 2; ++s) { const LAS unsigned char* ka = L + DR_QK + r * DR_SQ + (16 * s + 4 * hh) * 2;
                const s16x4 a00l = *(const LAS s16x4*)(ka), a00h = *(const LAS s16x4*)(ka + 16), a10l = *(const LAS s16x4*)(ka + 32 * DR_SQ), a10h = *(const LAS s16x4*)(ka + 32 * DR_SQ + 16), a11l = *(const LAS s16x4*)(ka + 32 * DR_SQ + 64), a11h = *(const LAS s16x4*)(ka + 32 * DR_SQ + 64 + 16);
                qk00[s] = __builtin_shufflevector(a00l, a00h, 0, 1, 2, 3, 4, 5, 6, 7); qk10[s] = __builtin_shufflevector(a10l, a10h, 0, 1, 2, 3, 4, 5, 6, 7); qk11[s] = __builtin_shufflevector(a11l, a11h, 0, 1, 2, 3, 4, 5, 6, 7); }
            const LAS unsigned char* kb = L + DR_KD + (4 * hh + q4) * DR_ST + (16 * cb + 4 * p4) * 2;
            bf16x8 fk[2][4];
#define DR_KFR(dst_, jt_, s_) do { _Pragma("unroll") for (int t_ = 0; t_ < 4; ++t_) { const s16x4 al_ = TR16(kb + (32 * (jt_) + 16 * (s_)) * DR_ST + 64 * t_), ah_ = TR16(kb + (32 * (jt_) + 16 * (s_) + 8) * DR_ST + 64 * t_); \
                dst_[t_] = __builtin_shufflevector(al_, ah_, 0, 1, 2, 3, 4, 5, 6, 7); } } while (0)
            DR_KFR(fk[0], 0, 0);
            bf16x8 vb[2][2];
#pragma unroll
            for (int s = 0; s < 2; ++s) { vb[0][s] = pack_acc8(vn0, s); vb[1][s] = pack_acc8(vn1, s); }
#pragma unroll
            for (int t = 0; t < 4; ++t)
#pragma unroll
                for (int e = 0; e < 16; ++e) S[t][e] *= gt;
            __builtin_amdgcn_sched_barrier(0);
#pragma unroll
            for (int s = 0; s < 2; ++s) { o0 = MFMA32(qk00[s], vb[0][s], o0); o1 = MFMA32(qk10[s], vb[0][s], o1); o1 = MFMA32(qk11[s], vb[1][s], o1); }
#pragma unroll
            for (int i = 0; i < 4; ++i) { const int jt = i >> 1, s = i & 1;
                if (i + 1 < 4) DR_KFR(fk[(i + 1) & 1], (i + 1) >> 1, (i + 1) & 1);
                __builtin_amdgcn_sched_barrier(0);
#pragma unroll
                for (int t = 0; t < 4; ++t) S[t] = MFMA32(fk[i & 1][t], vb[jt][s], S[t]);
                __builtin_amdgcn_sched_barrier(0);
            }
            {   bf16* op = F.MIX + (mrow0 + (size_t)n * 64) * DM + h * 128 + 32 * w + r;
#pragma unroll
                for (int e = 0; e < 16; ++e) { const int ir = (e & 3) + 8 * (e >> 2) + 4 * hh; op[(size_t)ir * DM] = (bf16)(pkbf(o0[e], 0.f) & 0xffffu); op[(size_t)(32 + ir) * DM] = (bf16)(pkbf(o1[e], 0.f) & 0xffffu); } }
#undef DR_AFR
#undef DR_KFR
            LDS_BARRIER();
        }
        if (n_hi < SEQ / 64) {
#pragma unroll
            for (int t = 0; t < 4; ++t)
#pragma unroll
                for (int e = 0; e < 16; ++e) ssave[(t * 16 + e) * 64] = S[t][e];
        }
        __builtin_amdgcn_s_setprio(0);
    }
#undef DR_ISSUE
#undef DR_COMMIT_A
#undef DR_COMMIT_B
}

constexpr int SWA_VSTRIDE = 288;
__device__ __forceinline__ void swa_mfma(Frame& F) {
    const int wave = F.wave;
    const bf16* PROJ = F.BIG;
    bf16* OB[3] = {F.PPB, F.PPB + (size_t)M_TOK * 1024, F.BIG + (size_t)M_TOK * NPROJ};
    float* LSE = (float*)(F.BIG + (size_t)M_TOK * NPROJ + (size_t)M_TOK * 1024);
    LAS unsigned char* vl = F.lds + RING_OFF;
    LAS unsigned char* kl = vl + 272 * SWA_VSTRIDE;
    for (int unit = F.bx - 32; unit < 32 * 192; unit += F.G - 32) {
        int tid = F.tid; asm volatile("" : "+v"(tid));
        const int lane = tid & 63; const int li = lane & 15, g = lane >> 4;
        const int bh = unit / 192, rem = unit - bh * 192; const int br = rem >> 6, blk = rem & 63;
        const int b = bh >> 3, h = bh & 7; const int dsh = 2 * br, d = 1 << dsh; const int nper = 64 >> dsh; const int r = blk / nper, n = blk - r * nper;
        const size_t rowbase = (size_t)b * SEQ + r;
        const int sub0 = 128 * n - 144;
        LDS_BARRIER();
        {   v4u kreg[9], vreg[9];
#pragma unroll
            for (int u = 0; u < 9; ++u) { const int id = tid + 512 * u; const int row = id >> 4, ch = id & 15; const int ks = sub0 + row; kreg[u] = (v4u){0u, 0u, 0u, 0u}; vreg[u] = (v4u){0u, 0u, 0u, 0u};
                if (id < 272 * 16 && ks >= 0) { const bf16* rp = PROJ + (rowbase + (size_t)ks * d) * NPROJ + h * 128 + ch * 8; kreg[u] = *(const v4u*)(rp + 1024); vreg[u] = *(const v4u*)(rp + 2048); } }
#pragma unroll
            for (int u = 0; u < 9; ++u) { const int id = tid + 512 * u; const int row = id >> 4, ch = id & 15;
                if (id < 272 * 16) { *(LAS v4u*)(kl + row * 272 + ch * 16) = kreg[u]; *(LAS v4u*)(vl + row * SWA_VSTRIDE + ch * 16) = vreg[u]; } }
        }
        LDS_BARRIER();
        const int q0w = 128 * n + 16 * wave;
        const size_t mq = rowbase + (size_t)(q0w + li) * d;
        bf16x8 qf[4];
        { const bf16* qp = PROJ + mq * NPROJ + h * 128 + 8 * g;
#pragma unroll
          for (int s = 0; s < 4; ++s) qf[s] = *(const bf16x8*)(qp + 32 * s); }
        f32x4 sacc[10];
        {   const LAS unsigned char* kbase = kl + (16 * wave + li) * 272 + 16 * g;
#pragma unroll
            for (int kt = 0; kt < 10; ++kt) { f32x4 acc = (f32x4){0.f, 0.f, 0.f, 0.f};
#pragma unroll
                for (int s = 0; s < 4; ++s) { const bf16x8 kf = *(const LAS bf16x8*)(kbase + (16 * kt) * 272 + 64 * s); acc = __builtin_amdgcn_mfma_f32_16x16x32_bf16(kf, qf[s], acc, 0, 0, 0); }
                sacc[kt] = acc; }
        }
        const float slope_d = exp2f(-(float)(h + 1)) * (float)d;
        float mx = -INFINITY;
#pragma unroll
        for (int kt = 0; kt < 10; ++kt)
#pragma unroll
            for (int e = 0; e < 4; ++e) { const int rel = 144 + li - 16 * kt - 4 * g - e; const bool valid = (rel >= 0) && (rel <= 128) && (q0w + li - rel >= 0);
                const float sv = valid ? sacc[kt][e] * SC128 - slope_d * (float)rel : -INFINITY; sacc[kt][e] = sv; mx = fmaxf(mx, sv); }
        mx = fmaxf(mx, __shfl_xor(mx, 16)); mx = fmaxf(mx, __shfl_xor(mx, 32));
        float l = 0.f;
#pragma unroll
        for (int kt = 0; kt < 10; ++kt)
#pragma unroll
            for (int e = 0; e < 4; ++e) { const float p = __expf(sacc[kt][e] - mx); sacc[kt][e] = p; l += p; }
        l += __shfl_xor(l, 16); l += __shfl_xor(l, 32);
        f32x4 oacc[8];
#pragma unroll
        for (int dt = 0; dt < 8; ++dt) oacc[dt] = (f32x4){0.f, 0.f, 0.f, 0.f};
        const LAS unsigned char* vbase = vl + (16 * wave + 4 * g + (li >> 2)) * SWA_VSTRIDE + (li & 3) * 8;
#pragma unroll
        for (int sp = 0; sp < 5; ++sp) {
            v4u pw; pw.x = pk2(sacc[2 * sp][0], sacc[2 * sp][1]); pw.y = pk2(sacc[2 * sp][2], sacc[2 * sp][3]); pw.z = pk2(sacc[2 * sp + 1][0], sacc[2 * sp + 1][1]); pw.w = pk2(sacc[2 * sp + 1][2], sacc[2 * sp + 1][3]);
            const bf16x8 pf = __builtin_bit_cast(bf16x8, pw);
#pragma unroll
            for (int dt = 0; dt < 8; ++dt) {
                const s16x4 lo = __builtin_amdgcn_ds_read_tr16_b64_v4i16((LAS s16x4*)(vbase + (32 * sp) * SWA_VSTRIDE + dt * 32));
                const s16x4 hi = __builtin_amdgcn_ds_read_tr16_b64_v4i16((LAS s16x4*)(vbase + (32 * sp + 16) * SWA_VSTRIDE + dt * 32));
                const bf16x8 af = __builtin_shufflevector(lo, hi, 0, 1, 2, 3, 4, 5, 6, 7);
                oacc[dt] = __builtin_amdgcn_mfma_f32_16x16x32_bf16(af, pf, oacc[dt], 0, 0, 0);
            }
        }
        const float il = 1.0f / l;
        bf16* op = OB[br] + mq * 1024 + h * 128 + 4 * g;
#pragma unroll
        for (int dt = 0; dt < 8; ++dt) { v2u w; w.x = pk2(oacc[dt][0] * il, oacc[dt][1] * il); w.y = pk2(oacc[dt][2] * il, oacc[dt][3] * il); *(v2u*)(op + 16 * dt) = w; }
        if (g == 0) LSE[((size_t)br * M_TOK + mq) * 8 + h] = mx + __logf(l);
    }
}

__device__ __forceinline__ void swa_merge(Frame& F) {
    const int gw = F.bx * NWAVES + F.wave, NGW = F.G * NWAVES, lane = F.lane; const int h = lane >> 3, c0 = (lane & 7) * 16;
    const bf16* OB0 = F.PPB; const bf16* OB1 = F.PPB + (size_t)M_TOK * 1024; const bf16* OB2 = F.BIG + (size_t)M_TOK * NPROJ;
    const float* LSE = (const float*)(F.BIG + (size_t)M_TOK * NPROJ + (size_t)M_TOK * 1024);
    for (int m = gw; m < M_TOK; m += NGW) {
        const size_t o = (size_t)m * 1024 + h * 128 + c0;
        const v4u a0 = *(const v4u*)(OB0 + o), a1 = *(const v4u*)(OB0 + o + 8), b0 = *(const v4u*)(OB1 + o), b1 = *(const v4u*)(OB1 + o + 8), c0v = *(const v4u*)(OB2 + o), c1v = *(const v4u*)(OB2 + o + 8);
        const float l0 = LSE[((size_t)0 * M_TOK + m) * 8 + h], l1 = LSE[((size_t)1 * M_TOK + m) * 8 + h], l2 = LSE[((size_t)2 * M_TOK + m) * 8 + h]; __builtin_amdgcn_sched_barrier(0);
        const float mx = fmaxf(l0, fmaxf(l1, l2)); float e0 = __expf(l0 - mx), e1 = __expf(l1 - mx), e2 = __expf(l2 - mx); const float inv = 1.0f / (e0 + e1 + e2); e0 *= inv; e1 *= inv; e2 *= inv;
        float x[16], y[16], z[16]; unpack8(a0, x); unpack8(a1, x + 8); unpack8(b0, y); unpack8(b1, y + 8); unpack8(c0v, z); unpack8(c1v, z + 8);
#pragma unroll
        for (int i = 0; i < 16; ++i) x[i] = e0 * x[i] + e1 * y[i] + e2 * z[i];
        v4u* dst = (v4u*)(F.MIX + (size_t)m * DM + h * 128 + c0); dst[0] = pack8(x); dst[1] = pack8(x + 8);
    }
}

__device__ __forceinline__ void ret_final(Frame& F) {
    const int gw = F.bx * NWAVES + F.wave, NGW = F.G * NWAVES, lane = F.lane; const int h = lane >> 4, c0 = (lane & 15) * 16;
    const float* ORET = (const float*)F.HN; const bf16* PROJ = F.BIG;
    for (int m = gw; m < M_TOK; m += NGW) {
        const f32x4* xp = (const f32x4*)(ORET + (size_t)m * 1024 + h * 256 + c0); const v4u* gp = (const v4u*)(PROJ + (size_t)m * NPROJ + 5120 + h * 256 + c0);
        const f32x4 x0 = xp[0], x1 = xp[1], x2 = xp[2], x3 = xp[3]; const v4u g0 = gp[0], g1 = gp[1]; __builtin_amdgcn_sched_barrier(0);
        float x[16] = {x0.x, x0.y, x0.z, x0.w, x1.x, x1.y, x1.z, x1.w, x2.x, x2.y, x2.z, x2.w, x3.x, x3.y, x3.z, x3.w}; float g[16]; unpack8(g0, g); unpack8(g1, g + 8);
        float s = 0.f;
#pragma unroll
        for (int i = 0; i < 16; ++i) s += x[i];
        const float mu = row16_sum(s) * (1.0f / 256.0f); float q = 0.f;
#pragma unroll
        for (int i = 0; i < 16; ++i) { x[i] -= mu; q += x[i] * x[i]; }
        const float r = 1.0f / sqrtf(row16_sum(q) * (1.0f / 256.0f) + GN_EPS);
#pragma unroll
        for (int i = 0; i < 16; ++i) x[i] = x[i] * r * siluf_(g[i]);
        v4u* dst = (v4u*)(F.MIX + (size_t)m * DM + 1024 + h * 256 + c0); dst[0] = pack8(x); dst[1] = pack8(x + 8);
    }
}
__device__ __forceinline__ void final_norm(Frame& F) {
    const int gw = F.bx * NWAVES + F.wave, NGW = F.G * NWAVES, lane = F.lane; const float* lnw = F.in[9];
    float* tmp = (float*)F.HN;
    f32x4 lw[8];
#pragma unroll
    for (int j = 0; j < 8; ++j) lw[j] = ((const f32x4*)lnw)[lane + 64 * j];
    for (int rp = gw; rp < M_TOK / 2; rp += NGW) {
        v2u w_[2][8];
#pragma unroll
        for (int r = 0; r < 2; ++r)
#pragma unroll
            for (int j = 0; j < 8; ++j) w_[r][j] = ((const v2u*)(F.H16 + ((size_t)2 * rp + r) * DM))[lane + 64 * j];
        __builtin_amdgcn_sched_barrier(0);
#pragma unroll
        for (int r = 0; r < 2; ++r) { const int row = 2 * rp + r; f32x4 v[8]; float ss = 0.f;
#pragma unroll
            for (int j = 0; j < 8; ++j) { v[j] = (f32x4){bflo(w_[r][j].x), bfhi(w_[r][j].x), bflo(w_[r][j].y), bfhi(w_[r][j].y)}; ss += (v[j].x * v[j].x + v[j].y * v[j].y) + (v[j].z * v[j].z + v[j].w * v[j].w); }
            ss = wave_sum(ss); const float rstd = 1.0f / sqrtf(ss * (1.0f / DM) + RMS_EPS);
            f32x4* o = (f32x4*)(F.out + (size_t)row * DM) + lane; (void)tmp;
#pragma unroll
            for (int j = 0; j < 8; ++j) o[64 * j] = v[j] * rstd * lw[j]; }
    }
}
__device__ __forceinline__ void final_copy(Frame& F) {
    const f32x4* src = (const f32x4*)F.HN; f32x4* dst = (f32x4*)(F.out + (size_t)(M_TOK / 2) * DM);
    const size_t n4 = (size_t)(M_TOK / 2) * DM / 4, stride = (size_t)F.G * 512;
    for (size_t i = (size_t)F.bx * 512 + F.tid; i < n4; i += 8 * stride) { f32x4 t_[8];
#pragma unroll
        for (int u = 0; u < 8; ++u) t_[u] = src[i + u * stride];
        __builtin_amdgcn_sched_barrier(0);
#pragma unroll
        for (int u = 0; u < 8; ++u) dst[i + u * stride] = t_[u]; }
}

#ifndef REP_T1
#define REP_T1 1
#endif
#ifndef REP_G1
#define REP_G1 1
#endif
#ifndef REP_EM1
#define REP_EM1 1
#endif
#ifndef REP_EM2
#define REP_EM2 1
#endif
#ifndef REP_OM1
#define REP_OM1 1
#endif
#ifndef REP_T2
#define REP_T2 1
#endif
#ifndef REP_G3
#define REP_G3 1
#endif
#ifndef REP_PP
#define REP_PP 1
#endif
#define REPEAT(n_) _Pragma("unroll 1") for (int rep_ = 0; rep_ < (n_); ++rep_)
#define REFRESH_F() do { int t_ = threadIdx.x; asm volatile("" : "+v"(t_)); F.tid = t_; F.lane = t_ & 63; F.wave = __builtin_amdgcn_readfirstlane(t_ >> 6); int b_ = blockIdx.x; asm volatile("" : "+s"(b_)); F.bx = b_; } while (0)
constexpr int PH_PER_LAYER = 11, NPH = DEPTH * PH_PER_LAYER + 2;
__global__ void __launch_bounds__(NWAVES * 64, 2) trunk_fwd(Args args) {
    extern __shared__ __attribute__((aligned(16))) unsigned char lds_raw[];
    Frame F;
    F.lds = (LAS unsigned char*)lds_raw;
    F.tid = threadIdx.x; F.lane = F.tid & 63; F.wave = __builtin_amdgcn_readfirstlane(F.tid >> 6);
    F.G = gridDim.x; F.bx = blockIdx.x;
    F.in = args.in; F.out = args.out;
    unsigned char* ws = args.ws; F.ws = ws; F.H16 = (bf16*)(ws + WS_PP2);
    F.PP2 = (bf16*)((unsigned char*)args.out + (size_t)M_TOK * DM * 2);
    F.WIN = (bf16*)(ws + WS_WIN); F.WOUT = (bf16*)(ws + WS_WOUT); F.WUP = (bf16*)(ws + WS_WUP); F.WDOWN = (bf16*)(ws + WS_WDOWN); F.WGATE = (bf16*)(ws + WS_WGATE); F.WPP = (bf16*)(ws + WS_WPP);
    F.PB = (bf16*)(ws + WS_PB); F.GB = (float*)(ws + WS_GB); F.HN = (bf16*)(ws + WS_HN); F.MIX = (bf16*)(ws + WS_MIX); F.BIG = (bf16*)(ws + WS_BIG); F.PPB = (bf16*)(ws + WS_PPB);
    for (int u = F.tid; u < (LDS_BYTES - LDSCTL_OFF) / 4; u += NWAVES * 64) ((LAS unsigned*)(F.lds + LDSCTL_OFF))[u] = 0u;
    __syncthreads();
    const int lo = args.ph_lo, hi = args.ph_hi;
    XcdBarrier bar; bar.bar = (unsigned*)(ws + WS_CTL) + CW_BAR; bar.x = 0; bar.st = nullptr;
    if (hi - lo > 1) bar = xcd_barrier_post((unsigned*)(ws + WS_CTL) + CW_BAR, (volatile LAS unsigned*)(F.lds + MISC_OFF) + 8);
#define IN(k) (lo <= (k) && (k) < hi)
#ifdef REP_BAR
#define SEAM(k) do { if (IN(k) && IN((k) + 1)) { xcd_barrier(bar); xcd_barrier(bar); } } while (0)
#else
#define SEAM(k) do { if (IN(k) && IN((k) + 1)) xcd_barrier(bar); } while (0)
#endif
    LAS unsigned char* ring = F.lds + RING_OFF;

    for (int layer = 0; layer < LAYER_HI; ++layer) {
        const int P = layer * PH_PER_LAYER; const int j = layer >> 1; const bool even = (layer & 1) == 0;
        { int t_ = threadIdx.x; asm volatile("" : "+v"(t_)); F.tid = t_; F.lane = t_ & 63; F.wave = __builtin_amdgcn_readfirstlane(t_ >> 6); int b_ = blockIdx.x; asm volatile("" : "+s"(b_)); F.bx = b_; }
        if (IN(P + 0)) { REPEAT(REP_T1) { phase_t1(F, layer); __syncthreads(); } } SEAM(P + 0);
        if (IN(P + 1)) REPEAT(REP_G1) { pg8::Gemm g{F.HN, even ? F.WIN : (bf16*)(F.ws + WS_WIN2), M_TOK, NPROJ, DM}; pg8::StaticOrder S; S.init(M_TOK, NPROJ, F.G, F.bx);
            pg8::EpiB16<0> E{F.BIG, NPROJ, nullptr}; pg8::gemm_phase<pg8::EpiB16<0>, pg8::StaticOrder, true, true>(ring, g, S, E); } SEAM(P + 1);
        if (IN(P + 2)) {
            if (even) {
 REPEAT(REP_EM1) { REFRESH_F(); dn_chunk_prep(F, j, 0, DN_C1, 0); __syncthreads(); lru_gates_mfma(F, j); __syncthreads(); }
 }
            else {
 REPEAT(REP_OM1) { REFRESH_F(); if (F.bx < 32) ret_chunk(F, F.bx); else { swa_mfma(F); __syncthreads(); { pg8::Gemm g{F.PB, F.WPP, M_TOK, DM, PLE}; pg8::StaticOrder S; S.init(M_TOK, DM, F.G - 32, F.bx - 32); pg8::EpiB16<0> E{F.PP2, DM, nullptr}; pg8::gemm_phase<pg8::EpiB16<0>, pg8::StaticOrder, true, true>(ring, g, S, E); } __syncthreads(); convert_w_rest(F, layer, 32); if (layer + 1 < DEPTH) convert_w_in(F, layer + 1, 32); } __syncthreads(); }
 }
        } SEAM(P + 2);
        if (IN(P + 3)) {
            if (even) {
 { int lo = 0, mid = DN_C1, hi = DN_C2;
   for (int st = 0; st < 2; ++st) { REFRESH_F(); asm volatile("" : "+s"(lo), "+s"(mid), "+s"(hi));
       if (F.bx < 32) dn_chunk_recur(F, F.bx, lo, mid); else dn_chunk_prep(F, j, mid, hi, 32);
       xcd_barrier(bar); lo = mid; mid = hi; hi = 128; } }
 REPEAT(REP_EM2) { REFRESH_F(); if (F.bx < 32) dn_chunk_recur(F, F.bx, DN_C2, 128); else { if (F.bx >= 128 && F.bx < 136) lru_carry(F, (F.bx - 128) * 512 + F.tid); __syncthreads(); { pg8::Gemm g{F.PB, F.WPP, M_TOK, DM, PLE}; pg8::StaticOrder S; S.init(M_TOK, DM, F.G - 32, F.bx - 32); pg8::EpiB16<0> E{F.PP2, DM, nullptr}; pg8::gemm_phase<pg8::EpiB16<0>, pg8::StaticOrder, true, true>(ring, g, S, E); } __syncthreads(); convert_w_rest(F, layer, 32); if (layer + 1 < DEPTH) convert_w_in(F, layer + 1, 32); } __syncthreads(); }
 }
        } if (even) SEAM(P + 3);
        if (IN(P + 4)) { if (even) { dn_final(F, j); lru_final(F); } else { ret_final(F); swa_merge(F); } } SEAM(P + 4);
        if (IN(P + 5)) {
            { pg8::Gemm g{F.MIX, F.WOUT, M_TOK, DM, DM}; pg8::StaticOrder S; S.init(M_TOK, DM, F.G, F.bx);
              pg8::EpiResid E{layer == 0 ? F.in[0] : nullptr, F.H16, F.H16, DM, (float*)(F.ws + WS_SS), nullptr}; pg8::gemm_phase<pg8::EpiResid, pg8::StaticOrder, true, true>(ring, g, S, E); }
#ifdef REP_G2
            { pg8::Gemm g{F.MIX, F.WOUT, M_TOK, DM, DM}; pg8::StaticOrder S; S.init(M_TOK, DM, F.G, F.bx); pg8::EpiResid E{F.in[0], nullptr, F.BIG, DM, nullptr, nullptr}; pg8::gemm_phase<pg8::EpiResid, pg8::StaticOrder, true, true>(ring, g, S, E); }
#endif
        } SEAM(P + 5);
        if (IN(P + 7)) REPEAT(REP_G3) { pg8::Gemm g{F.H16, F.WUP, M_TOK, DFF, DM}; pg8::StaticOrder S; S.init(M_TOK, DFF, F.G, F.bx);
            pg8::EpiB16<1> E{F.BIG, DFF, nullptr}; pg8::gemm_phase<pg8::EpiB16<1>, pg8::StaticOrder, true, true>(ring, g, S, E); } SEAM(P + 7);
        if (IN(P + 8)) { pg8::Gemm g{F.BIG, F.WDOWN, M_TOK, DM, DFF}; pg8::StaticOrder S; S.init(M_TOK, DM, F.G, F.bx);
            pg8::EpiResid E{nullptr, F.H16, F.HN, DM, (float*)(F.ws + WS_SS) + (size_t)M_TOK * 32, (const float*)(F.ws + WS_SS)}; pg8::gemm_phase<pg8::EpiResid, pg8::StaticOrder, true, true>(ring, g, S, E);
#ifdef REP_G4
            { pg8::EpiResid E2{F.in[0], nullptr, F.MIX, DM, nullptr, nullptr}; pg8::gemm_phase<pg8::EpiResid, pg8::StaticOrder, true, true>(ring, g, S, E2); }
#endif
            } SEAM(P + 8);
        if (IN(P + 10)) { pg8::Gemm g{F.HN, F.WGATE, M_TOK, DM, DM}; pg8::StaticOrder S; S.init(M_TOK, DM, F.G, F.bx);
            pg8::EpiGate E{F.HN, F.H16, F.PP2, DM, (const float*)(F.ws + WS_SS) + (size_t)M_TOK * 32}; pg8::gemm_phase<pg8::EpiGate, pg8::StaticOrder, true, true>(ring, g, S, E);
#ifdef REP_G5
            { pg8::EpiGate E2{F.HN, F.MIX, F.PP2, DM, nullptr}; pg8::gemm_phase<pg8::EpiGate, pg8::StaticOrder, true, true>(ring, g, S, E2); }
#endif
            } SEAM(P + 10);
    }
    if (IN(NPH - 2)) final_norm(F);
    SEAM(NPH - 2);
#undef IN
#undef SEAM
}

extern "C" void kernel_launch(void* const* d_in, const int* in_sizes, int n_in, void* d_out, int out_size, void* d_ws, size_t ws_size, hipStream_t stream) {
    static int grid = 0;
    if (grid == 0) {
        if (n_in != 25 || in_sizes[0] != M_TOK * DM || out_size != M_TOK * DM || ws_size < WS_END) {
            fprintf(stderr, "kernel_launch: unexpected shapes (n_in %d, in0 %d, out %d, ws %zu, need %zu); nothing launched\n", n_in, n_in > 0 ? in_sizes[0] : -1, out_size, ws_size, (size_t)WS_END); grid = -1; return; }
        int dev = 0, cus = 0;
        if (hipGetDevice(&dev) != hipSuccess || hipDeviceGetAttribute(&cus, hipDeviceAttributeMultiprocessorCount, dev) != hipSuccess) { grid = -1; return; }
        if (hipFuncSetAttribute((const void*)trunk_fwd, hipFuncAttributeMaxDynamicSharedMemorySize, LDS_BYTES) != hipSuccess) { fprintf(stderr, "kernel_launch: hipFuncSetAttribute failed\n"); grid = -1; return; }
        int per_cu = 0;
        if (hipOccupancyMaxActiveBlocksPerMultiprocessor(&per_cu, (const void*)trunk_fwd, NWAVES * 64, LDS_BYTES) != hipSuccess || per_cu < 1) { fprintf(stderr, "kernel_launch: occupancy query says %d blocks per CU\n", per_cu); }
        (void)hipGetLastError();
        grid = cus;
    }
    if (grid < 0) return;
    if (hipMemsetAsync((char*)d_ws + WS_CTL, 0, 65536, stream) != hipSuccess) return;
    Args a{};
    for (int i = 0; i < 25; ++i) a.in[i] = (const float*)d_in[i];
    a.out = (float*)d_out; a.ws = (unsigned char*)d_ws;
#if ONE_LAUNCH
    a.ph_lo = 0; a.ph_hi = NPH;
    hipLaunchKernelGGL(trunk_fwd, dim3(grid), dim3(NWAVES * 64), LDS_BYTES, stream, a);
#else
    for (int ph = 0; ph < NPH; ++ph) {
        const int pl = ph % PH_PER_LAYER, layer = ph / PH_PER_LAYER;
        if (ph < NPH - 2 && pl == 3 && (layer & 1)) continue;
        a.ph_lo = ph; a.ph_hi = ph + 1;
        hipLaunchKernelGGL(trunk_fwd, dim3(grid), dim3(NWAVES * 64), LDS_BYTES, stream, a);
    }
#endif
}
```

```cpp
#include <hip/hip_runtime.h>
#include <cstdio>
#include <cstdint>
#include <cmath>

#ifndef ONE_LAUNCH
#define ONE_LAUNCH 1
#endif

namespace pg8 {
#define PG8_LAS __attribute__((address_space(3)))
typedef unsigned short bf16_t;
typedef short bf16x8 __attribute__((ext_vector_type(8)));
typedef float f32x4 __attribute__((ext_vector_type(4)));
typedef unsigned u32x4 __attribute__((ext_vector_type(4)));
constexpr int BM = 256, BK = 64, HALF = 128, HTB = HALF * BK * 2  , STAGE_BYTES = 8 * HTB, NXCD = 8, WGM = 8;

__host__ __device__ __forceinline__ int lds_byte(int r, int c) { const int st = (r >> 4) * 2 + (c >> 5), rr = r & 15, cc = c & 31, ob = rr * 64 + cc * 2; return st * 1024 + (ob ^ (((ob >> 9) & 1) << 5)); }
__host__ __device__ __forceinline__ void stage_rc(int b, int& R, int& C) { const int st = b / 1024, sb = b % 1024, swz = sb ^ (((sb >> 9) & 1) << 5); R = (st >> 1) * 16 + swz / 64; C = (st & 1) * 32 + (swz % 64) / 2; }
__host__ __device__ __forceinline__ int perm32(int rho) { const int n = rho >> 4, i = rho & 15; return 8 * (i >> 2) + 4 * n + (i & 3); }

struct Unit { int pm, pn; };
struct Gemm { const bf16_t* A; const bf16_t* Bt; int M, N, K; };

struct StaticOrder {
    int nM, nN, nwg, G, c;
    __host__ __device__ void init(int M, int N, int G_, int c_) { nM = M / BM; nN = N / BM; nwg = nM * nN; G = G_; c = c_; }
    __host__ __device__ bool next(int i, Unit& u) const {
        const long L = (long)i * G + c; if (L >= nwg) return false;
        int wgid = (int)L; { const int q = nwg / NXCD, r = nwg % NXCD, xcd = wgid % NXCD, off = wgid / NXCD; wgid = (xcd < r ? xcd * (q + 1) : r * (q + 1) + (xcd - r) * q) + off; }
        const int nig = WGM * nN, gid = wgid / nig, fm = gid * WGM, gsz = (nM - fm) < WGM ? (nM - fm) : WGM;
        u.pm = fm + ((wgid % nig) % gsz); u.pn = (wgid % nig) / gsz; return true;
    }
    __device__ __forceinline__ void a_ready(const Unit&) const {}
    __device__ __forceinline__ void done(const Unit&) const {}
};

__device__ __forceinline__ unsigned cvt_pk_bf16(float lo, float hi) { unsigned r; asm volatile("v_cvt_pk_bf16_f32 %0, %1, %2" : "=v"(r) : "v"(lo), "v"(hi)); return r; }

__device__ __forceinline__ float row_rstd32(const float* ssp, int row, int fq) {
    const f32x4 a = *(const f32x4*)(ssp + (size_t)row * 32 + fq * 8), b = *(const f32x4*)(ssp + (size_t)row * 32 + fq * 8 + 4);
    float s = ((a[0] + a[1]) + (a[2] + a[3])) + ((b[0] + b[1]) + (b[2] + b[3]));
    s += __shfl_xor(s, 16); s += __shfl_xor(s, 32);
    return 1.0f / sqrtf(s * (1.0f / 2048.0f) + 1e-6f);
}
__device__ __forceinline__ void rows_rstd32(const float* ssp, int row0, int fq, float (&rs)[2][4]) {
    f32x4 pa[2][4][2];
#pragma unroll
    for (int ai = 0; ai < 2; ++ai)
#pragma unroll
        for (int m = 0; m < 4; ++m) { const float* p = ssp + (size_t)(row0 + ai * HALF + m * 16) * 32 + fq * 8; pa[ai][m][0] = *(const f32x4*)p; pa[ai][m][1] = *(const f32x4*)(p + 4); }
    __builtin_amdgcn_sched_barrier(0);
#pragma unroll
    for (int ai = 0; ai < 2; ++ai)
#pragma unroll
        for (int m = 0; m < 4; ++m) { const f32x4 a = pa[ai][m][0], b = pa[ai][m][1]; float s = ((a[0] + a[1]) + (a[2] + a[3])) + ((b[0] + b[1]) + (b[2] + b[3]));
            s += __shfl_xor(s, 16); s += __shfl_xor(s, 32); rs[ai][m] = 1.0f / sqrtf(s * (1.0f / 2048.0f) + 1e-6f); }
}
template <int ACT> struct EpiB16 {
    static constexpr bool PERM = true, AFTER_DRAIN = false;
    bf16_t* O; int ldc; const float* ss;
    __device__ __forceinline__ void operator()(const f32x4 (&acc)[2][2][4][2], const Unit& u, int wr, int wc, int fr, int fq) const {
        const int row0 = u.pm * BM + wr * 64 + fr; const int col0 = u.pn * BM + wc * 32 + 8 * fq;
        float rs[2][4];
        if (ss) rows_rstd32(ss, row0, fq, rs);
        else {
#pragma unroll
            for (int ai = 0; ai < 2; ++ai)
#pragma unroll
                for (int m = 0; m < 4; ++m) rs[ai][m] = 1.0f; }
#pragma unroll
        for (int ai = 0; ai < 2; ++ai)
#pragma unroll
            for (int m = 0; m < 4; ++m) { bf16_t* rowp = O + (size_t)(row0 + ai * HALF + m * 16) * ldc + col0;
#pragma unroll
                for (int bj = 0; bj < 2; ++bj) { f32x4 v0 = acc[ai][bj][m][0] * rs[ai][m], v1 = acc[ai][bj][m][1] * rs[ai][m];
                    if (ACT == 1) {
#pragma unroll
                        for (int j = 0; j < 4; ++j) { const float a = fmaxf(v0[j], 0.f), b = fmaxf(v1[j], 0.f); v0[j] = a * a; v1[j] = b * b; } }
                    u32x4 w; w.x = cvt_pk_bf16(v0[0], v0[1]); w.y = cvt_pk_bf16(v0[2], v0[3]); w.z = cvt_pk_bf16(v1[0], v1[1]); w.w = cvt_pk_bf16(v1[2], v1[3]);
                    __builtin_nontemporal_store(w, (u32x4*)(rowp + bj * HALF)); } }
    }
};
__device__ __forceinline__ void unpack_bf8(const u32x4 w, f32x4& a, f32x4& b) {
    a = (f32x4){__uint_as_float(w.x << 16), __uint_as_float(w.x & 0xffff0000u), __uint_as_float(w.y << 16), __uint_as_float(w.y & 0xffff0000u)};
    b = (f32x4){__uint_as_float(w.z << 16), __uint_as_float(w.z & 0xffff0000u), __uint_as_float(w.w << 16), __uint_as_float(w.w & 0xffff0000u)};
}
__device__ __forceinline__ u32x4 pack_bf8(const f32x4 a, const f32x4 b) { u32x4 w; w.x = cvt_pk_bf16(a[0], a[1]); w.y = cvt_pk_bf16(a[2], a[3]); w.z = cvt_pk_bf16(b[0], b[1]); w.w = cvt_pk_bf16(b[2], b[3]); return w; }
__device__ __forceinline__ float sumsq4(const f32x4 v) { return (v[0] * v[0] + v[1] * v[1]) + (v[2] * v[2] + v[3] * v[3]); }
struct EpiResid {
    static constexpr bool PERM = true, AFTER_DRAIN = false;
    const float* basef; const bf16_t* baseh; bf16_t* h16; int ldc; float* ss;
    const float* ssin;
    __device__ __forceinline__ void fin(const f32x4 (&acc)[2][2][4][2], const Unit& u, int q, int row0, int col0, int wc, int fq, f32x4 b0, f32x4 b1, f32x4 c0, f32x4 c1, float sc) const {
        const int ai = q >> 2, m = q & 3; const int row = row0 + ai * HALF + m * 16; const size_t off = (size_t)row * ldc + col0;
        const f32x4 v0 = b0 + acc[ai][0][m][0] * sc, v1 = b1 + acc[ai][0][m][1] * sc, v2 = c0 + acc[ai][1][m][0] * sc, v3 = c1 + acc[ai][1][m][1] * sc;
        *(u32x4*)(h16 + off) = pack_bf8(v0, v1); *(u32x4*)(h16 + off + HALF) = pack_bf8(v2, v3);
        if (ss) { float sq = (sumsq4(v0) + sumsq4(v1)) + (sumsq4(v2) + sumsq4(v3)); sq += __shfl_xor(sq, 16); sq += __shfl_xor(sq, 32);
            if (fq == 0) ss[(size_t)row * 32 + u.pn * 4 + wc] = sq; }
    }
    __device__ __forceinline__ void operator()(const f32x4 (&acc)[2][2][4][2], const Unit& u, int wr, int wc, int fr, int fq) const {
        const int row0 = u.pm * BM + wr * 64 + fr, col0 = u.pn * BM + wc * 32 + 8 * fq;
#define ER_OFF(q_) ((size_t)(row0 + ((q_) >> 2) * HALF + ((q_) & 3) * 16) * ldc + col0)
        if (basef) {
            f32x4 b[2][4];
#define ERF_LOAD(q_) do { const float* p_ = basef + ER_OFF(q_); b[(q_) & 1][0] = *(const f32x4*)p_; b[(q_) & 1][1] = *(const f32x4*)(p_ + 4); b[(q_) & 1][2] = *(const f32x4*)(p_ + HALF); b[(q_) & 1][3] = *(const f32x4*)(p_ + HALF + 4); } while (0)
            ERF_LOAD(0); ERF_LOAD(1);
            __builtin_amdgcn_sched_barrier(0);
#pragma unroll
            for (int q = 0; q < 8; ++q) {
                fin(acc, u, q, row0, col0, wc, fq, b[q & 1][0], b[q & 1][1], b[q & 1][2], b[q & 1][3], 1.0f);
                if (q + 2 < 8) ERF_LOAD(q + 2);
                asm volatile("" ::: "memory");
            }
#undef ERF_LOAD
        } else if (ssin) {
            u32x4 b[8][2]; f32x4 pa[2][4][2]; float rs2[2][4];
#define ER_BLOAD(q_) do { const bf16_t* p_ = baseh + ER_OFF(q_); b[q_][0] = *(const u32x4*)p_; b[q_][1] = *(const u32x4*)(p_ + HALF); } while (0)
#define ER_RS_LOAD(ai_) do { _Pragma("unroll") for (int m = 0; m < 4; ++m) { const float* p_ = ssin + (size_t)(row0 + (ai_) * HALF + m * 16) * 32 + fq * 8; pa[ai_][m][0] = *(const f32x4*)p_; pa[ai_][m][1] = *(const f32x4*)(p_ + 4); } } while (0)
#define ER_RS_REDUCE(ai_) do { _Pragma("unroll") for (int m = 0; m < 4; ++m) { const f32x4 a_ = pa[ai_][m][0], b_ = pa[ai_][m][1]; float s_ = ((a_[0] + a_[1]) + (a_[2] + a_[3])) + ((b_[0] + b_[1]) + (b_[2] + b_[3])); \
                s_ += __shfl_xor(s_, 16); s_ += __shfl_xor(s_, 32); rs2[ai_][m] = 1.0f / (s_ * (1.0f / 2048.0f) + 1e-6f); } } while (0)
#define ER_PROC(q_) do { f32x4 b0, b1, c0, c1; unpack_bf8(b[q_][0], b0, b1); unpack_bf8(b[q_][1], c0, c1); fin(acc, u, q_, row0, col0, wc, fq, b0, b1, c0, c1, rs2[(q_) >> 2][(q_) & 3]); asm volatile("" ::: "memory"); } while (0)
            ER_RS_LOAD(0); ER_BLOAD(0); ER_BLOAD(1); ER_BLOAD(2);
            __builtin_amdgcn_sched_barrier(0);
            ER_RS_REDUCE(0);
            ER_PROC(0); ER_RS_LOAD(1); ER_BLOAD(3); asm volatile("" ::: "memory");
            ER_PROC(1); ER_BLOAD(4); ER_BLOAD(5); asm volatile("" ::: "memory");
            ER_PROC(2); ER_BLOAD(6); ER_BLOAD(7); asm volatile("" ::: "memory");
            ER_PROC(3);
            ER_RS_REDUCE(1);
            ER_PROC(4); ER_PROC(5); ER_PROC(6); ER_PROC(7);
#undef ER_PROC
#undef ER_RS_REDUCE
#undef ER_RS_LOAD
#undef ER_BLOAD
        } else {
            u32x4 b[8][2];
#pragma unroll
            for (int q = 0; q < 8; ++q) { const bf16_t* p_ = baseh + ER_OFF(q); b[q][0] = *(const u32x4*)p_; b[q][1] = *(const u32x4*)(p_ + HALF); }
            __builtin_amdgcn_sched_barrier(0);
#pragma unroll
            for (int q = 0; q < 8; ++q) { f32x4 b0, b1, c0, c1; unpack_bf8(b[q][0], b0, b1); unpack_bf8(b[q][1], c0, c1);
                fin(acc, u, q, row0, col0, wc, fq, b0, b1, c0, c1, 1.0f);
                asm volatile("" ::: "memory"); }
        }
#undef ER_OFF
    }
};
struct EpiGate {
    static constexpr bool PERM = true, AFTER_DRAIN = false;
    const bf16_t* hin; bf16_t* h16; const bf16_t* pp; int ldc; const float* ss;
    __device__ __forceinline__ void operator()(const f32x4 (&acc)[2][2][4][2], const Unit& u, int wr, int wc, int fr, int fq) const {
        const int row0 = u.pm * BM + wr * 64 + fr, col0 = u.pn * BM + wc * 32 + 8 * fq;
        u32x4 hw[8][2], pw[8][2];
        f32x4 pa[2][4][2];
        float rsv[2][4];
#define EG_OFF(q_) ((size_t)(row0 + ((q_) >> 2) * HALF + ((q_) & 3) * 16) * ldc + col0)
#define EG_LOAD(q_) do { const size_t off_ = EG_OFF(q_); hw[q_][0] = *(const u32x4*)(hin + off_); hw[q_][1] = *(const u32x4*)(hin + off_ + HALF); pw[q_][0] = *(const u32x4*)(pp + off_); pw[q_][1] = *(const u32x4*)(pp + off_ + HALF); } while (0)
#define EG_RS_LOAD(ai_) do { if (ss) { _Pragma("unroll") for (int m = 0; m < 4; ++m) { const float* p_ = ss + (size_t)(row0 + (ai_) * HALF + m * 16) * 32 + fq * 8; pa[ai_][m][0] = *(const f32x4*)p_; pa[ai_][m][1] = *(const f32x4*)(p_ + 4); } } } while (0)
#define EG_RS_REDUCE(ai_) do { _Pragma("unroll") for (int m = 0; m < 4; ++m) { if (ss) { const f32x4 a_ = pa[ai_][m][0], b_ = pa[ai_][m][1]; float s_ = ((a_[0] + a_[1]) + (a_[2] + a_[3])) + ((b_[0] + b_[1]) + (b_[2] + b_[3])); \
            s_ += __shfl_xor(s_, 16); s_ += __shfl_xor(s_, 32); rsv[ai_][m] = 1.0f / sqrtf(s_ * (1.0f / 2048.0f) + 1e-6f); } else rsv[ai_][m] = 1.0f; } } while (0)
#define EG_PROC(q_) do { const int ai_ = (q_) >> 2, m_ = (q_) & 3; const size_t off = EG_OFF(q_); const float rs = rsv[ai_][m_]; \
            _Pragma("unroll") for (int bj = 0; bj < 2; ++bj) { f32x4 h0, h1, p0, p1; unpack_bf8(hw[q_][bj], h0, h1); unpack_bf8(pw[q_][bj], p0, p1); \
                const f32x4 a0 = acc[ai_][bj][m_][0], a1 = acc[ai_][bj][m_][1]; f32x4 r0, r1; \
                _Pragma("unroll") for (int j = 0; j < 4; ++j) { r0[j] = h0[j] + p0[j] / (1.0f + __expf(-a0[j] * rs)); r1[j] = h1[j] + p1[j] / (1.0f + __expf(-a1[j] * rs)); } \
                *(u32x4*)(h16 + off + bj * HALF) = pack_bf8(r0, r1); } \
            asm volatile("" ::: "memory"); } while (0)
        EG_RS_LOAD(0); EG_LOAD(0); EG_LOAD(1);
        __builtin_amdgcn_sched_barrier(0);
        EG_RS_REDUCE(0);
        EG_PROC(0); EG_LOAD(2); EG_RS_LOAD(1); asm volatile("" ::: "memory");
        EG_PROC(1); EG_LOAD(3); EG_LOAD(4); asm volatile("" ::: "memory");
        EG_RS_REDUCE(1);
        EG_PROC(2); EG_LOAD(5); EG_LOAD(6); asm volatile("" ::: "memory");
        EG_PROC(3); EG_LOAD(7); asm volatile("" ::: "memory");
        EG_PROC(4); EG_PROC(5); EG_PROC(6); EG_PROC(7);
#undef EG_PROC
#undef EG_RS_REDUCE
#undef EG_RS_LOAD
#undef EG_LOAD
#undef EG_OFF
    }
};

template <class Epi, class Sched, bool ALIGN_EPI = false, bool SP2 = false>
__device__ __forceinline__ void gemm_phase(PG8_LAS unsigned char* lds, const Gemm g, const Sched& S, const Epi& E) {
    int tid = threadIdx.x; asm volatile("" : "+v"(tid));
    const int wid = __builtin_amdgcn_readfirstlane(tid >> 6), lane = tid & 63, wr = wid >> 2, wc = wid & 3, fr = lane & 15, fq = lane >> 4;
    const int K = g.K, nt = K / BK;
    unsigned voffA[2], voffB[2];
#pragma unroll
    for (int i = 0; i < 2; ++i) { int R, C; stage_rc(tid * 16 + i * 8192, R, C); const int Rb = Epi::PERM ? ((R & ~31) + perm32(R & 31)) : R;
        voffA[i] = (unsigned)(R * K + C) * 2u; voffB[i] = (unsigned)(Rb * K + C) * 2u; }
    const size_t kstep = (size_t)(BK * 2);
    const size_t hstep = (size_t)HALF * K * 2;
    const size_t tstep = 2 * hstep;
    const unsigned ldsw = (unsigned)wid * 1024u;
    const int aoff = lds_byte(wr * 64 + fr, fq * 8), boff = lds_byte(wc * 32 + fr, fq * 8);
#define PG8_SA(b, h) (((b) * 2 + (h)) * HTB)
#define PG8_SB(b, h) ((4 + (b) * 2 + (h)) * HTB)
#define PG8_STAGE(bufoff, gbase, voff) do { _Pragma("unroll") for (int _i = 0; _i < 2; ++_i) \
        __builtin_amdgcn_global_load_lds((const unsigned*)((const char*)(gbase) + (voff)[_i]), (PG8_LAS unsigned*)(lds + (bufoff) + ldsw + _i * 8192), 16, 0, 0); } while (0)
#define PG8_LDA(dst, b, h) do { _Pragma("unroll") for (int m = 0; m < 4; ++m) _Pragma("unroll") for (int k = 0; k < 2; ++k) dst[m][k] = *(const PG8_LAS bf16x8*)(lds + PG8_SA(b, h) + aoff + m * 2048 + k * 1024); } while (0)
#define PG8_LDB(dst, b, h) do { _Pragma("unroll") for (int n = 0; n < 2; ++n) _Pragma("unroll") for (int k = 0; k < 2; ++k) dst[n][k] = *(const PG8_LAS bf16x8*)(lds + PG8_SB(b, h) + boff + n * 2048 + k * 1024); } while (0)
#define PG8_MMA(ai, bj, At, Bt) do { __builtin_amdgcn_s_setprio(1); _Pragma("unroll") for (int m = 0; m < 4; ++m) _Pragma("unroll") for (int n = 0; n < 2; ++n) _Pragma("unroll") for (int k = 0; k < 2; ++k) \
        acc[ai][bj][m][n] = __builtin_amdgcn_mfma_f32_16x16x32_bf16(Bt[n][k], At[m][k], acc[ai][bj][m][n], 0, 0, 0); __builtin_amdgcn_s_setprio(0); } while (0)
#define PG8_WAIT_V(n) asm volatile("s_waitcnt vmcnt(" #n ")" ::: "memory")
#define PG8_WAIT_V_SEL(t_, ui_) asm volatile("s_cmp_lg_u32 %0, 0\n\ts_cbranch_scc1 1f\n\ts_cmp_eq_u32 %1, 0\n\ts_cbranch_scc1 1f\n\ts_waitcnt vmcnt(24)\n\ts_branch 2f\n1:\n\ts_waitcnt vmcnt(8)\n2:" :: "s"(t_), "s"(ui_) : "memory", "scc")
#define PG8_WAIT_L(n) asm volatile("s_waitcnt lgkmcnt(" #n ")" ::: "memory")
#define PG8_BAR __builtin_amdgcn_s_barrier()
#define PG8_SCHED __builtin_amdgcn_sched_barrier(0)
    Unit cur, nxt; int ui = 0;
    if (!S.next(0, cur)) return;
    f32x4 acc[2][2][4][2];
#pragma unroll
    for (int a = 0; a < 2; ++a)
#pragma unroll
        for (int b = 0; b < 2; ++b)
#pragma unroll
            for (int m = 0; m < 4; ++m)
#pragma unroll
                for (int n = 0; n < 2; ++n) acc[a][b][m][n] = (f32x4){0.f, 0.f, 0.f, 0.f};
    bf16x8 At[4][2], B0[2][2], B1[2][2];
    const char* cA = (const char*)g.A + (size_t)cur.pm * tstep; const char* cB = (const char*)g.Bt + (size_t)cur.pn * tstep;
    S.a_ready(cur);
    if constexpr (SP2) {
        PG8_STAGE(PG8_SB(0, 0), cB, voffB); PG8_STAGE(PG8_SB(0, 1), cB + hstep, voffB); PG8_STAGE(PG8_SA(0, 0), cA, voffA); PG8_STAGE(PG8_SA(0, 1), cA + hstep, voffA);
        if (wr == 1) PG8_BAR;
        PG8_WAIT_V(2); PG8_BAR;
        PG8_STAGE(PG8_SB(1, 0), cB + kstep, voffB); PG8_STAGE(PG8_SA(1, 0), cA + kstep, voffA); PG8_STAGE(PG8_SB(1, 1), cB + hstep + kstep, voffB);
        PG8_WAIT_V(6); PG8_BAR;
    } else {
        PG8_STAGE(PG8_SB(0, 0), cB, voffB); PG8_STAGE(PG8_SA(0, 0), cA, voffA); PG8_STAGE(PG8_SB(0, 1), cB + hstep, voffB); PG8_STAGE(PG8_SA(0, 1), cA + hstep, voffA);
        if (wr == 1) PG8_BAR;
        PG8_WAIT_V(4); PG8_BAR;
        PG8_STAGE(PG8_SB(1, 0), cB + kstep, voffB); PG8_STAGE(PG8_SA(1, 0), cA + kstep, voffA); PG8_STAGE(PG8_SB(1, 1), cB + hstep + kstep, voffB);
        PG8_WAIT_V(6); PG8_BAR;
    }
    for (;;) {
        const bool has_next = S.next(ui + 1, nxt);
        const char* nA = has_next ? (const char*)g.A + (size_t)nxt.pm * tstep : cA; const char* nB = has_next ? (const char*)g.Bt + (size_t)nxt.pn * tstep : cB;
        for (int t = 0; t < nt; t += 2) {
            const bool last = (t == nt - 2);
            const char* a1 = cA + (size_t)(t + 1) * kstep;
            const char* a2 = last ? nA : cA + (size_t)(t + 2) * kstep; const char* b2 = last ? nB : cB + (size_t)(t + 2) * kstep;
            const char* a3 = a2 + kstep; const char* b3 = b2 + kstep;
            if (last && has_next) S.a_ready(nxt);
            if constexpr (SP2) {
            PG8_LDB(B0, 0, 0); PG8_LDB(B1, 0, 1); PG8_SCHED; PG8_LDA(At, 0, 0); PG8_STAGE(PG8_SA(1, 1), a1 + hstep, voffA);
            PG8_WAIT_V_SEL(t, ui);
            PG8_WAIT_L(0); PG8_BAR; PG8_MMA(0, 0, At, B0); PG8_MMA(0, 1, At, B1); PG8_BAR; PG8_SCHED;
            PG8_LDA(At, 0, 1); PG8_STAGE(PG8_SB(0, 0), b2, voffB); PG8_STAGE(PG8_SB(0, 1), b2 + hstep, voffB); PG8_STAGE(PG8_SA(0, 0), a2, voffA);
            PG8_WAIT_V_SEL(t, ui);
            PG8_WAIT_L(0); PG8_BAR; PG8_MMA(1, 0, At, B0); PG8_MMA(1, 1, At, B1); PG8_BAR; PG8_SCHED;
            PG8_LDB(B0, 1, 0); PG8_LDB(B1, 1, 1); PG8_SCHED; PG8_LDA(At, 1, 0); PG8_STAGE(PG8_SA(0, 1), a2 + hstep, voffA);
            PG8_WAIT_V(8); PG8_WAIT_L(0); PG8_BAR; PG8_MMA(0, 0, At, B0); PG8_MMA(0, 1, At, B1); PG8_BAR; PG8_SCHED;
            PG8_LDA(At, 1, 1); PG8_STAGE(PG8_SB(1, 0), b3, voffB); PG8_STAGE(PG8_SB(1, 1), b3 + hstep, voffB); PG8_STAGE(PG8_SA(1, 0), a3, voffA);
            PG8_WAIT_V(8); PG8_WAIT_L(0); PG8_BAR; PG8_MMA(1, 0, At, B0); PG8_MMA(1, 1, At, B1); PG8_BAR; PG8_SCHED;
            } else {
            PG8_LDB(B0, 0, 0); PG8_SCHED; PG8_LDA(At, 0, 0); PG8_STAGE(PG8_SA(1, 1), a1 + hstep, voffA);
            PG8_WAIT_L(8); PG8_BAR; PG8_WAIT_L(0); PG8_MMA(0, 0, At, B0); PG8_BAR; PG8_SCHED;
            PG8_LDB(B1, 0, 1); PG8_STAGE(PG8_SB(0, 0), b2, voffB);
            PG8_BAR; PG8_WAIT_L(0); PG8_MMA(0, 1, At, B1); PG8_BAR;
            PG8_LDA(At, 0, 1); PG8_STAGE(PG8_SA(0, 0), a2, voffA);
            PG8_BAR; PG8_WAIT_L(0); PG8_MMA(1, 0, At, B0); PG8_BAR; PG8_SCHED;
            PG8_STAGE(PG8_SB(0, 1), b2 + hstep, voffB);
            PG8_WAIT_V(6); PG8_BAR; PG8_MMA(1, 1, At, B1); PG8_BAR;
            PG8_LDB(B0, 1, 0); PG8_SCHED; PG8_LDA(At, 1, 0); PG8_STAGE(PG8_SA(0, 1), a2 + hstep, voffA);
            PG8_WAIT_L(8); PG8_BAR; PG8_WAIT_L(0); PG8_MMA(0, 0, At, B0); PG8_BAR; PG8_SCHED;
            PG8_LDB(B1, 1, 1); PG8_STAGE(PG8_SB(1, 0), b3, voffB);
            PG8_BAR; PG8_WAIT_L(0); PG8_MMA(0, 1, At, B1); PG8_BAR;
            PG8_LDA(At, 1, 1); PG8_STAGE(PG8_SA(1, 0), a3, voffA);
            PG8_BAR; PG8_WAIT_L(0); PG8_MMA(1, 0, At, B0); PG8_BAR; PG8_SCHED;
            PG8_STAGE(PG8_SB(1, 1), b3 + hstep, voffB);
            PG8_WAIT_V(6); PG8_BAR; PG8_MMA(1, 1, At, B1); PG8_BAR;
            }
        }
        if constexpr (ALIGN_EPI) { if (wr == 0) PG8_BAR; }
        if constexpr (!Epi::AFTER_DRAIN) { E(acc, cur, wr, wc, fr, fq); S.done(cur); }
        if (!has_next) break;
#pragma unroll
        for (int a = 0; a < 2; ++a)
#pragma unroll
            for (int b = 0; b < 2; ++b)
#pragma unroll
                for (int m = 0; m < 4; ++m)
#pragma unroll
                    for (int n = 0; n < 2; ++n) acc[a][b][m][n] = (f32x4){0.f, 0.f, 0.f, 0.f};
        cur = nxt; cA = nA; cB = nB; ++ui;
        if constexpr (ALIGN_EPI) { if (wr == 1) PG8_BAR; }
    }
    PG8_WAIT_V(0);
    if constexpr (!ALIGN_EPI) { if (wr == 0) PG8_BAR; }
    PG8_BAR;
    if constexpr (Epi::AFTER_DRAIN) { E.fused(acc, cur, wr, wc, fr, fq, lds, wid, lane); S.done(cur); }
#undef PG8_SA
#undef PG8_SB
#undef PG8_STAGE
#undef PG8_LDA
#undef PG8_LDB
#undef PG8_MMA
#undef PG8_WAIT_V
#undef PG8_WAIT_L
#undef PG8_BAR
#undef PG8_SCHED
}
}

constexpr int NB = 4, SEQ = 8192, DM = 2048, DFF = 8192, NPROJ = 6144, PLE = 256, DEPTH = 4;
constexpr int M_TOK = NB * SEQ;
constexpr int EV_IN_W = 6160;
constexpr float RMS_EPS = 1e-6f, GN_EPS = 1e-5f;
constexpr float SC128 = 0.08838834764831845f;
constexpr int NWAVES = 8;
#ifndef LAYER_HI
#define LAYER_HI DEPTH
#endif

constexpr size_t MiB = 1u << 20;
constexpr size_t WS_CTL = 0, CTL_ZERO_BYTES = 1 * MiB;
constexpr size_t WS_WIN = WS_CTL + CTL_ZERO_BYTES;
constexpr size_t WS_WOUT = WS_WIN + (size_t)NPROJ * DM * 2;
constexpr size_t WS_WUP = WS_WOUT + (size_t)DM * DM * 2;
constexpr size_t WS_WDOWN = WS_WUP + (size_t)DFF * DM * 2;
constexpr size_t WS_WGATE = WS_WDOWN + (size_t)DM * DFF * 2;
constexpr size_t WS_WPP = WS_WGATE + (size_t)DM * DM * 2;
constexpr size_t WS_PB = WS_WPP + (size_t)DM * PLE * 2;
constexpr size_t WS_GB = WS_PB + (size_t)M_TOK * PLE * 2;
constexpr size_t WS_HN = WS_GB + (size_t)M_TOK * 16 * 4;
constexpr size_t WS_MIX = WS_HN + (size_t)M_TOK * DM * 2;
constexpr size_t WS_BIG = WS_MIX + (size_t)M_TOK * DM * 2;
constexpr size_t WS_PPB = WS_BIG + (size_t)M_TOK * DFF * 2;
constexpr size_t WS_LSUM = WS_PPB + (size_t)M_TOK * DM * 2;
constexpr size_t WS_LCIN = WS_LSUM + (size_t)NB * 256 * 1024 * 8;
constexpr size_t WS_DQK = WS_LCIN + (size_t)NB * 256 * 1024 * 4;
constexpr size_t WS_DGT = WS_DQK + (size_t)4096 * 64 * 64 * 2;
constexpr size_t WS_WLT = WS_DGT + 4096 * 4;
constexpr size_t WS_PP2 = WS_WLT + 8 * 256 * 128 * 2;
constexpr size_t WS_WIN2 = WS_PP2 + (size_t)M_TOK * DM * 2;
constexpr size_t WS_SS = WS_WIN2 + (size_t)NPROJ * DM * 2;
constexpr size_t WS_END = WS_SS + (size_t)2 * M_TOK * 32 * 4;
static_assert(WS_END <= 1286087808ull, "workspace map exceeds the guaranteed d_ws size (sum of inputs)");
constexpr int CW_BAR = 4096;

constexpr int RING_OFF = 0, RING_BYTES = 131072;
constexpr int LDS_BYTES = 163840;
constexpr int LDSCTL_OFF = LDS_BYTES - 1024, MISC_OFF = LDSCTL_OFF + 320;

#define GAS __attribute__((address_space(1)))
#define LAS __attribute__((address_space(3)))
typedef unsigned short bf16;
typedef unsigned v4u __attribute__((ext_vector_type(4)));
typedef unsigned v2u __attribute__((ext_vector_type(2)));
typedef float f32x4 __attribute__((ext_vector_type(4)));
typedef float f32x2 __attribute__((ext_vector_type(2)));
#define LDS_WAIT() asm volatile("s_waitcnt lgkmcnt(0)" ::: "memory")
#define LDS_BARRIER() do { asm volatile("s_waitcnt lgkmcnt(0)" ::: "memory"); __builtin_amdgcn_s_barrier(); asm volatile("" ::: "memory"); } while (0)
__device__ __forceinline__ unsigned f2bf(float f) { unsigned u = __float_as_uint(f); return (u + 0x7fffu + ((u >> 16) & 1u)) >> 16; }
__device__ __forceinline__ unsigned pk2(float lo, float hi) { return f2bf(lo) | (f2bf(hi) << 16); }
typedef __bf16 bf16v2_t __attribute__((ext_vector_type(2)));
__device__ __forceinline__ unsigned pkbf(float lo, float hi) { const f32x2 v = {lo, hi}; return __builtin_bit_cast(unsigned, __builtin_convertvector(v, bf16v2_t)); }
__device__ __forceinline__ float bflo(unsigned u) { return __uint_as_float(u << 16); }
__device__ __forceinline__ float bfhi(unsigned u) { return __uint_as_float(u & 0xffff0000u); }
__device__ __forceinline__ float bf2f(bf16 b) { return __uint_as_float((unsigned)b << 16); }
__device__ __forceinline__ float sigmoidf_(float x) { return 1.0f / (1.0f + __expf(-x)); }
__device__ __forceinline__ float siluf_(float x) { return x / (1.0f + __expf(-x)); }
__device__ __forceinline__ float softplusf_(float x) { return x > 20.f ? x : log1pf(expf(x)); }
__device__ __forceinline__ float neg_expm1f_(float x) { const float p = x * (1.f + x * 0.5f * (1.f + x * (1.f / 3.f) * (1.f + x * 0.25f * (1.f + x * 0.2f * (1.f + x * (1.f / 6.f) * (1.f + x * (1.f / 7.f))))))); return x > -0.35f ? -p : 1.0f - __expf(x); }
__device__ __forceinline__ float gelu_tanh(float x) { const float z = 0.7978845608028654f * (x + 0.044715f * x * x * x); const float th = 1.0f - 2.0f / (__expf(2.0f * z) + 1.0f); return 0.5f * x * (1.0f + th); }
__device__ __forceinline__ float wave_sum(float v) {
#pragma unroll
    for (int o = 1; o < 64; o <<= 1) v += __shfl_xor(v, o);
    return v;
}
__device__ __forceinline__ float wave_max(float v) {
#pragma unroll
    for (int o = 1; o < 64; o <<= 1) v = fmaxf(v, __shfl_xor(v, o));
    return v;
}
#define DPP_ADD(v, ctrl) ((v) + __int_as_float(__builtin_amdgcn_update_dpp(0, __float_as_int(v), (ctrl), 0xF, 0xF, true)))
__device__ __forceinline__ float row16_sum(float v) {
    v = DPP_ADD(v, 0xB1);
    v = DPP_ADD(v, 0x4E);
    v = DPP_ADD(v, 0x141);
    v = DPP_ADD(v, 0x140);
    return v;
}

__device__ __forceinline__ float row8_sum(float v) { v = DPP_ADD(v, 0xB1); v = DPP_ADD(v, 0x4E); v = DPP_ADD(v, 0x141); return v; }
__device__ __forceinline__ void unpack8(const v4u x, float* o) { o[0] = bflo(x.x); o[1] = bfhi(x.x); o[2] = bflo(x.y); o[3] = bfhi(x.y); o[4] = bflo(x.z); o[5] = bfhi(x.z); o[6] = bflo(x.w); o[7] = bfhi(x.w); }
__device__ __forceinline__ v4u pack8(const float* a) { v4u w; w.x = pkbf(a[0], a[1]); w.y = pkbf(a[2], a[3]); w.z = pkbf(a[4], a[5]); w.w = pkbf(a[6], a[7]); return w; }

#define XB_TMO      128
#define XB_XCNT(j)  (256  + 64 * (j))
#define XB_XSUB(j)  (1280 + 64 * (j))
#define XB_XGEN(j)  (2304 + 64 * (j))
#define XB_TOP      3328
#define XB_TOPGEN   3392
#define XCD_BAR_WORDS 3456
#define XB_SPIN_CAP (1u << 20)

__device__ __forceinline__ unsigned xb_ld(unsigned* p)              { return __hip_atomic_load(p, __ATOMIC_RELAXED, __HIP_MEMORY_SCOPE_AGENT); }
__device__ __forceinline__ unsigned xb_add(unsigned* p, unsigned v) { return __hip_atomic_fetch_add(p, v, __ATOMIC_RELAXED, __HIP_MEMORY_SCOPE_AGENT); }
__device__ __forceinline__ unsigned xb_xcc_id() { return (unsigned)__builtin_amdgcn_s_getreg((3 << 11) | 20) & 0xFu; }
#define XB_SPIN(cond, bar) do { unsigned _sp = 0; while (cond) { __builtin_amdgcn_s_sleep(1); \
    if ((++_sp & 255u) == 0u) { if (xb_ld(&(bar)[XB_TMO])) break; if (_sp > XB_SPIN_CAP) { atomicAdd(&(bar)[XB_TMO], 1u); break; } } } } while (0)

struct XcdBarrier { unsigned* bar; unsigned x; volatile LAS unsigned* st; };

__device__ __forceinline__ XcdBarrier xcd_barrier_post(unsigned* bar, volatile LAS unsigned* st) {
    XcdBarrier b; b.bar = bar; b.x = xb_xcc_id(); b.st = st;
    if (threadIdx.x == 0) (void)xb_add(&bar[XB_XCNT(b.x)], 1u);
    return b;
}
__device__ __forceinline__ void xcd_barrier_complete(unsigned* bar, unsigned x, unsigned& nloc, unsigned& nx) {
    const unsigned G = gridDim.x * gridDim.y * gridDim.z;
    unsigned sum, cnt, mine, sp = 0u;
    for (;;) {
        sum = 0u; cnt = 0u; mine = 0u;
#pragma unroll
        for (unsigned j = 0; j < 16; ++j) { const unsigned c = xb_ld(&bar[XB_XCNT(j)]); sum += c; cnt += (c > 0u) ? 1u : 0u; mine = (j == x) ? c : mine; }
        if (sum == G) break;
        __builtin_amdgcn_s_sleep(1);
        if ((++sp & 255u) == 0u) { if (xb_ld(&bar[XB_TMO])) break; if (sp > XB_SPIN_CAP) { atomicAdd(&bar[XB_TMO], 1u); break; } }
    }
    nloc = mine > 0u ? mine : 1u; nx = cnt > 0u ? cnt : 1u;
}
__device__ __forceinline__ void xcd_barrier(const XcdBarrier& b) {
    asm volatile("s_waitcnt vmcnt(0)" ::: "memory");
    __syncthreads();
    if (threadIdx.x == 0) {
        unsigned* bar = b.bar;
        __builtin_amdgcn_s_waitcnt(0);
        unsigned nloc = b.st[0], nx = b.st[1];
        if (nloc == 0u) { xcd_barrier_complete(bar, b.x, nloc, nx); b.st[0] = nloc; b.st[1] = nx; }
        const unsigned old = xb_add(&bar[XB_XSUB(b.x)], 1u);
        const unsigned gen = old / nloc;
        if (old + 1u == (gen + 1u) * nloc) {
            __builtin_amdgcn_fence(__ATOMIC_RELEASE, "agent");
            asm volatile("s_waitcnt vmcnt(0)" ::: "memory");
            const unsigned og = xb_add(&bar[XB_TOP], 1u);
            const unsigned tg = og / nx;
            if (og + 1u == (tg + 1u) * nx) xb_add(&bar[XB_TOPGEN], 1u);
            else XB_SPIN(xb_ld(&bar[XB_TOPGEN]) == tg, bar);
            __builtin_amdgcn_fence(__ATOMIC_ACQUIRE, "agent");
            xb_add(&bar[XB_XGEN(b.x)], 1u);
            asm volatile("s_waitcnt vmcnt(0)" ::: "memory");
        } else {
            XB_SPIN(xb_ld(&bar[XB_XGEN(b.x)]) == gen, bar);
            __builtin_amdgcn_fence(__ATOMIC_ACQUIRE, "agent");
            asm volatile("s_waitcnt vmcnt(0)" ::: "memory");
        }
    }
    __syncthreads();
}

struct Args { const float* in[25]; float* out; unsigned char* ws; int ph_lo, ph_hi; };
struct Frame {
    LAS unsigned char* lds;
    int tid, lane, wave, bx, G;
    const float* const* in;
    float* out;
    bf16 *WIN, *WOUT, *WUP, *WDOWN, *WGATE, *WPP, *PB, *HN, *MIX, *BIG, *PPB;
    float* GB; unsigned char* ws; bf16* PP2; bf16* H16;
};

__device__ __forceinline__ void tr_item(const float* W, int ldw, int c0, int K, bf16* WT, int r0, int nblk, LAS float* scr, int item, int lane, const float* kscale) {
    const int kb = item / nblk, nb = item % nblk, k0 = 64 * kb, n0 = 32 * nb;
    {   float wv[32];
#pragma unroll
        for (int i = 0; i < 32; ++i) wv[i] = W[(size_t)(k0 + 2 * i + (lane >> 5)) * ldw + c0 + n0 + (lane & 31)];
        __builtin_amdgcn_sched_barrier(0);
#pragma unroll
        for (int i = 0; i < 32; ++i) { const int kk = 2 * i + (lane >> 5); const float sc = kscale ? kscale[k0 + kk] : 1.0f; scr[kk * 33 + (lane & 31)] = wv[i] * sc; } }
    LDS_WAIT(); asm volatile("" ::: "memory");
    const int c = lane & 7;
#pragma unroll
    for (int j = 0; j < 4; ++j) { const int n = (lane >> 3) + 8 * j; const LAS float* s = scr + (8 * c) * 33 + n;
        v4u o; o.x = pk2(s[0 * 33], s[1 * 33]); o.y = pk2(s[2 * 33], s[3 * 33]); o.z = pk2(s[4 * 33], s[5 * 33]); o.w = pk2(s[6 * 33], s[7 * 33]);
        *(v4u*)(WT + (size_t)(r0 + n0 + n) * K + k0 + 8 * c) = o; }
    LDS_WAIT(); asm volatile("" ::: "memory");
}
__device__ __forceinline__ void tr_matrix(Frame& F, const float* W, int ldw, int c0, int K, bf16* WT, int r0, int ncols, int wg0 = 0, const float* kscale = nullptr) {
    LAS float* scr = (LAS float*)(F.lds + RING_OFF + F.wave * 16384);
    const int gw = (F.bx - wg0) * NWAVES + F.wave, NGW = (F.G - wg0) * NWAVES, nblk = ncols / 32, nitems = (K / 64) * nblk;
    for (int it = gw; it < nitems; it += NGW) tr_item(W, ldw, c0, K, WT, r0, nblk, scr, it, F.lane, kscale);
}

template <bool GBV, bool SRC16>
__device__ __forceinline__ void rms_rows(Frame& F, const void* hsrcv, const float* lnw, bf16* HN, float* GB) {
    const float* hsrc = (const float*)hsrcv; const bf16* hsrc16 = (const bf16*)hsrcv;
    const int gw = F.bx * NWAVES + F.wave, NGW = F.G * NWAVES, lane = F.lane;
    const LAS float* wabT = (const LAS float*)(F.lds + RING_OFF);
    f32x4 lw[8];
#pragma unroll
    for (int j = 0; j < 8; ++j) lw[j] = ((const f32x4*)lnw)[lane + 64 * j];
    for (int pi = gw; pi < M_TOK / 2; pi += NGW) {
        f32x4 y[2][8];
        if (SRC16) { v2u w_[2][8];
#pragma unroll
            for (int r = 0; r < 2; ++r)
#pragma unroll
                for (int j = 0; j < 8; ++j) w_[r][j] = ((const v2u*)(hsrc16 + ((size_t)2 * pi + r) * DM))[lane + 64 * j];
            __builtin_amdgcn_sched_barrier(0);
#pragma unroll
            for (int r = 0; r < 2; ++r)
#pragma unroll
                for (int j = 0; j < 8; ++j) y[r][j] = (f32x4){bflo(w_[r][j].x), bfhi(w_[r][j].x), bflo(w_[r][j].y), bfhi(w_[r][j].y)};
        } else {
#pragma unroll
            for (int r = 0; r < 2; ++r)
#pragma unroll
                for (int j = 0; j < 8; ++j) y[r][j] = ((const f32x4*)(hsrc + ((size_t)2 * pi + r) * DM))[lane + 64 * j];
            __builtin_amdgcn_sched_barrier(0);
        }
#pragma unroll
        for (int r = 0; r < 2; ++r) {
            const size_t row = (size_t)2 * pi + r;
            float ss = 0.f;
#pragma unroll
            for (int j = 0; j < 8; ++j) ss += (y[r][j].x * y[r][j].x + y[r][j].y * y[r][j].y) + (y[r][j].z * y[r][j].z + y[r][j].w * y[r][j].w);
            ss = wave_sum(ss);
            const float rstd = 1.0f / sqrtf(ss * (1.0f / DM) + RMS_EPS);
            v2u* dst = (v2u*)(HN + row * DM) + lane;
#pragma unroll
            for (int j = 0; j < 8; ++j) { y[r][j] = y[r][j] * rstd * lw[j];
                v2u o; o.x = pkbf(y[r][j].x, y[r][j].y); o.y = pkbf(y[r][j].z, y[r][j].w); dst[64 * j] = o; }
        }
        if (GBV) {
            float keep0 = 0.f, keep1 = 0.f;
#pragma unroll 1
            for (int c = 0; c < 16; ++c) {
                float a0 = 0.f, a1 = 0.f;
                const LAS f32x4* wp = (const LAS f32x4*)(wabT + c * DM) + lane;
#pragma unroll
                for (int j = 0; j < 8; ++j) { const f32x4 w = wp[64 * j];
                    a0 += (y[0][j].x * w.x + y[0][j].y * w.y) + (y[0][j].z * w.z + y[0][j].w * w.w);
                    a1 += (y[1][j].x * w.x + y[1][j].y * w.y) + (y[1][j].z * w.z + y[1][j].w * w.w); }
                a0 = wave_sum(a0); a1 = wave_sum(a1);
                if (lane == c) { keep0 = a0; keep1 = a1; }
            }
            if (lane < 16) { GB[((size_t)2 * pi) * 16 + lane] = keep0; GB[((size_t)2 * pi + 1) * 16 + lane] = keep1; }
        }
    }
}

__device__ __forceinline__ void convert_w_in(Frame& F, int layer, int wg0) {
    const int j = layer >> 1; bf16* dst = (layer & 1) ? (bf16*)(F.ws + WS_WIN2) : F.WIN;
    if ((layer & 1) == 0) { const float* w = F.in[10] + (size_t)j * DM * EV_IN_W;
        tr_matrix(F, w, EV_IN_W, 0, DM, dst, 0, 4096, wg0); tr_matrix(F, w, EV_IN_W, 4112, DM, dst, 4096, 2048, wg0);
    } else tr_matrix(F, F.in[23] + (size_t)j * DM * NPROJ, NPROJ, 0, DM, dst, 0, NPROJ, wg0);
}
__device__ __forceinline__ void convert_w_rest(Frame& F, int layer, int wg0) {
    const int j = layer >> 1;
    tr_matrix(F, ((layer & 1) ? F.in[24] : F.in[11]) + (size_t)j * DM * DM, DM, 0, DM, F.WOUT, 0, DM, wg0);
    tr_matrix(F, F.in[5] + (size_t)layer * DM * DFF, DFF, 0, DM, F.WUP, 0, DFF, wg0, F.in[3] + (size_t)layer * DM);
    tr_matrix(F, F.in[6] + (size_t)layer * DFF * DM, DM, 0, DFF, F.WDOWN, 0, DM, wg0);
    tr_matrix(F, F.in[8] + (size_t)layer * DM * DM, DM, 0, DM, F.WGATE, 0, DM, wg0, F.in[4] + (size_t)layer * DM);
}
__device__ __forceinline__ void phase_t1(Frame& F, int layer) {
    const int j = layer >> 1; const bool even = (layer & 1) == 0;
    if (layer == 0) convert_w_in(F, 0, 0);
    tr_matrix(F, F.in[7] + (size_t)layer * PLE * DM, DM, 0, PLE, F.WPP, 0, DM);
    if (even) {
        bf16* WLT = (bf16*)(F.ws + WS_WLT); const float* wa = F.in[18] + (size_t)j * 8 * 128 * 128; const float* wx = F.in[20] + (size_t)j * 8 * 128 * 128;
        for (int i = F.bx * 512 + F.tid; i < 8 * 256 * 16; i += F.G * 512) { const int o = i & 255, gi = i >> 8; const int gg = gi >> 4, in0 = (gi & 15) * 8;
            const float* src = (o < 128 ? wa : wx) + ((size_t)gg * 128 + in0) * 128 + (o & 127);
            v4u w; w.x = pk2(src[0], src[128]); w.y = pk2(src[256], src[384]); w.z = pk2(src[512], src[640]); w.w = pk2(src[768], src[896]);
            *(v4u*)(WLT + ((size_t)gg * 256 + o) * 128 + in0) = w; }
    }
    {
        const f32x4* src = (const f32x4*)(F.in[1] + (size_t)layer * M_TOK * PLE);
        const size_t n8 = (size_t)M_TOK * PLE / 8, stride = (size_t)F.G * 512;
        for (size_t i = (size_t)F.bx * 512 + F.tid; i < n8; i += 4 * stride) { f32x4 a[4], b[4];
#pragma unroll
            for (int u = 0; u < 4; ++u) { a[u] = src[2 * (i + u * stride)]; b[u] = src[2 * (i + u * stride) + 1]; }
            __builtin_amdgcn_sched_barrier(0);
#pragma unroll
            for (int u = 0; u < 4; ++u) { v4u o; o.x = pkbf(a[u].x, a[u].y); o.y = pkbf(a[u].z, a[u].w); o.z = pkbf(b[u].x, b[u].y); o.w = pkbf(b[u].z, b[u].w); ((v4u*)F.PB)[i + u * stride] = o; } }
    }
    const void* hsrc = (layer == 0) ? (const void*)F.in[0] : (const void*)F.H16;
    const float* lnw = F.in[2] + (size_t)layer * DM;
    if (even) {
        __syncthreads();
        LAS float* wabT = (LAS float*)(F.lds + RING_OFF);
        const float* w = F.in[10] + (size_t)j * DM * EV_IN_W + 4096;
        for (int i = F.tid; i < 16 * DM; i += 512) { const int k = i >> 4, c = i & 15; wabT[c * DM + k] = w[(size_t)k * EV_IN_W + c]; }
        __syncthreads();
        if (layer == 0) rms_rows<true, false>(F, hsrc, lnw, F.HN, F.GB); else rms_rows<true, true>(F, hsrc, lnw, F.HN, F.GB);
        __syncthreads();
    } else rms_rows<false, true>(F, hsrc, lnw, F.HN, nullptr);
}

__device__ __forceinline__ void lru_carry(Frame& F, int id) {
    const int b = id >> 10, ch = id & 1023;
    const f32x2* LSUM = (const f32x2*)(F.ws + WS_LSUM) + (size_t)b * 128 * 1024 + ch; float* LCIN = (float*)(F.ws + WS_LCIN) + (size_t)b * 128 * 1024 + ch;
    float carry = 0.f;
    for (int t0 = 0; t0 < 128; t0 += 8) { f32x2 s[8];
#pragma unroll
        for (int i = 0; i < 8; ++i) s[i] = LSUM[(size_t)(t0 + i) * 1024];
#pragma unroll
        for (int i = 0; i < 8; ++i) { LCIN[(size_t)(t0 + i) * 1024] = carry; carry = s[i].x * carry + s[i].y; } }
}

__device__ __forceinline__ void lru_final(Frame& F) {
    const bf16* HL = F.HN; const bf16* PC = F.HN + (size_t)M_TOK * 1024; const bf16* PROJ = F.BIG; const float* LCIN = (const float*)(F.ws + WS_LCIN);
    const size_t n8 = (size_t)M_TOK * 1024 / 8, stride = (size_t)F.G * 512;
    for (size_t i = (size_t)F.bx * 512 + F.tid; i < n8; i += stride) {
        const size_t m = i >> 7; const int c0 = (int)(i & 127) * 8; const size_t tile = m >> 6;
        const v4u hw = *(const v4u*)(HL + m * 1024 + c0), pw = *(const v4u*)(PC + m * 1024 + c0), yw = *(const v4u*)(PROJ + m * NPROJ + 5120 + c0);
        const f32x4 ca = *(const f32x4*)(LCIN + tile * 1024 + c0), cb = *(const f32x4*)(LCIN + tile * 1024 + c0 + 4); __builtin_amdgcn_sched_barrier(0);
        v4u o;
        o.x = pk2((bflo(hw.x) + bflo(pw.x) * ca.x) * gelu_tanh(bflo(yw.x)), (bfhi(hw.x) + bfhi(pw.x) * ca.y) * gelu_tanh(bfhi(yw.x)));
        o.y = pk2((bflo(hw.y) + bflo(pw.y) * ca.z) * gelu_tanh(bflo(yw.y)), (bfhi(hw.y) + bfhi(pw.y) * ca.w) * gelu_tanh(bfhi(yw.y)));
        o.z = pk2((bflo(hw.z) + bflo(pw.z) * cb.x) * gelu_tanh(bflo(yw.z)), (bfhi(hw.z) + bfhi(pw.z) * cb.y) * gelu_tanh(bfhi(yw.z)));
        o.w = pk2((bflo(hw.w) + bflo(pw.w) * cb.z) * gelu_tanh(bflo(yw.w)), (bfhi(hw.w) + bfhi(pw.w) * cb.w) * gelu_tanh(bfhi(yw.w)));
        *(v4u*)(F.MIX + m * DM + 1024 + c0) = o;
    }
}

__device__ __forceinline__ void dn_final(Frame& F, int j) {
    const int gw = F.bx * NWAVES + F.wave, NGW = F.G * NWAVES, lane = F.lane; const int h = lane >> 3, c0 = (lane & 7) * 16;
    const bf16* PROJ = F.BIG; const float* nw = F.in[15] + j * 128 + c0;
    float wv[16];
#pragma unroll
    for (int i = 0; i < 4; ++i) { const f32x4 w4 = *(const f32x4*)(nw + 4 * i); wv[4 * i] = w4.x; wv[4 * i + 1] = w4.y; wv[4 * i + 2] = w4.z; wv[4 * i + 3] = w4.w; }
    for (int m = gw; m < M_TOK; m += NGW) {
        v4u* op = (v4u*)(F.MIX + (size_t)m * DM + h * 128 + c0); const v4u* zp = (const v4u*)(PROJ + (size_t)m * NPROJ + 3072 + h * 128 + c0);
        const v4u o0 = op[0], o1 = op[1], z0 = zp[0], z1 = zp[1]; __builtin_amdgcn_sched_barrier(0);
        float o[16], z[16]; unpack8(o0, o); unpack8(o1, o + 8); unpack8(z0, z); unpack8(z1, z + 8);
        float ss = 0.f;
#pragma unroll
        for (int i = 0; i < 16; ++i) ss += o[i] * o[i];
        ss = row8_sum(ss); const float r = 1.0f / sqrtf(ss * (1.0f / 128.0f) + RMS_EPS);
#pragma unroll
        for (int i = 0; i < 16; ++i) o[i] = o[i] * r * wv[i] * siluf_(z[i]);
        op[0] = pack8(o); op[1] = pack8(o + 8);
    }
}
typedef short bf16x8 __attribute__((ext_vector_type(8)));
typedef short s16x4 __attribute__((ext_vector_type(4)));
typedef float f32x16 __attribute__((ext_vector_type(16)));
#define MFMA32(a, b, c) __builtin_amdgcn_mfma_f32_32x32x16_bf16((a), (b), (c), 0, 0, 0)
#define TR16(p) __builtin_amdgcn_ds_read_tr16_b64_v4i16((LAS s16x4*)(p))
__device__ __forceinline__ bf16x8 pack_acc8(const f32x16& x, int s) {
    v4u p; p.x = pkbf(x[8 * s + 0], x[8 * s + 1]); p.y = pkbf(x[8 * s + 2], x[8 * s + 3]); p.z = pkbf(x[8 * s + 4], x[8 * s + 5]); p.w = pkbf(x[8 * s + 6], x[8 * s + 7]);
    return __builtin_bit_cast(bf16x8, p);
}
__device__ __forceinline__ v4u scale8(v4u x, float sc) {
    v4u o; o.x = pkbf(bflo(x.x) * sc, bfhi(x.x) * sc); o.y = pkbf(bflo(x.y) * sc, bfhi(x.y) * sc); o.z = pkbf(bflo(x.z) * sc, bfhi(x.z) * sc); o.w = pkbf(bflo(x.w) * sc, bfhi(x.w) * sc); return o;
}
constexpr int RT_QS = 272, RT_VS = 320, RT_S8 = 264;
constexpr int RT_QL = 0, RT_KL = 64 * RT_QS, RT_QD = 2 * 64 * RT_QS, RT_KT = RT_QD + 64 * RT_S8, RT_VL = RT_KT + 64 * RT_VS, RT_VSC = RT_VL + 64 * RT_VS;
__device__ __forceinline__ void ret_chunk(Frame& F, int wg) {
    const int tid = F.tid, lane = F.lane, wave = F.wave;
    const int bh = wg >> 1, b = bh >> 2, h = bh & 3, half = wg & 1;
    const bf16* PROJ = F.BIG; float* ORET = (float*)F.HN;
    LAS unsigned char* L = F.lds + RING_OFF;
    const float lg = log2f(1.0f - exp2f(-5.0f - (float)h));
    const float g64 = exp2f(64.0f * lg);
    const int r = lane & 31, hh = lane >> 5, q4 = (lane & 15) >> 2, p4 = lane & 3, cb = (lane >> 4) & 1;
    const int srow = (tid & 255) >> 4, sch = tid & 15;
    v4u pq[2][4], pk[2][4], pv[2][4];
    const size_t mrow0 = (size_t)b * SEQ;
#define RT_ISSUE(SET_, n_) do { _Pragma("unroll") for (int u = 0; u < 4; ++u) { const bf16* rp = PROJ + (mrow0 + (size_t)(n_) * 64 + srow + 16 * u) * NPROJ; \
            pq[SET_][u] = *(const v4u*)(rp + 3072 + h * 128 + sch * 8); pk[SET_][u] = *(const v4u*)(rp + 3584 + h * 128 + sch * 8); pv[SET_][u] = *(const v4u*)(rp + 4096 + h * 256 + half * 128 + sch * 8); } } while (0)
#define RT_COMMIT_A(SET_) do { _Pragma("unroll") for (int u = 0; u < 4; ++u) { const int row = srow + 16 * u; \
            *(LAS v4u*)(L + RT_QL + row * RT_QS + sch * 16) = pq[SET_][u]; *(LAS v4u*)(L + RT_KL + row * RT_QS + sch * 16) = pk[SET_][u]; } } while (0)
#define RT_COMMIT_B(SET_) do { _Pragma("unroll") for (int u = 0; u < 4; ++u) { const int row = srow + 16 * u; \
            { const v4u qd_ = scale8(pq[SET_][u], exp2f((float)(row + 1) * lg)); *(LAS v2u*)(L + RT_QD + row * RT_S8 + sch * 16) = (v2u){qd_.x, qd_.y}; *(LAS v2u*)(L + RT_QD + row * RT_S8 + sch * 16 + 8) = (v2u){qd_.z, qd_.w}; } \
            *(LAS v4u*)(L + RT_KT + row * RT_VS + sch * 16) = pk[SET_][u]; \
            *(LAS v4u*)(L + RT_VL + row * RT_VS + sch * 16) = pv[SET_][u]; \
            *(LAS v4u*)(L + RT_VSC + row * RT_VS + sch * 16) = scale8(pv[SET_][u], exp2f((float)(63 - row) * lg) * SC128); } } while (0)
    f32x16 S[4];
#pragma unroll
    for (int t = 0; t < 4; ++t)
#pragma unroll
        for (int e = 0; e < 16; ++e) S[t][e] = 0.f;
    if (wave >= 4) {
        RT_ISSUE(0, 0); RT_COMMIT_A(0); RT_COMMIT_B(0); RT_ISSUE(1, 1); RT_ISSUE(0, 2);
        LDS_BARRIER();
        v4u qdx[4], vsx[4];
#define RT_SCALE_B(SET_) do { _Pragma("unroll") for (int u = 0; u < 4; ++u) { const int row = srow + 16 * u; qdx[u] = scale8(pq[SET_][u], exp2f((float)(row + 1) * lg)); vsx[u] = scale8(pv[SET_][u], exp2f((float)(63 - row) * lg) * SC128); asm volatile("" : "+v"(qdx[u]), "+v"(vsx[u])); } } while (0)
#define RT_WRITE_B(SET_) do { _Pragma("unroll") for (int u = 0; u < 4; ++u) { const int row = srow + 16 * u; \
            *(LAS v2u*)(L + RT_QD + row * RT_S8 + sch * 16) = (v2u){qdx[u].x, qdx[u].y}; *(LAS v2u*)(L + RT_QD + row * RT_S8 + sch * 16 + 8) = (v2u){qdx[u].z, qdx[u].w}; \
            *(LAS v4u*)(L + RT_KT + row * RT_VS + sch * 16) = pk[SET_][u]; \
            *(LAS v4u*)(L + RT_VL + row * RT_VS + sch * 16) = pv[SET_][u]; \
            *(LAS v4u*)(L + RT_VSC + row * RT_VS + sch * 16) = vsx[u]; } } while (0)
        for (int n = 0; n < SEQ / 64; n += 2) {
            LDS_BARRIER(); RT_COMMIT_A(1); RT_SCALE_B(1);
            LDS_BARRIER(); RT_WRITE_B(1); if (n + 3 < SEQ / 64) RT_ISSUE(1, n + 3);
            LDS_BARRIER(); if (n + 2 < SEQ / 64) { RT_COMMIT_A(0); RT_SCALE_B(0); }
            LDS_BARRIER(); if (n + 2 < SEQ / 64) { RT_WRITE_B(0); if (n + 4 < SEQ / 64) RT_ISSUE(0, n + 4); }
        }
#undef RT_SCALE_B
#undef RT_WRITE_B
    } else {
    __builtin_amdgcn_s_setprio(3);
    LDS_BARRIER();
    for (int n = 0; n < SEQ / 64; ++n) {
        {
            const int w = wave;
            f32x16 pt00, pt01, pt11;
#pragma unroll
            for (int e = 0; e < 16; ++e) { pt00[e] = 0.f; pt01[e] = 0.f; pt11[e] = 0.f; }
            bf16x8 kq[3][4];
#define RT_PT_RD(s_, b_) do { kq[b_][0] = *(const LAS bf16x8*)(L + RT_KL + r * RT_QS + (16 * (s_) + 8 * hh) * 2); kq[b_][1] = *(const LAS bf16x8*)(L + RT_KL + (32 + r) * RT_QS + (16 * (s_) + 8 * hh) * 2); \
                kq[b_][2] = *(const LAS bf16x8*)(L + RT_QL + r * RT_QS + (16 * (s_) + 8 * hh) * 2); kq[b_][3] = *(const LAS bf16x8*)(L + RT_QL + (32 + r) * RT_QS + (16 * (s_) + 8 * hh) * 2); } while (0)
            RT_PT_RD(0, 0); RT_PT_RD(1, 1);
#pragma unroll
            for (int s = 0; s < 8; ++s) {
                if (s + 2 < 8) RT_PT_RD(s + 2, (s + 2) % 3);
                __builtin_amdgcn_sched_barrier(0);
                pt00 = MFMA32(kq[s % 3][0], kq[s % 3][2], pt00); pt01 = MFMA32(kq[s % 3][0], kq[s % 3][3], pt01); pt11 = MFMA32(kq[s % 3][1], kq[s % 3][3], pt11);
                __builtin_amdgcn_sched_barrier(0);
            }
#undef RT_PT_RD
            LDS_BARRIER();
            const LAS unsigned char* vb = L + RT_VL + (4 * hh + q4) * RT_VS + (32 * w + 16 * cb + 4 * p4) * 2;
            s16x4 vr[2][4];
#pragma unroll
            for (int s = 0; s < 2; ++s) { vr[s][0] = TR16(vb + (16 * s) * RT_VS); vr[s][1] = TR16(vb + (16 * s + 8) * RT_VS); vr[s][2] = TR16(vb + (32 + 16 * s) * RT_VS); vr[s][3] = TR16(vb + (32 + 16 * s + 8) * RT_VS); }
            s16x4 qd[3][4];
#define RT_QD_RD(i_, b_) do { const LAS unsigned char* qa = L + RT_QD + r * RT_S8 + (32 * ((i_) >> 1) + 16 * ((i_) & 1) + 4 * hh) * 2; \
                qd[b_][0] = *(const LAS s16x4*)(qa); qd[b_][1] = *(const LAS s16x4*)(qa + 16); qd[b_][2] = *(const LAS s16x4*)(qa + 32 * RT_S8); qd[b_][3] = *(const LAS s16x4*)(qa + 32 * RT_S8 + 16); } while (0)
            RT_QD_RD(0, 0);
            __builtin_amdgcn_sched_barrier(0);
#pragma unroll
            for (int e = 0; e < 16; ++e) { const int jr = (e & 3) + 8 * (e >> 2) + 4 * hh;
                const int dd = r - jr;
                const float fd = dd >= 0 ? exp2f((float)dd * lg) * SC128 : 0.f;
                pt00[e] *= fd; pt11[e] *= fd; pt01[e] *= exp2f((float)(dd + 32) * lg) * SC128; }
            f32x16 o0, o1;
#pragma unroll
            for (int e = 0; e < 16; ++e) { o0[e] = 0.f; o1[e] = 0.f; }
#pragma unroll
            for (int s = 0; s < 2; ++s) {
                const bf16x8 v0 = __builtin_shufflevector(vr[s][0], vr[s][1], 0, 1, 2, 3, 4, 5, 6, 7);
                const bf16x8 v1 = __builtin_shufflevector(vr[s][2], vr[s][3], 0, 1, 2, 3, 4, 5, 6, 7);
                o0 = MFMA32(pack_acc8(pt00, s), v0, o0);
                o1 = MFMA32(pack_acc8(pt01, s), v0, o1);
                o1 = MFMA32(pack_acc8(pt11, s), v1, o1);
            }
            RT_QD_RD(1, 1);
            const LAS unsigned char* kb = L + RT_KT + (8 * hh + q4) * RT_VS + (16 * cb + 4 * p4) * 2;
            const LAS unsigned char* sb2 = L + RT_VSC + (8 * hh + q4) * RT_VS + (32 * w + 16 * cb + 4 * p4) * 2;
            s16x4 ks[2][10];
#define RT_SU_RD(sp_, b_) do { ks[b_][0] = TR16(sb2 + (16 * (sp_)) * RT_VS); ks[b_][1] = TR16(sb2 + (16 * (sp_) + 4) * RT_VS); \
                _Pragma("unroll") for (int t = 0; t < 4; ++t) { ks[b_][2 + 2 * t] = TR16(kb + (16 * (sp_)) * RT_VS + 64 * t); ks[b_][3 + 2 * t] = TR16(kb + (16 * (sp_) + 4) * RT_VS + 64 * t); } } while (0)
#pragma unroll
            for (int i = 0; i < 8; ++i) {
                if (i + 2 < 8) RT_QD_RD(i + 2, (i + 2) % 3); else if (i == 6) RT_SU_RD(0, 0);
                __builtin_amdgcn_sched_barrier(0);
                const bf16x8 sb = pack_acc8(S[i >> 1], i & 1);
                o0 = MFMA32(__builtin_shufflevector(qd[i % 3][0], qd[i % 3][1], 0, 1, 2, 3, 4, 5, 6, 7), sb, o0);
                o1 = MFMA32(__builtin_shufflevector(qd[i % 3][2], qd[i % 3][3], 0, 1, 2, 3, 4, 5, 6, 7), sb, o1);
                __builtin_amdgcn_sched_barrier(0);
            }
#undef RT_QD_RD
            {   float* op = ORET + (mrow0 + (size_t)n * 64) * 1024 + h * 256 + half * 128 + 32 * w + r;
#pragma unroll
                for (int e = 0; e < 16; ++e) { const int ir = (e & 3) + 8 * (e >> 2) + 4 * hh; op[(size_t)ir * 1024] = o0[e]; op[(size_t)(32 + ir) * 1024] = o1[e]; } }
#pragma unroll
            for (int t = 0; t < 4; ++t)
#pragma unroll
                for (int e = 0; e < 16; ++e) S[t][e] *= g64;
#pragma unroll
            for (int sp = 0; sp < 4; ++sp) {
                if (sp + 1 < 4) RT_SU_RD(sp + 1, (sp + 1) & 1);
                __builtin_amdgcn_sched_barrier(0);
                const bf16x8 bv = __builtin_shufflevector(ks[sp & 1][0], ks[sp & 1][1], 0, 1, 2, 3, 4, 5, 6, 7);
#pragma unroll
                for (int t = 0; t < 4; ++t) S[t] = MFMA32(__builtin_shufflevector(ks[sp & 1][2 + 2 * t], ks[sp & 1][3 + 2 * t], 0, 1, 2, 3, 4, 5, 6, 7), bv, S[t]);
                __builtin_amdgcn_sched_barrier(0);
            }
#undef RT_SU_RD
        }
        LDS_BARRIER();
    }
    __builtin_amdgcn_s_setprio(0);
    }
#undef RT_ISSUE
#undef RT_COMMIT_A
#undef RT_COMMIT_B
}

constexpr int LG_XA = 0, LG_XF = 64 * 272, LG_LA = LG_XF + 64 * 132 * 4, LG_SUM = LG_LA + 64 * 132 * 4;
__device__ __forceinline__ void lru_gates_mfma(Frame& F, int j) {
    const int lane = F.lane, wave = F.wave; const int r = lane & 31, hh = lane >> 5;
    const bf16* PROJ = F.BIG; bf16* HL = F.HN; bf16* PC = F.HN + (size_t)M_TOK * 1024; f32x2* LSUM = (f32x2*)(F.ws + WS_LSUM);
    LAS unsigned char* L = F.lds + RING_OFF; LAS float* XF = (LAS float*)(L + LG_XF); LAS float* LA = (LAS float*)(L + LG_LA); LAS f32x2* SUMS = (LAS f32x2*)(L + LG_SUM);
    const int g = F.bx & 7; const int it = wave & 1, ct = wave >> 1;
    const bf16* WLT = (const bf16*)(F.ws + WS_WLT) + (size_t)g * 256 * 128;
    const float* convw = F.in[16] + (size_t)j * 4 * 1024 + g * 128; const float* convb = F.in[17] + (size_t)j * 1024 + g * 128;
    bf16x8 waf[8], wxf[8];
#pragma unroll
    for (int s = 0; s < 8; ++s) { waf[s] = *(const bf16x8*)(WLT + (32 * ct + r) * 128 + 16 * s + 8 * hh); wxf[s] = *(const bf16x8*)(WLT + (128 + 32 * ct + r) * 128 + 16 * s + 8 * hh); }
    const int chl = 32 * ct + r, chg = g * 128 + chl;
    const float ba_c = F.in[19][(size_t)j * 1024 + chg], bx_c = F.in[21][(size_t)j * 1024 + chg], sp8 = 8.0f * softplusf_(-F.in[22][(size_t)j * 1024 + chg]);
    for (int tile = F.bx >> 3; tile < M_TOK / 64; tile += F.G >> 3) {
        const int m0 = tile * 64;
        int tid = F.tid; asm volatile("" : "+v"(tid));
        {   const int tok = tid >> 3, c0 = (tid & 7) * 16; const int m = m0 + tok, t = m & (SEQ - 1);
            float a[16];
#pragma unroll
            for (int i = 0; i < 4; ++i) { const f32x4 b4 = *(const f32x4*)(convb + c0 + 4 * i); a[4 * i] = b4.x; a[4 * i + 1] = b4.y; a[4 * i + 2] = b4.z; a[4 * i + 3] = b4.w; }
            v4u xq[4][2];
#pragma unroll
            for (int jj = 0; jj < 4; ++jj) { const bool ok = (t - 3 + jj) >= 0; const v4u* xp = (const v4u*)(PROJ + (size_t)(ok ? m - 3 + jj : m) * NPROJ + 4096 + g * 128 + c0); xq[jj][0] = xp[0]; xq[jj][1] = xp[1]; }
            __builtin_amdgcn_sched_barrier(0);
#pragma unroll
            for (int jj = 0; jj < 4; ++jj) { const float fz = (t - 3 + jj) >= 0 ? 1.0f : 0.0f; const v4u x0 = xq[jj][0], x1 = xq[jj][1];
                const unsigned xw[8] = {x0.x, x0.y, x0.z, x0.w, x1.x, x1.y, x1.z, x1.w};
#pragma unroll
                for (int i = 0; i < 4; ++i) { const f32x4 w4 = *(const f32x4*)(convw + jj * 1024 + c0 + 4 * i) * fz;
                    a[4 * i] += w4.x * bflo(xw[2 * i]); a[4 * i + 1] += w4.y * bfhi(xw[2 * i]); a[4 * i + 2] += w4.z * bflo(xw[2 * i + 1]); a[4 * i + 3] += w4.w * bfhi(xw[2 * i + 1]); } }
            v4u w0, w1; w0.x = pkbf(a[0], a[1]); w0.y = pkbf(a[2], a[3]); w0.z = pkbf(a[4], a[5]); w0.w = pkbf(a[6], a[7]); w1.x = pkbf(a[8], a[9]); w1.y = pkbf(a[10], a[11]); w1.z = pkbf(a[12], a[13]); w1.w = pkbf(a[14], a[15]);
            *(LAS v4u*)(L + LG_XA + tok * 272 + c0 * 2) = w0; *(LAS v4u*)(L + LG_XA + tok * 272 + c0 * 2 + 16) = w1;
#pragma unroll
            for (int i = 0; i < 4; ++i) *(LAS f32x4*)(XF + tok * 132 + c0 + 4 * i) = (f32x4){a[4 * i], a[4 * i + 1], a[4 * i + 2], a[4 * i + 3]};
        }
        LDS_BARRIER();
        {   f32x16 aa, ax;
#pragma unroll
            for (int e = 0; e < 16; ++e) { aa[e] = 0.f; ax[e] = 0.f; }
#pragma unroll
            for (int s = 0; s < 8; ++s) { const bf16x8 af = *(const LAS bf16x8*)(L + LG_XA + (32 * it + r) * 272 + (16 * s + 8 * hh) * 2); aa = MFMA32(af, waf[s], aa); ax = MFMA32(af, wxf[s], ax); }
#pragma unroll
            for (int e = 0; e < 16; ++e) { const int tok = 32 * it + (e & 3) + 8 * (e >> 2) + 4 * hh;
                const float rr = sigmoidf_(aa[e] + ba_c), ii = sigmoidf_(ax[e] + bx_c); const float la = -rr * sp8; const float x = XF[tok * 132 + chl];
                LA[tok * 132 + chl] = la; XF[tok * 132 + chl] = sqrtf(neg_expm1f_(2.0f * la)) * (ii * x); }
        }
        LDS_BARRIER();
        {
            const int ch = tid & 127, seg = tid >> 7; float hl[16], pl[16]; float hs = 0.f, pr = 1.f;
#pragma unroll
            for (int k = 0; k < 16; ++k) { const int tok = 16 * seg + k; const float a = __expf(LA[tok * 132 + ch]); hs = a * hs + XF[tok * 132 + ch]; pr *= a; hl[k] = hs; pl[k] = pr; }
            SUMS[seg * 128 + ch] = (f32x2){pr, hs};
            LDS_BARRIER();
            float carry = 0.f, pp = 1.f;
            for (int s2 = 0; s2 < seg; ++s2) { const f32x2 sv = SUMS[s2 * 128 + ch]; carry = sv.x * carry + sv.y; pp *= sv.x; }
            bf16* hp = HL + (size_t)(m0 + 16 * seg) * 1024 + g * 128 + ch; bf16* pq = PC + (size_t)(m0 + 16 * seg) * 1024 + g * 128 + ch;
#pragma unroll
            for (int k = 0; k < 16; ++k) { hp[(size_t)k * 1024] = (bf16)f2bf(hl[k] + pl[k] * carry); pq[(size_t)k * 1024] = (bf16)f2bf(pl[k] * pp); }
            if (seg == 3) LSUM[(size_t)tile * 1024 + g * 128 + ch] = (f32x2){pl[15] * pp, hl[15] + pl[15] * carry};
        }
        LDS_BARRIER();
    }
}

constexpr int DP_KH = 0, DP_QH = 64 * 272, DP_KB = 2 * 64 * 272, DP_VB = DP_KB + 64 * 320, DP_MT = DP_VB + 64 * 320, DP_TL = DP_MT + 64 * 272, DP_SC = DP_TL + 64 * 144, DP_CW = DP_SC + 1024;
static_assert(DP_CW + 4 * 3072 * 4 <= LDSCTL_OFF, "DeltaNet prep LDS map");
__device__ __forceinline__ void dn_chunk_prep(Frame& F, int j, int n_lo, int n_hi, int wg0) {
    const int wave = F.wave;
    const bf16* PROJ = F.BIG;
    bf16* NWg = F.BIG + (size_t)M_TOK * NPROJ; bf16* QDg = NWg + (size_t)M_TOK * 1024; bf16* KDg = F.PPB; bf16* Ug = F.PPB + (size_t)M_TOK * 1024;
    bf16* QKg = (bf16*)(F.ws + WS_DQK); float* GTg = (float*)(F.ws + WS_DGT);
    const float* cw = F.in[12] + (size_t)j * 4 * 3072; const float* a_log = F.in[13] + j * 8; const float* dtb = F.in[14] + j * 8;
    LAS unsigned char* L = F.lds + RING_OFF;
    LAS float* Mt = (LAS float*)(L + DP_MT);
    LAS float* bet = (LAS float*)(L + DP_SC); LAS float* gl = bet + 64; LAS float* gcl = gl + 64;
    LAS float* cwl = (LAS float*)(L + DP_CW);
    {   f32x4 wq[6];
#pragma unroll
        for (int u = 0; u < 6; ++u) wq[u] = *(const f32x4*)(cw + 4 * (F.tid + 512 * u));
#pragma unroll
        for (int u = 0; u < 6; ++u) *(LAS f32x4*)(cwl + 4 * (F.tid + 512 * u)) = wq[u]; }
    v4u rg[7];
#define DP_RAWLOAD(idx_, tidp_) do { const int bh_ = (idx_) & 31, n_ = n_lo + ((idx_) >> 5); const size_t m0_ = (size_t)(bh_ >> 3) * SEQ + (size_t)n_ * 64; const int h_ = bh_ & 7; \
        _Pragma("unroll") for (int u = 0; u < 7; ++u) { const int id = (tidp_) + 512 * u; const int row = id / 48, ch = id - row * 48; rg[u] = (v4u){0u, 0u, 0u, 0u}; \
            if (id < 67 * 48 && (n_ > 0 || row >= 3)) rg[u] = *(const v4u*)(PROJ + (m0_ + row - 3) * NPROJ + (ch >> 4) * 1024 + h_ * 128 + (ch & 15) * 8); } } while (0)
    if (F.bx - wg0 < 32 * (n_hi - n_lo)) { int tp = F.tid; asm volatile("" : "+v"(tp)); DP_RAWLOAD(F.bx - wg0, tp); }
    for (int idx = F.bx - wg0; idx < 32 * (n_hi - n_lo); idx += F.G - wg0) {
        const int bh = idx & 31, n = n_lo + (idx >> 5); const int chunk = bh * 128 + n; const int b = bh >> 3, h = bh & 7;
        int tid = F.tid; asm volatile("" : "+v"(tid));
        const int lane = tid & 63; const int r = lane & 31, hh = lane >> 5, q4 = (lane & 15) >> 2, p4 = lane & 3, cb = (lane >> 4) & 1;
        const size_t m0 = (size_t)b * SEQ + (size_t)n * 64;
        const int tok = tid >> 3, c0 = (tid & 7) * 16; const size_t m = m0 + tok; const int t = (int)(m & (SEQ - 1));
        float qv[16], kv[16], vv[16];
        LDS_BARRIER();
        {   LAS unsigned char* raw = L + DP_KB;
#pragma unroll
            for (int u = 0; u < 7; ++u) { const int id = tid + 512 * u; const int row = id / 48, ch = id - row * 48; if (id < 67 * 48) *(LAS v4u*)(raw + row * 784 + ch * 16) = rg[u]; }
            LDS_BARRIER();
#pragma unroll
            for (int ten = 0; ten < 3; ++ten) {
                float a[16];
#pragma unroll
                for (int i = 0; i < 16; ++i) a[i] = 0.f;
                const int col = ten * 1024 + h * 128 + c0;
#pragma unroll 1
                for (int jj = 0; jj < 4; ++jj) { const LAS v4u* xp = (const LAS v4u*)(raw + (tok + jj) * 784 + ten * 256 + c0 * 2); const v4u x0 = xp[0], x1 = xp[1];
                    const unsigned xw[8] = {x0.x, x0.y, x0.z, x0.w, x1.x, x1.y, x1.z, x1.w};
#pragma unroll
                    for (int i = 0; i < 4; ++i) { const f32x4 w4 = *(const LAS f32x4*)(cwl + jj * 3072 + col + 4 * i);
                        a[4 * i] += w4.x * bflo(xw[2 * i]); a[4 * i + 1] += w4.y * bfhi(xw[2 * i]); a[4 * i + 2] += w4.z * bflo(xw[2 * i + 1]); a[4 * i + 3] += w4.w * bfhi(xw[2 * i + 1]); } }
#pragma unroll
                for (int i = 0; i < 16; ++i) { const float s = siluf_(a[i]); if (ten == 0) qv[i] = s; else if (ten == 1) kv[i] = s; else vv[i] = s; }
            }
        }
        {   float sq = 0.f, sk = 0.f;
#pragma unroll
            for (int i = 0; i < 16; ++i) { sq += qv[i] * qv[i]; sk += kv[i] * kv[i]; }
            sq += __shfl_xor(sq, 1); sq += __shfl_xor(sq, 2); sq += __shfl_xor(sq, 4);
            sk += __shfl_xor(sk, 1); sk += __shfl_xor(sk, 2); sk += __shfl_xor(sk, 4);
            const float fq = SC128 / sqrtf(sq + 1e-6f), fk = 1.0f / sqrtf(sk + 1e-6f);
#pragma unroll
            for (int i = 0; i < 16; ++i) { qv[i] *= fq; kv[i] *= fk; } }
        LDS_BARRIER();
        if ((tid & 7) == 0) { const float braw = F.GB[m * 16 + h], araw = F.GB[m * 16 + 8 + h];
            bet[tok] = sigmoidf_(braw); gl[tok] = -expf(a_log[h]) * softplusf_(araw + dtb[h]); }
        {
            v4u w0, w1;
            w0.x = pkbf(kv[0], kv[1]); w0.y = pkbf(kv[2], kv[3]); w0.z = pkbf(kv[4], kv[5]); w0.w = pkbf(kv[6], kv[7]); w1.x = pkbf(kv[8], kv[9]); w1.y = pkbf(kv[10], kv[11]); w1.z = pkbf(kv[12], kv[13]); w1.w = pkbf(kv[14], kv[15]);
            *(LAS v4u*)(L + DP_KH + tok * 272 + c0 * 2) = w0; *(LAS v4u*)(L + DP_KH + tok * 272 + c0 * 2 + 16) = w1;
            w0.x = pkbf(qv[0], qv[1]); w0.y = pkbf(qv[2], qv[3]); w0.z = pkbf(qv[4], qv[5]); w0.w = pkbf(qv[6], qv[7]); w1.x = pkbf(qv[8], qv[9]); w1.y = pkbf(qv[10], qv[11]); w1.z = pkbf(qv[12], qv[13]); w1.w = pkbf(qv[14], qv[15]);
            *(LAS v4u*)(L + DP_QH + tok * 272 + c0 * 2) = w0; *(LAS v4u*)(L + DP_QH + tok * 272 + c0 * 2 + 16) = w1; }
        LDS_BARRIER();
        if (wave == 0) { float v = gl[lane];
#pragma unroll
            for (int o = 1; o < 64; o <<= 1) { const float u = __shfl_up(v, o); if (lane >= o) v += u; }
            gcl[lane] = v; }
        LDS_BARRIER();
        {
            const float gct = gcl[tok], gclast = gcl[63], bt = bet[tok]; const float eg = __expf(gct), egl = __expf(gclast - gct), kbs = bt * eg;
            v4u w0, w1;
#define DP_PACK16(arr, sc) do { w0.x = pkbf(arr[0] * (sc), arr[1] * (sc)); w0.y = pkbf(arr[2] * (sc), arr[3] * (sc)); w0.z = pkbf(arr[4] * (sc), arr[5] * (sc)); w0.w = pkbf(arr[6] * (sc), arr[7] * (sc)); \
            w1.x = pkbf(arr[8] * (sc), arr[9] * (sc)); w1.y = pkbf(arr[10] * (sc), arr[11] * (sc)); w1.z = pkbf(arr[12] * (sc), arr[13] * (sc)); w1.w = pkbf(arr[14] * (sc), arr[15] * (sc)); } while (0)
            DP_PACK16(qv, eg); { v4u* gp = (v4u*)(QDg + m * 1024 + h * 128 + c0); gp[0] = w0; gp[1] = w1; }
            DP_PACK16(kv, egl); { v4u* gp = (v4u*)(KDg + m * 1024 + h * 128 + c0); gp[0] = w0; gp[1] = w1; }
            DP_PACK16(kv, kbs); *(LAS v4u*)(L + DP_KB + tok * 320 + c0 * 2) = w0; *(LAS v4u*)(L + DP_KB + tok * 320 + c0 * 2 + 16) = w1;
            DP_PACK16(vv, bt); *(LAS v4u*)(L + DP_VB + tok * 320 + c0 * 2) = w0; *(LAS v4u*)(L + DP_VB + tok * 320 + c0 * 2 + 16) = w1;
#undef DP_PACK16
            if (tid == 0) GTg[chunk] = __expf(gclast);
        }
        if (wave < 3) { const int it = wave == 0 ? 0 : 1, jt = wave == 2 ? 1 : 0;
            f32x16 acc;
#pragma unroll
            for (int e = 0; e < 16; ++e) acc[e] = 0.f;
#pragma unroll
            for (int s = 0; s < 8; ++s) { const bf16x8 a = *(const LAS bf16x8*)(L + DP_KH + (32 * it + r) * 272 + (16 * s + 8 * hh) * 2), bb = *(const LAS bf16x8*)(L + DP_KH + (32 * jt + r) * 272 + (16 * s + 8 * hh) * 2);
                acc = MFMA32(a, bb, acc); }
            const int jg = 32 * jt + r; const float gcj = gcl[jg];
#pragma unroll
            for (int g4 = 0; g4 < 4; ++g4) { f32x4 o;
#pragma unroll
                for (int e = 0; e < 4; ++e) { const int ig = 32 * it + 8 * g4 + 4 * hh + e; o[e] = ig > jg ? bet[ig] * acc[4 * g4 + e] * __expf(gcl[ig] - gcj) : 0.f; }
                *(LAS f32x4*)(Mt + jg * 68 + 32 * it + 8 * g4 + 4 * hh) = o; }
        } else if (wave == 3) {
#pragma unroll
            for (int g4 = 0; g4 < 4; ++g4) *(LAS f32x4*)(Mt + (32 + r) * 68 + 8 * g4 + 4 * hh) = (f32x4){0.f, 0.f, 0.f, 0.f};
        } else if (wave < 7) { const int jt = wave == 6 ? 1 : 0, it = wave == 4 ? 0 : 1;
            f32x16 acc;
#pragma unroll
            for (int e = 0; e < 16; ++e) acc[e] = 0.f;
#pragma unroll
            for (int s = 0; s < 8; ++s) { const bf16x8 a = *(const LAS bf16x8*)(L + DP_KH + (32 * jt + r) * 272 + (16 * s + 8 * hh) * 2), bb = *(const LAS bf16x8*)(L + DP_QH + (32 * it + r) * 272 + (16 * s + 8 * hh) * 2);
                acc = MFMA32(a, bb, acc); }
            const int ig = 32 * it + r; const float gci = gcl[ig];
#pragma unroll
            for (int g4 = 0; g4 < 4; ++g4) { float o[4];
#pragma unroll
                for (int e = 0; e < 4; ++e) { const int jg = 32 * jt + 8 * g4 + 4 * hh + e; o[e] = ig >= jg ? acc[4 * g4 + e] * __expf(gci - gcl[jg]) : 0.f; }
                v2u w; w.x = pkbf(o[0], o[1]); w.y = pkbf(o[2], o[3]);
                *(v2u*)(QKg + (size_t)chunk * 4096 + ig * 64 + 32 * jt + 8 * g4 + 4 * hh) = w; }
        }
        LDS_BARRIER();
        { const int nidx = idx + F.G - wg0; if (nidx < 32 * (n_hi - n_lo)) DP_RAWLOAD(nidx, tid); }
        if (wave == 0) {
            int ln = lane; asm volatile("" : "+v"(ln));
            const LAS float* MtO; { unsigned mo = (unsigned)(size_t)Mt; asm volatile("" : "+v"(mo)); MtO = (const LAS float*)(size_t)mo; }
            float tr[64];
#pragma unroll
            for (int k = 0; k < 64; ++k) tr[k] = (k == ln) ? 1.f : 0.f;
#pragma unroll
            for (int jc = 62; jc >= 0; --jc) {
                float s0 = 0.f, s1 = 0.f, s2 = 0.f, s3 = 0.f;
#pragma unroll
                for (int k4 = ((jc + 1) & ~3); k4 < 64; k4 += 4) { const f32x4 mv = *(const LAS f32x4*)(MtO + jc * 68 + k4);
                    s0 += tr[k4] * mv.x; s1 += tr[k4 + 1] * mv.y; s2 += tr[k4 + 2] * mv.z; s3 += tr[k4 + 3] * mv.w; }
                tr[jc] -= (s0 + s1) + (s2 + s3);
                asm volatile("" : "+v"(tr[jc]));
            }
#pragma unroll
            for (int k8 = 0; k8 < 8; ++k8) { v4u w; w.x = pkbf(tr[8 * k8], tr[8 * k8 + 1]); w.y = pkbf(tr[8 * k8 + 2], tr[8 * k8 + 3]); w.z = pkbf(tr[8 * k8 + 4], tr[8 * k8 + 5]); w.w = pkbf(tr[8 * k8 + 6], tr[8 * k8 + 7]);
                *(LAS v4u*)(L + DP_TL + ln * 144 + k8 * 16) = w; }
        }
        LDS_BARRIER();
#pragma unroll
        for (int jb = 0; jb < 2; ++jb) { const int job = 2 * wave + jb; const int mat = job >> 3, ft = (job >> 1) & 3, it = job & 1;
            f32x16 acc;
#pragma unroll
            for (int e = 0; e < 16; ++e) acc[e] = 0.f;
            const LAS unsigned char* rb = L + (mat ? DP_VB : DP_KB) + (8 * hh + q4) * 320 + (32 * ft + 16 * cb + 4 * p4) * 2;
#pragma unroll
            for (int s = 0; s < 4; ++s) { const s16x4 al = TR16(rb + (16 * s) * 320), ah = TR16(rb + (16 * s + 4) * 320);
                const bf16x8 tb = *(const LAS bf16x8*)(L + DP_TL + (32 * it + r) * 144 + (16 * s + 8 * hh) * 2);
                acc = MFMA32(__builtin_shufflevector(al, ah, 0, 1, 2, 3, 4, 5, 6, 7), tb, acc); }
            const float sg = mat ? 1.f : -1.f; bf16* dst = (mat ? Ug : NWg) + (m0 + 32 * it + r) * 1024 + h * 128 + 32 * ft + 4 * hh;
#pragma unroll
            for (int g4 = 0; g4 < 4; ++g4) { v2u w; w.x = pkbf(sg * acc[4 * g4], sg * acc[4 * g4 + 1]); w.y = pkbf(sg * acc[4 * g4 + 2], sg * acc[4 * g4 + 3]); *(v2u*)(dst + 8 * g4) = w; }
        }
    }
}
#undef DP_RAWLOAD

constexpr int DR_S8 = 264, DR_ST = 320, DR_SQ = 136;
constexpr int DR_NW = 0, DR_QD = 64 * DR_S8, DR_KD = 2 * 64 * DR_S8, DR_QK = DR_KD + 64 * DR_ST, DR_U = DR_QK + 64 * DR_SQ;
constexpr int DN_C1 = 40, DN_C2 = 84;
__device__ __forceinline__ void dn_chunk_recur(Frame& F, int wg, int n_lo, int n_hi) {
    const int tid = F.tid, lane = F.lane, wave = F.wave; const int b = wg >> 3, h = wg & 7;
    const bf16* NWg = F.BIG + (size_t)M_TOK * NPROJ; const bf16* QDg = NWg + (size_t)M_TOK * 1024; const bf16* KDg = F.PPB; const bf16* Ug = F.PPB + (size_t)M_TOK * 1024;
    const bf16* QKg = (const bf16*)(F.ws + WS_DQK) + (size_t)wg * 128 * 4096; const float* GTg = (const float*)(F.ws + WS_DGT) + wg * 128;
    LAS unsigned char* L = F.lds + RING_OFF;
    const int r = lane & 31, hh = lane >> 5, q4 = (lane & 15) >> 2, p4 = lane & 3, cb = (lane >> 4) & 1;
    const size_t mrow0 = (size_t)b * SEQ;
    const int srow = (tid & 255) >> 4, sch = tid & 15;
    v4u pa[2][4], pb[2][4], pc[2][4], pd[2][4], pe[2][2];
#define DR_ISSUE(SET_, n_) do { _Pragma("unroll") for (int u = 0; u < 4; ++u) { const size_t o = (mrow0 + (size_t)(n_) * 64 + srow + 16 * u) * 1024 + h * 128 + sch * 8; \
            pa[SET_][u] = *(const v4u*)(NWg + o); pb[SET_][u] = *(const v4u*)(QDg + o); pc[SET_][u] = *(const v4u*)(KDg + o); pd[SET_][u] = *(const v4u*)(Ug + o); } \
        _Pragma("unroll") for (int u = 0; u < 2; ++u) pe[SET_][u] = *(const v4u*)(QKg + (size_t)(n_) * 4096 + ((tid & 255) + 256 * u) * 8); } while (0)
#define DR_COMMIT_A(SET_) do { _Pragma("unroll") for (int u = 0; u < 4; ++u) { const int row = srow + 16 * u; \
            *(LAS v2u*)(L + DR_NW + row * DR_S8 + sch * 16) = (v2u){pa[SET_][u].x, pa[SET_][u].y}; *(LAS v2u*)(L + DR_NW + row * DR_S8 + sch * 16 + 8) = (v2u){pa[SET_][u].z, pa[SET_][u].w}; \
            *(LAS v2u*)(L + DR_QD + row * DR_S8 + sch * 16) = (v2u){pb[SET_][u].x, pb[SET_][u].y}; *(LAS v2u*)(L + DR_QD + row * DR_S8 + sch * 16 + 8) = (v2u){pb[SET_][u].z, pb[SET_][u].w}; \
            *(LAS v4u*)(L + DR_U + row * DR_ST + sch * 16) = pd[SET_][u]; } } while (0)
#define DR_COMMIT_B(SET_) do { _Pragma("unroll") for (int u = 0; u < 4; ++u) { const int row = srow + 16 * u; *(LAS v4u*)(L + DR_KD + row * DR_ST + sch * 16) = pc[SET_][u]; } \
        _Pragma("unroll") for (int u = 0; u < 2; ++u) { const int id = (tid & 255) + 256 * u; *(LAS v2u*)(L + DR_QK + (id >> 3) * DR_SQ + (id & 7) * 16) = (v2u){pe[SET_][u].x, pe[SET_][u].y}; *(LAS v2u*)(L + DR_QK + (id >> 3) * DR_SQ + (id & 7) * 16 + 8) = (v2u){pe[SET_][u].z, pe[SET_][u].w}; } } while (0)
    if (wave >= 4) {
        DR_ISSUE(0, n_lo); DR_COMMIT_A(0); DR_COMMIT_B(0); DR_ISSUE(1, n_lo + 1); if (n_lo + 2 < n_hi) DR_ISSUE(0, n_lo + 2);
        LDS_BARRIER();
        for (int n = n_lo; n < n_hi; n += 2) {
            LDS_BARRIER(); DR_COMMIT_A(1);
            LDS_BARRIER(); DR_COMMIT_B(1); if (n + 3 < n_hi) DR_ISSUE(1, n + 3);
            LDS_BARRIER(); if (n + 2 < n_hi) DR_COMMIT_A(0);
            LDS_BARRIER(); if (n + 2 < n_hi) { DR_COMMIT_B(0); if (n + 4 < n_hi) DR_ISSUE(0, n + 4); }
        }
    } else {
        __builtin_amdgcn_s_setprio(3);
        const int w = wave;
        f32x16 S[4];
        float* ssave = (float*)(F.ws + WS_LSUM) + (size_t)1024 * 1024 + ((size_t)(wg * 4 + w) * 64) * 64 + lane;
#pragma unroll
        for (int t = 0; t < 4; ++t)
#pragma unroll
            for (int e = 0; e < 16; ++e) S[t][e] = n_lo > 0 ? ssave[(t * 16 + e) * 64] : 0.f;
        const float gtl = GTg[lane], gth = GTg[64 + lane];
        LDS_BARRIER();
        for (int n = n_lo; n < n_hi; ++n) {
            const float gt = __int_as_float(__builtin_amdgcn_readlane(__float_as_int(n < 64 ? gtl : gth), n & 63));
#define DR_AFR(dst_, base_) do { const LAS unsigned char* p_ = (base_); const s16x4 l0_ = *(const LAS s16x4*)(p_), h0_ = *(const LAS s16x4*)(p_ + 16), l1_ = *(const LAS s16x4*)(p_ + 32 * DR_S8), h1_ = *(const LAS s16x4*)(p_ + 32 * DR_S8 + 16); \
                dst_[0] = __builtin_shufflevector(l0_, h0_, 0, 1, 2, 3, 4, 5, 6, 7); dst_[1] = __builtin_shufflevector(l1_, h1_, 0, 1, 2, 3, 4, 5, 6, 7); } while (0)
            const LAS unsigned char* wbase = L + DR_NW + r * DR_S8 + (4 * hh) * 2; const LAS unsigned char* qbase = L + DR_QD + r * DR_S8 + (4 * hh) * 2;
            bf16x8 fw[2][2], fq[2][2];
            DR_AFR(fw[0], wbase); DR_AFR(fq[0], qbase);
            f32x16 vn0, vn1;
            {   const LAS unsigned char* ub = L + DR_U + (4 * hh + q4) * DR_ST + (32 * w + 16 * cb + 4 * p4) * 2;
                s16x4 u0[4], u1[4];
#pragma unroll
                for (int g4 = 0; g4 < 4; ++g4) { u0[g4] = TR16(ub + (8 * g4) * DR_ST); u1[g4] = TR16(ub + (32 + 8 * g4) * DR_ST); }
#pragma unroll
                for (int g4 = 0; g4 < 4; ++g4)
#pragma unroll
                    for (int e = 0; e < 4; ++e) { vn0[4 * g4 + e] = bf2f((bf16)u0[g4][e]); vn1[4 * g4 + e] = bf2f((bf16)u1[g4][e]); } }
            f32x16 o0, o1;
#pragma unroll
            for (int e = 0; e < 16; ++e) { o0[e] = 0.f; o1[e] = 0.f; }
#pragma unroll
            for (int i = 0; i < 8; ++i) { const int t = i >> 1, s = i & 1;
                if (i + 1 < 8) { const int off = (32 * ((i + 1) >> 1) + 16 * ((i + 1) & 1)) * 2; DR_AFR(fw[(i + 1) & 1], wbase + off); DR_AFR(fq[(i + 1) & 1], qbase + off); }
                const bf16x8 sbv = pack_acc8(S[t], s);
                __builtin_amdgcn_sched_barrier(0);
                vn0 = MFMA32(fw[i & 1][0], sbv, vn0); vn1 = MFMA32(fw[i & 1][1], sbv, vn1);
                o0 = MFMA32(fq[i & 1][0], sbv, o0); o1 = MFMA32(fq[i & 1][1], sbv, o1);
                __builtin_amdgcn_sched_barrier(0);
            }
            LDS_BARRIER();
            bf16x8 qk00[2], qk10[2], qk11[2];
#pragma unroll
            for (int s = 0; s < 2; ++s) { const LAS unsigned char* ka = L + DR_QK + r * DR_SQ + (16 * s + 4 * hh) * 2;
                const s16x4 a00l = *(const LAS s16x4*)(ka), a00h = *(const LAS s16x4*)(ka + 16), a10l = *(const LAS s16x4*)(ka + 32 * DR_SQ), a10h = *(const LAS s16x4*)(ka + 32 * DR_SQ + 16), a11l = *(const LAS s16x4*)(ka + 32 * DR_SQ + 64), a11h = *(const LAS s16x4*)(ka + 32 * DR_SQ + 64 + 16);
                qk00[s] = __builtin_shufflevector(a00l, a00h, 0, 1, 2, 3, 4, 5, 6, 7); qk10[s] = __builtin_shufflevector(a10l, a10h, 0, 1, 2, 3, 4, 5, 6, 7); qk11[s] = __builtin_shufflevector(a11l, a11h, 0, 1, 2, 3, 4, 5, 6, 7); }
            const LAS unsigned char* kb = L + DR_KD + (4 * hh + q4) * DR_ST + (16 * cb + 4 * p4) * 2;
            bf16x8 fk[2][4];
#define DR_KFR(dst_, jt_, s_) do { _Pragma("unroll") for (int t_ = 0; t_ < 4; ++t_) { const s16x4 al_ = TR16(kb + (32 * (jt_) + 16 * (s_)) * DR_ST + 64 * t_), ah_ = TR16(kb + (32 * (jt_) + 16 * (s_) + 8) * DR_ST + 64 * t_); \
                dst_[t_] = __builtin_shufflevector(al_, ah_, 0, 1, 2, 3, 4, 5, 6, 7); } } while (0)
            DR_KFR(fk[0], 0, 0);
            bf16x8 vb[2][2];
#pragma unroll
            for (int s = 0; s < 2; ++s) { vb[0][s] = pack_acc8(vn0, s); vb[1][s] = pack_acc8(vn1, s); }
#pragma unroll
            for (int t = 0; t < 4; ++t)
#pragma unroll
                for (int e = 0; e < 16; ++e) S[t][e] *= gt;
            __builtin_amdgcn_sched_barrier(0);
#pragma unroll
            for (int s = 0; s < 2; ++s) { o0 = MFMA32(qk00[s], vb[0][s], o0); o1 = MFMA32(qk10[s], vb[0][s], o1); o1 = MFMA32(qk11[s], vb[1][s], o1); }
#pragma unroll
            for (int i = 0; i < 4; ++i) { const int jt = i >> 1, s = i & 1;
                if (i + 1 < 4) DR_KFR(fk[(i + 1) & 1], (i + 1) >> 1, (i + 1) & 1);
                __builtin_amdgcn_sched_barrier(0);
#pragma unroll
                for (int t = 0; t < 4; ++t) S[t] = MFMA32(fk[i & 1][t], vb[jt][s], S[t]);
                __builtin_amdgcn_sched_barrier(0);
            }
            {   bf16* op = F.MIX + (mrow0 + (size_t)n * 64) * DM + h * 128 + 32 * w + r;
#pragma unroll
                for (int e = 0; e < 16; ++e) { const int ir = (e & 3) + 8 * (e >> 2) + 4 * hh; op[(size_t)ir * DM] = (bf16)(pkbf(o0[e], 0.f) & 0xffffu); op[(size_t)(32 + ir) * DM] = (bf16)(pkbf(o1[e], 0.f) & 0xffffu); } }
#undef DR_AFR
#undef DR_KFR
            LDS_BARRIER();
        }
        if (n_hi < SEQ / 64) {
#pragma unroll
            for (int t = 0; t < 4; ++t)
#pragma unroll
                for (int e = 0; e < 16; ++e) ssave[(t * 16 + e) * 64] = S[t][e];
        }
        __builtin_amdgcn_s_setprio(0);
    }
#undef DR_ISSUE
#undef DR_COMMIT_A
#undef DR_COMMIT_B
}

constexpr int SWA_VSTRIDE = 288;
__device__ __forceinline__ void swa_mfma(Frame& F) {
    const int wave = F.wave;
    const bf16* PROJ = F.BIG;
    bf16* OB[3] = {F.PPB, F.PPB + (size_t)M_TOK * 1024, F.BIG + (size_t)M_TOK * NPROJ};
    float* LSE = (float*)(F.BIG + (size_t)M_TOK * NPROJ + (size_t)M_TOK * 1024);
    LAS unsigned char* vl = F.lds + RING_OFF;
    LAS unsigned char* kl = vl + 272 * SWA_VSTRIDE;
    v4u kreg[9], vreg[9]; bf16x8 qfn[4];
#define SW_LOAD(unit_, tid_) do { const int bh_ = (unit_) / 192, rem_ = (unit_) - bh_ * 192; const int br_ = rem_ >> 6, blk_ = rem_ & 63; const int b_ = bh_ >> 3, h_ = bh_ & 7; const int dsh_ = 2 * br_, d_ = 1 << dsh_; \
        const int nper_ = 64 >> dsh_; const int r_ = blk_ / nper_, n_ = blk_ - r_ * nper_; const size_t rowbase_ = (size_t)b_ * SEQ + r_; const int sub0_ = 128 * n_ - 144; \
        _Pragma("unroll") for (int u = 0; u < 9; ++u) { const int id = (tid_) + 512 * u; const int row = id >> 4, ch = id & 15; const int ks = sub0_ + row; kreg[u] = (v4u){0u, 0u, 0u, 0u}; vreg[u] = (v4u){0u, 0u, 0u, 0u}; \
            if (id < 272 * 16 && ks >= 0) { const bf16* rp = PROJ + (rowbase_ + (size_t)ks * d_) * NPROJ + h_ * 128 + ch * 8; kreg[u] = *(const v4u*)(rp + 1024); vreg[u] = *(const v4u*)(rp + 2048); } } \
        { const int lane_ = (tid_) & 63; const size_t mq_ = rowbase_ + (size_t)(128 * n_ + 16 * wave + (lane_ & 15)) * d_; const bf16* qp = PROJ + mq_ * NPROJ + h_ * 128 + 8 * (lane_ >> 4); \
          _Pragma("unroll") for (int s = 0; s < 4; ++s) qfn[s] = *(const bf16x8*)(qp + 32 * s); } } while (0)
    if (F.bx - 32 < 32 * 192) { int tp = F.tid; asm volatile("" : "+v"(tp)); SW_LOAD(F.bx - 32, tp); }
    for (int unit = F.bx - 32; unit < 32 * 192; unit += F.G - 32) {
        int tid = F.tid; asm volatile("" : "+v"(tid));
        const int lane = tid & 63; const int li = lane & 15, g = lane >> 4;
        const int bh = unit / 192, rem = unit - bh * 192; const int br = rem >> 6, blk = rem & 63;
        const int b = bh >> 3, h = bh & 7; const int dsh = 2 * br, d = 1 << dsh; const int nper = 64 >> dsh; const int r = blk / nper, n = blk - r * nper;
        const size_t rowbase = (size_t)b * SEQ + r;
        const int sub0 = 128 * n - 144;
        LDS_BARRIER();
        {
#pragma unroll
            for (int u = 0; u < 9; ++u) { const int id = tid + 512 * u; const int row = id >> 4, ch = id & 15;
                if (id < 272 * 16) { *(LAS v4u*)(kl + row * 272 + ch * 16) = kreg[u]; *(LAS v4u*)(vl + row * SWA_VSTRIDE + ch * 16) = vreg[u]; } }
        }
        bf16x8 qf[4];
#pragma unroll
        for (int s = 0; s < 4; ++s) qf[s] = qfn[s];
        LDS_BARRIER();
        { const int nu = unit + F.G - 32; if (nu < 32 * 192) SW_LOAD(nu, tid); }
        const int q0w = 128 * n + 16 * wave;
        const size_t mq = rowbase + (size_t)(q0w + li) * d;
        f32x4 sacc[10];
        {   const LAS unsigned char* kbase = kl + (16 * wave + li) * 272 + 16 * g;
#pragma unroll
            for (int kt = 0; kt < 10; ++kt) { f32x4 acc = (f32x4){0.f, 0.f, 0.f, 0.f};
#pragma unroll
                for (int s = 0; s < 4; ++s) { const bf16x8 kf = *(const LAS bf16x8*)(kbase + (16 * kt) * 272 + 64 * s); acc = __builtin_amdgcn_mfma_f32_16x16x32_bf16(kf, qf[s], acc, 0, 0, 0); }
                sacc[kt] = acc; }
        }
        const float slope_d = exp2f(-(float)(h + 1)) * (float)d;
        float mx = -INFINITY;
#pragma unroll
        for (int kt = 0; kt < 10; ++kt)
#pragma unroll
            for (int e = 0; e < 4; ++e) { const int rel = 144 + li - 16 * kt - 4 * g - e; const bool valid = (rel >= 0) && (rel <= 128) && (q0w + li - rel >= 0);
                const float sv = valid ? sacc[kt][e] * SC128 - slope_d * (float)rel : -INFINITY; sacc[kt][e] = sv; mx = fmaxf(mx, sv); }
        mx = fmaxf(mx, __shfl_xor(mx, 16)); mx = fmaxf(mx, __shfl_xor(mx, 32));
        float l = 0.f;
#pragma unroll
        for (int kt = 0; kt < 10; ++kt)
#pragma unroll
            for (int e = 0; e < 4; ++e) { const float p = __expf(sacc[kt][e] - mx); sacc[kt][e] = p; l += p; }
        l += __shfl_xor(l, 16); l += __shfl_xor(l, 32);
        f32x4 oacc[8];
#pragma unroll
        for (int dt = 0; dt < 8; ++dt) oacc[dt] = (f32x4){0.f, 0.f, 0.f, 0.f};
        const LAS unsigned char* vbase = vl + (16 * wave + 4 * g + (li >> 2)) * SWA_VSTRIDE + (li & 3) * 8;
#pragma unroll
        for (int sp = 0; sp < 5; ++sp) {
            v4u pw; pw.x = pk2(sacc[2 * sp][0], sacc[2 * sp][1]); pw.y = pk2(sacc[2 * sp][2], sacc[2 * sp][3]); pw.z = pk2(sacc[2 * sp + 1][0], sacc[2 * sp + 1][1]); pw.w = pk2(sacc[2 * sp + 1][2], sacc[2 * sp + 1][3]);
            const bf16x8 pf = __builtin_bit_cast(bf16x8, pw);
#pragma unroll
            for (int dt = 0; dt < 8; ++dt) {
                const s16x4 lo = __builtin_amdgcn_ds_read_tr16_b64_v4i16((LAS s16x4*)(vbase + (32 * sp) * SWA_VSTRIDE + dt * 32));
                const s16x4 hi = __builtin_amdgcn_ds_read_tr16_b64_v4i16((LAS s16x4*)(vbase + (32 * sp + 16) * SWA_VSTRIDE + dt * 32));
                const bf16x8 af = __builtin_shufflevector(lo, hi, 0, 1, 2, 3, 4, 5, 6, 7);
                oacc[dt] = __builtin_amdgcn_mfma_f32_16x16x32_bf16(af, pf, oacc[dt], 0, 0, 0);
            }
        }
        const float il = 1.0f / l;
        bf16* op = OB[br] + mq * 1024 + h * 128 + 4 * g;
#pragma unroll
        for (int dt = 0; dt < 8; ++dt) { v2u w; w.x = pk2(oacc[dt][0] * il, oacc[dt][1] * il); w.y = pk2(oacc[dt][2] * il, oacc[dt][3] * il); *(v2u*)(op + 16 * dt) = w; }
        if (g == 0) LSE[((size_t)br * M_TOK + mq) * 8 + h] = mx + __logf(l);
    }
}
#undef SW_LOAD

__device__ __forceinline__ void swa_merge(Frame& F) {
    const int gw = F.bx * NWAVES + F.wave, NGW = F.G * NWAVES, lane = F.lane; const int h = lane >> 3, c0 = (lane & 7) * 16;
    const bf16* OB0 = F.PPB; const bf16* OB1 = F.PPB + (size_t)M_TOK * 1024; const bf16* OB2 = F.BIG + (size_t)M_TOK * NPROJ;
    const float* LSE = (const float*)(F.BIG + (size_t)M_TOK * NPROJ + (size_t)M_TOK * 1024);
    for (int m = gw; m < M_TOK; m += NGW) {
        const size_t o = (size_t)m * 1024 + h * 128 + c0;
        const v4u a0 = *(const v4u*)(OB0 + o), a1 = *(const v4u*)(OB0 + o + 8), b0 = *(const v4u*)(OB1 + o), b1 = *(const v4u*)(OB1 + o + 8), c0v = *(const v4u*)(OB2 + o), c1v = *(const v4u*)(OB2 + o + 8);
        const float l0 = LSE[((size_t)0 * M_TOK + m) * 8 + h], l1 = LSE[((size_t)1 * M_TOK + m) * 8 + h], l2 = LSE[((size_t)2 * M_TOK + m) * 8 + h]; __builtin_amdgcn_sched_barrier(0);
        const float mx = fmaxf(l0, fmaxf(l1, l2)); float e0 = __expf(l0 - mx), e1 = __expf(l1 - mx), e2 = __expf(l2 - mx); const float inv = 1.0f / (e0 + e1 + e2); e0 *= inv; e1 *= inv; e2 *= inv;
        float x[16], y[16], z[16]; unpack8(a0, x); unpack8(a1, x + 8); unpack8(b0, y); unpack8(b1, y + 8); unpack8(c0v, z); unpack8(c1v, z + 8);
#pragma unroll
        for (int i = 0; i < 16; ++i) x[i] = e0 * x[i] + e1 * y[i] + e2 * z[i];
        v4u* dst = (v4u*)(F.MIX + (size_t)m * DM + h * 128 + c0); dst[0] = pack8(x); dst[1] = pack8(x + 8);
    }
}

__device__ __forceinline__ void ret_final(Frame& F) {
    const int gw = F.bx * NWAVES + F.wave, NGW = F.G * NWAVES, lane = F.lane; const int h = lane >> 4, c0 = (lane & 15) * 16;
    const float* ORET = (const float*)F.HN; const bf16* PROJ = F.BIG;
    for (int m = gw; m < M_TOK; m += NGW) {
        const f32x4* xp = (const f32x4*)(ORET + (size_t)m * 1024 + h * 256 + c0); const v4u* gp = (const v4u*)(PROJ + (size_t)m * NPROJ + 5120 + h * 256 + c0);
        const f32x4 x0 = xp[0], x1 = xp[1], x2 = xp[2], x3 = xp[3]; const v4u g0 = gp[0], g1 = gp[1]; __builtin_amdgcn_sched_barrier(0);
        float x[16] = {x0.x, x0.y, x0.z, x0.w, x1.x, x1.y, x1.z, x1.w, x2.x, x2.y, x2.z, x2.w, x3.x, x3.y, x3.z, x3.w}; float g[16]; unpack8(g0, g); unpack8(g1, g + 8);
        float s = 0.f;
#pragma unroll
        for (int i = 0; i < 16; ++i) s += x[i];
        const float mu = row16_sum(s) * (1.0f / 256.0f); float q = 0.f;
#pragma unroll
        for (int i = 0; i < 16; ++i) { x[i] -= mu; q += x[i] * x[i]; }
        const float r = 1.0f / sqrtf(row16_sum(q) * (1.0f / 256.0f) + GN_EPS);
#pragma unroll
        for (int i = 0; i < 16; ++i) x[i] = x[i] * r * siluf_(g[i]);
        v4u* dst = (v4u*)(F.MIX + (size_t)m * DM + 1024 + h * 256 + c0); dst[0] = pack8(x); dst[1] = pack8(x + 8);
    }
}
__device__ __forceinline__ void final_norm(Frame& F) {
    const int gw = F.bx * NWAVES + F.wave, NGW = F.G * NWAVES, lane = F.lane; const float* lnw = F.in[9];
    float* tmp = (float*)F.HN;
    f32x4 lw[8];
#pragma unroll
    for (int j = 0; j < 8; ++j) lw[j] = ((const f32x4*)lnw)[lane + 64 * j];
    for (int rp = gw; rp < M_TOK / 2; rp += NGW) {
        v2u w_[2][8];
#pragma unroll
        for (int r = 0; r < 2; ++r)
#pragma unroll
            for (int j = 0; j < 8; ++j) w_[r][j] = ((const v2u*)(F.H16 + ((size_t)2 * rp + r) * DM))[lane + 64 * j];
        __builtin_amdgcn_sched_barrier(0);
#pragma unroll
        for (int r = 0; r < 2; ++r) { const int row = 2 * rp + r; f32x4 v[8]; float ss = 0.f;
#pragma unroll
            for (int j = 0; j < 8; ++j) { v[j] = (f32x4){bflo(w_[r][j].x), bfhi(w_[r][j].x), bflo(w_[r][j].y), bfhi(w_[r][j].y)}; ss += (v[j].x * v[j].x + v[j].y * v[j].y) + (v[j].z * v[j].z + v[j].w * v[j].w); }
            ss = wave_sum(ss); const float rstd = 1.0f / sqrtf(ss * (1.0f / DM) + RMS_EPS);
            f32x4* o = (f32x4*)(F.out + (size_t)row * DM) + lane; (void)tmp;
#pragma unroll
            for (int j = 0; j < 8; ++j) o[64 * j] = v[j] * rstd * lw[j]; }
    }
}
__device__ __forceinline__ void final_copy(Frame& F) {
    const f32x4* src = (const f32x4*)F.HN; f32x4* dst = (f32x4*)(F.out + (size_t)(M_TOK / 2) * DM);
    const size_t n4 = (size_t)(M_TOK / 2) * DM / 4, stride = (size_t)F.G * 512;
    for (size_t i = (size_t)F.bx * 512 + F.tid; i < n4; i += 8 * stride) { f32x4 t_[8];
#pragma unroll
        for (int u = 0; u < 8; ++u) t_[u] = src[i + u * stride];
        __builtin_amdgcn_sched_barrier(0);
#pragma unroll
        for (int u = 0; u < 8; ++u) dst[i + u * stride] = t_[u]; }
}

#ifndef REP_T1
#define REP_T1 1
#endif
#ifndef REP_G1
#define REP_G1 1
#endif
#ifndef REP_EM1
#define REP_EM1 1
#endif
#ifndef REP_EM2
#define REP_EM2 1
#endif
#ifndef REP_OM1
#define REP_OM1 1
#endif
#ifndef REP_T2
#define REP_T2 1
#endif
#ifndef REP_G3
#define REP_G3 1
#endif
#ifndef REP_PP
#define REP_PP 1
#endif
#define REPEAT(n_) _Pragma("unroll 1") for (int rep_ = 0; rep_ < (n_); ++rep_)
#define REFRESH_F() do { int t_ = threadIdx.x; asm volatile("" : "+v"(t_)); F.tid = t_; F.lane = t_ & 63; F.wave = __builtin_amdgcn_readfirstlane(t_ >> 6); int b_ = blockIdx.x; asm volatile("" : "+s"(b_)); F.bx = b_; } while (0)
constexpr int PH_PER_LAYER = 11, NPH = DEPTH * PH_PER_LAYER + 2;
__global__ void __launch_bounds__(NWAVES * 64, 2) trunk_fwd(Args args) {
    extern __shared__ __attribute__((aligned(16))) unsigned char lds_raw[];
    Frame F;
    F.lds = (LAS unsigned char*)lds_raw;
    F.tid = threadIdx.x; F.lane = F.tid & 63; F.wave = __builtin_amdgcn_readfirstlane(F.tid >> 6);
    F.G = gridDim.x; F.bx = blockIdx.x;
    F.in = args.in; F.out = args.out;
    unsigned char* ws = args.ws; F.ws = ws; F.H16 = (bf16*)(ws + WS_PP2);
    F.PP2 = (bf16*)((unsigned char*)args.out + (size_t)M_TOK * DM * 2);
    F.WIN = (bf16*)(ws + WS_WIN); F.WOUT = (bf16*)(ws + WS_WOUT); F.WUP = (bf16*)(ws + WS_WUP); F.WDOWN = (bf16*)(ws + WS_WDOWN); F.WGATE = (bf16*)(ws + WS_WGATE); F.WPP = (bf16*)(ws + WS_WPP);
    F.PB = (bf16*)(ws + WS_PB); F.GB = (float*)(ws + WS_GB); F.HN = (bf16*)(ws + WS_HN); F.MIX = (bf16*)(ws + WS_MIX); F.BIG = (bf16*)(ws + WS_BIG); F.PPB = (bf16*)(ws + WS_PPB);
    for (int u = F.tid; u < (LDS_BYTES - LDSCTL_OFF) / 4; u += NWAVES * 64) ((LAS unsigned*)(F.lds + LDSCTL_OFF))[u] = 0u;
    __syncthreads();
    const int lo = args.ph_lo, hi = args.ph_hi;
    XcdBarrier bar; bar.bar = (unsigned*)(ws + WS_CTL) + CW_BAR; bar.x = 0; bar.st = nullptr;
    if (hi - lo > 1) bar = xcd_barrier_post((unsigned*)(ws + WS_CTL) + CW_BAR, (volatile LAS unsigned*)(F.lds + MISC_OFF) + 8);
#define IN(k) (lo <= (k) && (k) < hi)
#ifdef REP_BAR
#define SEAM(k) do { if (IN(k) && IN((k) + 1)) { xcd_barrier(bar); xcd_barrier(bar); } } while (0)
#else
#define SEAM(k) do { if (IN(k) && IN((k) + 1)) xcd_barrier(bar); } while (0)
#endif
    LAS unsigned char* ring = F.lds + RING_OFF;

    for (int layer = 0; layer < LAYER_HI; ++layer) {
        const int P = layer * PH_PER_LAYER; const int j = layer >> 1; const bool even = (layer & 1) == 0;
        { int t_ = threadIdx.x; asm volatile("" : "+v"(t_)); F.tid = t_; F.lane = t_ & 63; F.wave = __builtin_amdgcn_readfirstlane(t_ >> 6); int b_ = blockIdx.x; asm volatile("" : "+s"(b_)); F.bx = b_; }
        if (IN(P + 0)) { REPEAT(REP_T1) { phase_t1(F, layer); __syncthreads(); } } SEAM(P + 0);
        if (IN(P + 1)) REPEAT(REP_G1) { pg8::Gemm g{F.HN, even ? F.WIN : (bf16*)(F.ws + WS_WIN2), M_TOK, NPROJ, DM}; pg8::StaticOrder S; S.init(M_TOK, NPROJ, F.G, F.bx);
            pg8::EpiB16<0> E{F.BIG, NPROJ, nullptr}; pg8::gemm_phase<pg8::EpiB16<0>, pg8::StaticOrder, true, true>(ring, g, S, E); } SEAM(P + 1);
        if (IN(P + 2)) {
            if (even) {
 REPEAT(REP_EM1) { REFRESH_F(); dn_chunk_prep(F, j, 0, DN_C1, 0); __syncthreads(); lru_gates_mfma(F, j); __syncthreads(); }
 }
            else {
 REPEAT(REP_OM1) { REFRESH_F(); if (F.bx < 32) ret_chunk(F, F.bx); else { swa_mfma(F); __syncthreads(); { pg8::Gemm g{F.PB, F.WPP, M_TOK, DM, PLE}; pg8::StaticOrder S; S.init(M_TOK, DM, F.G - 32, F.bx - 32); pg8::EpiB16<0> E{F.PP2, DM, nullptr}; pg8::gemm_phase<pg8::EpiB16<0>, pg8::StaticOrder, true, true>(ring, g, S, E); } __syncthreads(); convert_w_rest(F, layer, 32); if (layer + 1 < DEPTH) convert_w_in(F, layer + 1, 32); } __syncthreads(); }
 }
        } SEAM(P + 2);
        if (IN(P + 3)) {
            if (even) {
 { int lo = 0, mid = DN_C1, hi = DN_C2;
   for (int st = 0; st < 2; ++st) { REFRESH_F(); asm volatile("" : "+s"(lo), "+s"(mid), "+s"(hi));
       if (F.bx < 32) dn_chunk_recur(F, F.bx, lo, mid); else dn_chunk_prep(F, j, mid, hi, 32);
       xcd_barrier(bar); lo = mid; mid = hi; hi = 128; } }
 REPEAT(REP_EM2) { REFRESH_F(); if (F.bx < 32) dn_chunk_recur(F, F.bx, DN_C2, 128); else { if (F.bx >= 128 && F.bx < 136) lru_carry(F, (F.bx - 128) * 512 + F.tid); __syncthreads(); { pg8::Gemm g{F.PB, F.WPP, M_TOK, DM, PLE}; pg8::StaticOrder S; S.init(M_TOK, DM, F.G - 32, F.bx - 32); pg8::EpiB16<0> E{F.PP2, DM, nullptr}; pg8::gemm_phase<pg8::EpiB16<0>, pg8::StaticOrder, true, true>(ring, g, S, E); } __syncthreads(); convert_w_rest(F, layer, 32); if (layer + 1 < DEPTH) convert_w_in(F, layer + 1, 32); } __syncthreads(); }
 }
        } if (even) SEAM(P + 3);
        if (IN(P + 4)) { if (even) { dn_final(F, j); lru_final(F); } else { ret_final(F); swa_merge(F); } } SEAM(P + 4);
        if (IN(P + 5)) {
            { pg8::Gemm g{F.MIX, F.WOUT, M_TOK, DM, DM}; pg8::StaticOrder S; S.init(M_TOK, DM, F.G, F.bx);
              pg8::EpiResid E{layer == 0 ? F.in[0] : nullptr, F.H16, F.H16, DM, (float*)(F.ws + WS_SS), nullptr}; pg8::gemm_phase<pg8::EpiResid, pg8::StaticOrder, true, true>(ring, g, S, E); }
#ifdef REP_G2
            { pg8::Gemm g{F.MIX, F.WOUT, M_TOK, DM, DM}; pg8::StaticOrder S; S.init(M_TOK, DM, F.G, F.bx); pg8::EpiResid E{F.in[0], nullptr, F.BIG, DM, nullptr, nullptr}; pg8::gemm_phase<pg8::EpiResid, pg8::StaticOrder, true, true>(ring, g, S, E); }
#endif
        } SEAM(P + 5);
        if (IN(P + 7)) REPEAT(REP_G3) { pg8::Gemm g{F.H16, F.WUP, M_TOK, DFF, DM}; pg8::StaticOrder S; S.init(M_TOK, DFF, F.G, F.bx);
            pg8::EpiB16<1> E{F.BIG, DFF, nullptr}; pg8::gemm_phase<pg8::EpiB16<1>, pg8::StaticOrder, true, true>(ring, g, S, E); } SEAM(P + 7);
        if (IN(P + 8)) { pg8::Gemm g{F.BIG, F.WDOWN, M_TOK, DM, DFF}; pg8::StaticOrder S; S.init(M_TOK, DM, F.G, F.bx);
            pg8::EpiResid E{nullptr, F.H16, F.HN, DM, (float*)(F.ws + WS_SS) + (size_t)M_TOK * 32, (const float*)(F.ws + WS_SS)}; pg8::gemm_phase<pg8::EpiResid, pg8::StaticOrder, true, true>(ring, g, S, E);
#ifdef REP_G4
            { pg8::EpiResid E2{F.in[0], nullptr, F.MIX, DM, nullptr, nullptr}; pg8::gemm_phase<pg8::EpiResid, pg8::StaticOrder, true, true>(ring, g, S, E2); }
#endif
            } SEAM(P + 8);
        if (IN(P + 10)) { pg8::Gemm g{F.HN, F.WGATE, M_TOK, DM, DM}; pg8::StaticOrder S; S.init(M_TOK, DM, F.G, F.bx);
            pg8::EpiGate E{F.HN, F.H16, F.PP2, DM, (const float*)(F.ws + WS_SS) + (size_t)M_TOK * 32}; pg8::gemm_phase<pg8::EpiGate, pg8::StaticOrder, true, true>(ring, g, S, E);
#ifdef REP_G5
            { pg8::EpiGate E2{F.HN, F.MIX, F.PP2, DM, nullptr}; pg8::gemm_phase<pg8::EpiGate, pg8::StaticOrder, true, true>(ring, g, S, E2); }
#endif
            } SEAM(P + 10);
    }
    if (IN(NPH - 2)) final_norm(F);
    SEAM(NPH - 2);
#undef IN
#undef SEAM
}

extern "C" void kernel_launch(void* const* d_in, const int* in_sizes, int n_in, void* d_out, int out_size, void* d_ws, size_t ws_size, hipStream_t stream) {
    static int grid = 0;
    if (grid == 0) {
        if (n_in != 25 || in_sizes[0] != M_TOK * DM || out_size != M_TOK * DM || ws_size < WS_END) {
            fprintf(stderr, "kernel_launch: unexpected shapes (n_in %d, in0 %d, out %d, ws %zu, need %zu); nothing launched\n", n_in, n_in > 0 ? in_sizes[0] : -1, out_size, ws_size, (size_t)WS_END); grid = -1; return; }
        int dev = 0, cus = 0;
        if (hipGetDevice(&dev) != hipSuccess || hipDeviceGetAttribute(&cus, hipDeviceAttributeMultiprocessorCount, dev) != hipSuccess) { grid = -1; return; }
        if (hipFuncSetAttribute((const void*)trunk_fwd, hipFuncAttributeMaxDynamicSharedMemorySize, LDS_BYTES) != hipSuccess) { fprintf(stderr, "kernel_launch: hipFuncSetAttribute failed\n"); grid = -1; return; }
        int per_cu = 0;
        if (hipOccupancyMaxActiveBlocksPerMultiprocessor(&per_cu, (const void*)trunk_fwd, NWAVES * 64, LDS_BYTES) != hipSuccess || per_cu < 1) { fprintf(stderr, "kernel_launch: occupancy query says %d blocks per CU\n", per_cu); }
        (void)hipGetLastError();
        grid = cus;
    }
    if (grid < 0) return;
    if (hipMemsetAsync((char*)d_ws + WS_CTL, 0, 65536, stream) != hipSuccess) return;
    Args a{};
    for (int i = 0; i < 25; ++i) a.in[i] = (const float*)d_in[i];
    a.out = (float*)d_out; a.ws = (unsigned char*)d_ws;
#if ONE_LAUNCH
    a.ph_lo = 0; a.ph_hi = NPH;
    hipLaunchKernelGGL(trunk_fwd, dim3(grid), dim3(NWAVES * 64), LDS_BYTES, stream, a);
#else
    for (int ph = 0; ph < NPH; ++ph) {
        const int pl = ph % PH_PER_LAYER, layer = ph / PH_PER_LAYER;
        if (ph < NPH - 2 && pl == 3 && (layer & 1)) continue;
        a.ph_lo = ph; a.ph_hi = ph + 1;
        hipLaunchKernelGGL(trunk_fwd, dim3(grid), dim3(NWAVES * 64), LDS_BYTES, stream, a);
    }
#endif
}
```

```cpp
#include <hip/hip_runtime.h>
#include <cstdio>
#include <cstdint>
#include <cmath>

#ifndef ONE_LAUNCH
#define ONE_LAUNCH 1
#endif

namespace pg8 {
#define PG8_LAS __attribute__((address_space(3)))
typedef unsigned short bf16_t;
typedef short bf16x8 __attribute__((ext_vector_type(8)));
typedef float f32x4 __attribute__((ext_vector_type(4)));
typedef unsigned u32x4 __attribute__((ext_vector_type(4)));
constexpr int BM = 256, BK = 64, HALF = 128, HTB = HALF * BK * 2  , STAGE_BYTES = 8 * HTB, NXCD = 8, WGM = 8;

__host__ __device__ __forceinline__ int lds_byte(int r, int c) { const int st = (r >> 4) * 2 + (c >> 5), rr = r & 15, cc = c & 31, ob = rr * 64 + cc * 2; return st * 1024 + (ob ^ (((ob >> 9) & 1) << 5)); }
__host__ __device__ __forceinline__ void stage_rc(int b, int& R, int& C) { const int st = b / 1024, sb = b % 1024, swz = sb ^ (((sb >> 9) & 1) << 5); R = (st >> 1) * 16 + swz / 64; C = (st & 1) * 32 + (swz % 64) / 2; }
__host__ __device__ __forceinline__ int perm32(int rho) { const int n = rho >> 4, i = rho & 15; return 8 * (i >> 2) + 4 * n + (i & 3); }

struct Unit { int pm, pn; };
struct Gemm { const bf16_t* A; const bf16_t* Bt; int M, N, K; };

struct StaticOrder {
    int nM, nN, nwg, G, c;
    __host__ __device__ void init(int M, int N, int G_, int c_) { nM = M / BM; nN = N / BM; nwg = nM * nN; G = G_; c = c_; }
    __host__ __device__ bool next(int i, Unit& u) const {
        const long L = (long)i * G + c; if (L >= nwg) return false;
        int wgid = (int)L; { const int q = nwg / NXCD, r = nwg % NXCD, xcd = wgid % NXCD, off = wgid / NXCD; wgid = (xcd < r ? xcd * (q + 1) : r * (q + 1) + (xcd - r) * q) + off; }
        const int nig = WGM * nN, gid = wgid / nig, fm = gid * WGM, gsz = (nM - fm) < WGM ? (nM - fm) : WGM;
        u.pm = fm + ((wgid % nig) % gsz); u.pn = (wgid % nig) / gsz; return true;
    }
    __device__ __forceinline__ void a_ready(const Unit&) const {}
    __device__ __forceinline__ void done(const Unit&) const {}
};

__device__ __forceinline__ unsigned cvt_pk_bf16(float lo, float hi) { unsigned r; asm volatile("v_cvt_pk_bf16_f32 %0, %1, %2" : "=v"(r) : "v"(lo), "v"(hi)); return r; }

__device__ __forceinline__ float row_rstd32(const float* ssp, int row, int fq) {
    const f32x4 a = *(const f32x4*)(ssp + (size_t)row * 32 + fq * 8), b = *(const f32x4*)(ssp + (size_t)row * 32 + fq * 8 + 4);
    float s = ((a[0] + a[1]) + (a[2] + a[3])) + ((b[0] + b[1]) + (b[2] + b[3]));
    s += __shfl_xor(s, 16); s += __shfl_xor(s, 32);
    return 1.0f / sqrtf(s * (1.0f / 2048.0f) + 1e-6f);
}
__device__ __forceinline__ void rows_rstd32(const float* ssp, int row0, int fq, float (&rs)[2][4]) {
    f32x4 pa[2][4][2];
#pragma unroll
    for (int ai = 0; ai < 2; ++ai)
#pragma unroll
        for (int m = 0; m < 4; ++m) { const float* p = ssp + (size_t)(row0 + ai * HALF + m * 16) * 32 + fq * 8; pa[ai][m][0] = *(const f32x4*)p; pa[ai][m][1] = *(const f32x4*)(p + 4); }
    __builtin_amdgcn_sched_barrier(0);
#pragma unroll
    for (int ai = 0; ai < 2; ++ai)
#pragma unroll
        for (int m = 0; m < 4; ++m) { const f32x4 a = pa[ai][m][0], b = pa[ai][m][1]; float s = ((a[0] + a[1]) + (a[2] + a[3])) + ((b[0] + b[1]) + (b[2] + b[3]));
            s += __shfl_xor(s, 16); s += __shfl_xor(s, 32); rs[ai][m] = 1.0f / sqrtf(s * (1.0f / 2048.0f) + 1e-6f); }
}
template <int ACT> struct EpiB16 {
    static constexpr bool PERM = true, AFTER_DRAIN = false;
    bf16_t* O; int ldc; const float* ss;
    __device__ __forceinline__ void operator()(const f32x4 (&acc)[2][2][4][2], const Unit& u, int wr, int wc, int fr, int fq) const {
        const int row0 = u.pm * BM + wr * 64 + fr; const int col0 = u.pn * BM + wc * 32 + 8 * fq;
        float rs[2][4];
        if (ss) rows_rstd32(ss, row0, fq, rs);
        else {
#pragma unroll
            for (int ai = 0; ai < 2; ++ai)
#pragma unroll
                for (int m = 0; m < 4; ++m) rs[ai][m] = 1.0f; }
#pragma unroll
        for (int ai = 0; ai < 2; ++ai)
#pragma unroll
            for (int m = 0; m < 4; ++m) { bf16_t* rowp = O + (size_t)(row0 + ai * HALF + m * 16) * ldc + col0;
#pragma unroll
                for (int bj = 0; bj < 2; ++bj) { f32x4 v0 = acc[ai][bj][m][0] * rs[ai][m], v1 = acc[ai][bj][m][1] * rs[ai][m];
                    if (ACT == 1) {
#pragma unroll
                        for (int j = 0; j < 4; ++j) { const float a = fmaxf(v0[j], 0.f), b = fmaxf(v1[j], 0.f); v0[j] = a * a; v1[j] = b * b; } }
                    u32x4 w; w.x = cvt_pk_bf16(v0[0], v0[1]); w.y = cvt_pk_bf16(v0[2], v0[3]); w.z = cvt_pk_bf16(v1[0], v1[1]); w.w = cvt_pk_bf16(v1[2], v1[3]);
                    __builtin_nontemporal_store(w, (u32x4*)(rowp + bj * HALF)); } }
    }
};
__device__ __forceinline__ void unpack_bf8(const u32x4 w, f32x4& a, f32x4& b) {
    a = (f32x4){__uint_as_float(w.x << 16), __uint_as_float(w.x & 0xffff0000u), __uint_as_float(w.y << 16), __uint_as_float(w.y & 0xffff0000u)};
    b = (f32x4){__uint_as_float(w.z << 16), __uint_as_float(w.z & 0xffff0000u), __uint_as_float(w.w << 16), __uint_as_float(w.w & 0xffff0000u)};
}
__device__ __forceinline__ u32x4 pack_bf8(const f32x4 a, const f32x4 b) { u32x4 w; w.x = cvt_pk_bf16(a[0], a[1]); w.y = cvt_pk_bf16(a[2], a[3]); w.z = cvt_pk_bf16(b[0], b[1]); w.w = cvt_pk_bf16(b[2], b[3]); return w; }
__device__ __forceinline__ float sumsq4(const f32x4 v) { return (v[0] * v[0] + v[1] * v[1]) + (v[2] * v[2] + v[3] * v[3]); }
struct EpiResid {
    static constexpr bool PERM = true, AFTER_DRAIN = false;
    const float* basef; const bf16_t* baseh; bf16_t* h16; int ldc; float* ss;
    const float* ssin;
    __device__ __forceinline__ void fin(const f32x4 (&acc)[2][2][4][2], const Unit& u, int q, int row0, int col0, int wc, int fq, f32x4 b0, f32x4 b1, f32x4 c0, f32x4 c1, float sc) const {
        const int ai = q >> 2, m = q & 3; const int row = row0 + ai * HALF + m * 16; const size_t off = (size_t)row * ldc + col0;
        const f32x4 v0 = b0 + acc[ai][0][m][0] * sc, v1 = b1 + acc[ai][0][m][1] * sc, v2 = c0 + acc[ai][1][m][0] * sc, v3 = c1 + acc[ai][1][m][1] * sc;
        *(u32x4*)(h16 + off) = pack_bf8(v0, v1); *(u32x4*)(h16 + off + HALF) = pack_bf8(v2, v3);
        if (ss) { float sq = (sumsq4(v0) + sumsq4(v1)) + (sumsq4(v2) + sumsq4(v3)); sq += __shfl_xor(sq, 16); sq += __shfl_xor(sq, 32);
            if (fq == 0) ss[(size_t)row * 32 + u.pn * 4 + wc] = sq; }
    }
    __device__ __forceinline__ void operator()(const f32x4 (&acc)[2][2][4][2], const Unit& u, int wr, int wc, int fr, int fq) const {
        const int row0 = u.pm * BM + wr * 64 + fr, col0 = u.pn * BM + wc * 32 + 8 * fq;
#define ER_OFF(q_) ((size_t)(row0 + ((q_) >> 2) * HALF + ((q_) & 3) * 16) * ldc + col0)
        if (basef) {
            f32x4 b[2][4];
#define ERF_LOAD(q_) do { const float* p_ = basef + ER_OFF(q_); b[(q_) & 1][0] = *(const f32x4*)p_; b[(q_) & 1][1] = *(const f32x4*)(p_ + 4); b[(q_) & 1][2] = *(const f32x4*)(p_ + HALF); b[(q_) & 1][3] = *(const f32x4*)(p_ + HALF + 4); } while (0)
            ERF_LOAD(0); ERF_LOAD(1);
            __builtin_amdgcn_sched_barrier(0);
#pragma unroll
            for (int q = 0; q < 8; ++q) {
                fin(acc, u, q, row0, col0, wc, fq, b[q & 1][0], b[q & 1][1], b[q & 1][2], b[q & 1][3], 1.0f);
                if (q + 2 < 8) ERF_LOAD(q + 2);
                asm volatile("" ::: "memory");
            }
#undef ERF_LOAD
        } else if (ssin) {
            u32x4 b[8][2]; f32x4 pa[2][4][2]; float rs2[2][4];
#define ER_BLOAD(q_) do { const bf16_t* p_ = baseh + ER_OFF(q_); b[q_][0] = *(const u32x4*)p_; b[q_][1] = *(const u32x4*)(p_ + HALF); } while (0)
#define ER_RS_LOAD(ai_) do { _Pragma("unroll") for (int m = 0; m < 4; ++m) { const float* p_ = ssin + (size_t)(row0 + (ai_) * HALF + m * 16) * 32 + fq * 8; pa[ai_][m][0] = *(const f32x4*)p_; pa[ai_][m][1] = *(const f32x4*)(p_ + 4); } } while (0)
#define ER_RS_REDUCE(ai_) do { _Pragma("unroll") for (int m = 0; m < 4; ++m) { const f32x4 a_ = pa[ai_][m][0], b_ = pa[ai_][m][1]; float s_ = ((a_[0] + a_[1]) + (a_[2] + a_[3])) + ((b_[0] + b_[1]) + (b_[2] + b_[3])); \
                s_ += __shfl_xor(s_, 16); s_ += __shfl_xor(s_, 32); rs2[ai_][m] = 1.0f / (s_ * (1.0f / 2048.0f) + 1e-6f); } } while (0)
#define ER_PROC(q_) do { f32x4 b0, b1, c0, c1; unpack_bf8(b[q_][0], b0, b1); unpack_bf8(b[q_][1], c0, c1); fin(acc, u, q_, row0, col0, wc, fq, b0, b1, c0, c1, rs2[(q_) >> 2][(q_) & 3]); asm volatile("" ::: "memory"); } while (0)
            ER_RS_LOAD(0); ER_BLOAD(0); ER_BLOAD(1); ER_BLOAD(2);
            __builtin_amdgcn_sched_barrier(0);
            ER_RS_REDUCE(0);
            ER_PROC(0); ER_RS_LOAD(1); ER_BLOAD(3); asm volatile("" ::: "memory");
            ER_PROC(1); ER_BLOAD(4); ER_BLOAD(5); asm volatile("" ::: "memory");
            ER_PROC(2); ER_BLOAD(6); ER_BLOAD(7); asm volatile("" ::: "memory");
            ER_PROC(3);
            ER_RS_REDUCE(1);
            ER_PROC(4); ER_PROC(5); ER_PROC(6); ER_PROC(7);
#undef ER_PROC
#undef ER_RS_REDUCE
#undef ER_RS_LOAD
#undef ER_BLOAD
        } else {
            u32x4 b[8][2];
#pragma unroll
            for (int q = 0; q < 8; ++q) { const bf16_t* p_ = baseh + ER_OFF(q); b[q][0] = *(const u32x4*)p_; b[q][1] = *(const u32x4*)(p_ + HALF); }
            __builtin_amdgcn_sched_barrier(0);
#pragma unroll
            for (int q = 0; q < 8; ++q) { f32x4 b0, b1, c0, c1; unpack_bf8(b[q][0], b0, b1); unpack_bf8(b[q][1], c0, c1);
                fin(acc, u, q, row0, col0, wc, fq, b0, b1, c0, c1, 1.0f);
                asm volatile("" ::: "memory"); }
        }
#undef ER_OFF
    }
};
struct EpiGate {
    static constexpr bool PERM = true, AFTER_DRAIN = false;
    const bf16_t* hin; bf16_t* h16; const bf16_t* pp; int ldc; const float* ss;
    __device__ __forceinline__ void operator()(const f32x4 (&acc)[2][2][4][2], const Unit& u, int wr, int wc, int fr, int fq) const {
        const int row0 = u.pm * BM + wr * 64 + fr, col0 = u.pn * BM + wc * 32 + 8 * fq;
        u32x4 hw[8][2], pw[8][2];
        f32x4 pa[2][4][2];
        float rsv[2][4];
#define EG_OFF(q_) ((size_t)(row0 + ((q_) >> 2) * HALF + ((q_) & 3) * 16) * ldc + col0)
#define EG_LOAD(q_) do { const size_t off_ = EG_OFF(q_); hw[q_][0] = *(const u32x4*)(hin + off_); hw[q_][1] = *(const u32x4*)(hin + off_ + HALF); pw[q_][0] = *(const u32x4*)(pp + off_); pw[q_][1] = *(const u32x4*)(pp + off_ + HALF); } while (0)
#define EG_RS_LOAD(ai_) do { if (ss) { _Pragma("unroll") for (int m = 0; m < 4; ++m) { const float* p_ = ss + (size_t)(row0 + (ai_) * HALF + m * 16) * 32 + fq * 8; pa[ai_][m][0] = *(const f32x4*)p_; pa[ai_][m][1] = *(const f32x4*)(p_ + 4); } } } while (0)
#define EG_RS_REDUCE(ai_) do { _Pragma("unroll") for (int m = 0; m < 4; ++m) { if (ss) { const f32x4 a_ = pa[ai_][m][0], b_ = pa[ai_][m][1]; float s_ = ((a_[0] + a_[1]) + (a_[2] + a_[3])) + ((b_[0] + b_[1]) + (b_[2] + b_[3])); \
            s_ += __shfl_xor(s_, 16); s_ += __shfl_xor(s_, 32); rsv[ai_][m] = 1.0f / sqrtf(s_ * (1.0f / 2048.0f) + 1e-6f); } else rsv[ai_][m] = 1.0f; } } while (0)
#define EG_PROC(q_) do { const int ai_ = (q_) >> 2, m_ = (q_) & 3; const size_t off = EG_OFF(q_); const float rs = rsv[ai_][m_]; \
            _Pragma("unroll") for (int bj = 0; bj < 2; ++bj) { f32x4 h0, h1, p0, p1; unpack_bf8(hw[q_][bj], h0, h1); unpack_bf8(pw[q_][bj], p0, p1); \
                const f32x4 a0 = acc[ai_][bj][m_][0], a1 = acc[ai_][bj][m_][1]; f32x4 r0, r1; \
                _Pragma("unroll") for (int j = 0; j < 4; ++j) { r0[j] = h0[j] + p0[j] / (1.0f + __expf(-a0[j] * rs)); r1[j] = h1[j] + p1[j] / (1.0f + __expf(-a1[j] * rs)); } \
                *(u32x4*)(h16 + off + bj * HALF) = pack_bf8(r0, r1); } \
            asm volatile("" ::: "memory"); } while (0)
        EG_RS_LOAD(0); EG_LOAD(0); EG_LOAD(1);
        __builtin_amdgcn_sched_barrier(0);
        EG_RS_REDUCE(0);
        EG_PROC(0); EG_LOAD(2); EG_RS_LOAD(1); asm volatile("" ::: "memory");
        EG_PROC(1); EG_LOAD(3); EG_LOAD(4); asm volatile("" ::: "memory");
        EG_RS_REDUCE(1);
        EG_PROC(2); EG_LOAD(5); EG_LOAD(6); asm volatile("" ::: "memory");
        EG_PROC(3); EG_LOAD(7); asm volatile("" ::: "memory");
        EG_PROC(4); EG_PROC(5); EG_PROC(6); EG_PROC(7);
#undef EG_PROC
#undef EG_RS_REDUCE
#undef EG_RS_LOAD
#undef EG_LOAD
#undef EG_OFF
    }
};

template <class Epi, class Sched, bool ALIGN_EPI = false, bool SP2 = false>
__device__ __forceinline__ void gemm_phase(PG8_LAS unsigned char* lds, const Gemm g, const Sched& S, const Epi& E) {
    int tid = threadIdx.x; asm volatile("" : "+v"(tid));
    const int wid = __builtin_amdgcn_readfirstlane(tid >> 6), lane = tid & 63, wr = wid >> 2, wc = wid & 3, fr = lane & 15, fq = lane >> 4;
    const int K = g.K, nt = K / BK;
    unsigned voffA[2], voffB[2];
#pragma unroll
    for (int i = 0; i < 2; ++i) { int R, C; stage_rc(tid * 16 + i * 8192, R, C); const int Rb = Epi::PERM ? ((R & ~31) + perm32(R & 31)) : R;
        voffA[i] = (unsigned)(R * K + C) * 2u; voffB[i] = (unsigned)(Rb * K + C) * 2u; }
    const size_t kstep = (size_t)(BK * 2);
    const size_t hstep = (size_t)HALF * K * 2;
    const size_t tstep = 2 * hstep;
    const unsigned ldsw = (unsigned)wid * 1024u;
    const int aoff = lds_byte(wr * 64 + fr, fq * 8), boff = lds_byte(wc * 32 + fr, fq * 8);
#define PG8_SA(b, h) (((b) * 2 + (h)) * HTB)
#define PG8_SB(b, h) ((4 + (b) * 2 + (h)) * HTB)
#define PG8_STAGE(bufoff, gbase, voff) do { _Pragma("unroll") for (int _i = 0; _i < 2; ++_i) \
        __builtin_amdgcn_global_load_lds((const unsigned*)((const char*)(gbase) + (voff)[_i]), (PG8_LAS unsigned*)(lds + (bufoff) + ldsw + _i * 8192), 16, 0, 0); } while (0)
#define PG8_LDA(dst, b, h) do { _Pragma("unroll") for (int m = 0; m < 4; ++m) _Pragma("unroll") for (int k = 0; k < 2; ++k) dst[m][k] = *(const PG8_LAS bf16x8*)(lds + PG8_SA(b, h) + aoff + m * 2048 + k * 1024); } while (0)
#define PG8_LDB(dst, b, h) do { _Pragma("unroll") for (int n = 0; n < 2; ++n) _Pragma("unroll") for (int k = 0; k < 2; ++k) dst[n][k] = *(const PG8_LAS bf16x8*)(lds + PG8_SB(b, h) + boff + n * 2048 + k * 1024); } while (0)
#define PG8_MMA(ai, bj, At, Bt) do { __builtin_amdgcn_s_setprio(1); _Pragma("unroll") for (int m = 0; m < 4; ++m) _Pragma("unroll") for (int n = 0; n < 2; ++n) _Pragma("unroll") for (int k = 0; k < 2; ++k) \
        acc[ai][bj][m][n] = __builtin_amdgcn_mfma_f32_16x16x32_bf16(Bt[n][k], At[m][k], acc[ai][bj][m][n], 0, 0, 0); __builtin_amdgcn_s_setprio(0); } while (0)
#define PG8_WAIT_V(n) asm volatile("s_waitcnt vmcnt(" #n ")" ::: "memory")
#define PG8_WAIT_V_SEL(t_, ui_) asm volatile("s_cmp_lg_u32 %0, 0\n\ts_cbranch_scc1 1f\n\ts_cmp_eq_u32 %1, 0\n\ts_cbranch_scc1 1f\n\ts_waitcnt vmcnt(24)\n\ts_branch 2f\n1:\n\ts_waitcnt vmcnt(8)\n2:" :: "s"(t_), "s"(ui_) : "memory", "scc")
#define PG8_WAIT_L(n) asm volatile("s_waitcnt lgkmcnt(" #n ")" ::: "memory")
#define PG8_BAR __builtin_amdgcn_s_barrier()
#define PG8_SCHED __builtin_amdgcn_sched_barrier(0)
    Unit cur, nxt; int ui = 0;
    if (!S.next(0, cur)) return;
    f32x4 acc[2][2][4][2];
#pragma unroll
    for (int a = 0; a < 2; ++a)
#pragma unroll
        for (int b = 0; b < 2; ++b)
#pragma unroll
            for (int m = 0; m < 4; ++m)
#pragma unroll
                for (int n = 0; n < 2; ++n) acc[a][b][m][n] = (f32x4){0.f, 0.f, 0.f, 0.f};
    bf16x8 At[4][2], B0[2][2], B1[2][2];
    const char* cA = (const char*)g.A + (size_t)cur.pm * tstep; const char* cB = (const char*)g.Bt + (size_t)cur.pn * tstep;
    S.a_ready(cur);
    if constexpr (SP2) {
        PG8_STAGE(PG8_SB(0, 0), cB, voffB); PG8_STAGE(PG8_SB(0, 1), cB + hstep, voffB); PG8_STAGE(PG8_SA(0, 0), cA, voffA); PG8_STAGE(PG8_SA(0, 1), cA + hstep, voffA);
        if (wr == 1) PG8_BAR;
        PG8_WAIT_V(2); PG8_BAR;
        PG8_STAGE(PG8_SB(1, 0), cB + kstep, voffB); PG8_STAGE(PG8_SA(1, 0), cA + kstep, voffA); PG8_STAGE(PG8_SB(1, 1), cB + hstep + kstep, voffB);
        PG8_WAIT_V(6); PG8_BAR;
    } else {
        PG8_STAGE(PG8_SB(0, 0), cB, voffB); PG8_STAGE(PG8_SA(0, 0), cA, voffA); PG8_STAGE(PG8_SB(0, 1), cB + hstep, voffB); PG8_STAGE(PG8_SA(0, 1), cA + hstep, voffA);
        if (wr == 1) PG8_BAR;
        PG8_WAIT_V(4); PG8_BAR;
        PG8_STAGE(PG8_SB(1, 0), cB + kstep, voffB); PG8_STAGE(PG8_SA(1, 0), cA + kstep, voffA); PG8_STAGE(PG8_SB(1, 1), cB + hstep + kstep, voffB);
        PG8_WAIT_V(6); PG8_BAR;
    }
    for (;;) {
        const bool has_next = S.next(ui + 1, nxt);
        const char* nA = has_next ? (const char*)g.A + (size_t)nxt.pm * tstep : cA; const char* nB = has_next ? (const char*)g.Bt + (size_t)nxt.pn * tstep : cB;
        for (int t = 0; t < nt; t += 2) {
            const bool last = (t == nt - 2);
            const char* a1 = cA + (size_t)(t + 1) * kstep;
            const char* a2 = last ? nA : cA + (size_t)(t + 2) * kstep; const char* b2 = last ? nB : cB + (size_t)(t + 2) * kstep;
            const char* a3 = a2 + kstep; const char* b3 = b2 + kstep;
            if (last && has_next) S.a_ready(nxt);
            if constexpr (SP2) {
            PG8_LDB(B0, 0, 0); PG8_LDB(B1, 0, 1); PG8_SCHED; PG8_LDA(At, 0, 0); PG8_STAGE(PG8_SA(1, 1), a1 + hstep, voffA);
            PG8_WAIT_V_SEL(t, ui);
            PG8_WAIT_L(0); PG8_BAR; PG8_MMA(0, 0, At, B0); PG8_MMA(0, 1, At, B1); PG8_BAR; PG8_SCHED;
            PG8_LDA(At, 0, 1); PG8_STAGE(PG8_SB(0, 0), b2, voffB); PG8_STAGE(PG8_SB(0, 1), b2 + hstep, voffB); PG8_STAGE(PG8_SA(0, 0), a2, voffA);
            PG8_WAIT_V_SEL(t, ui);
            PG8_WAIT_L(0); PG8_BAR; PG8_MMA(1, 0, At, B0); PG8_MMA(1, 1, At, B1); PG8_BAR; PG8_SCHED;
            PG8_LDB(B0, 1, 0); PG8_LDB(B1, 1, 1); PG8_SCHED; PG8_LDA(At, 1, 0); PG8_STAGE(PG8_SA(0, 1), a2 + hstep, voffA);
            PG8_WAIT_V(8); PG8_WAIT_L(0); PG8_BAR; PG8_MMA(0, 0, At, B0); PG8_MMA(0, 1, At, B1); PG8_BAR; PG8_SCHED;
            PG8_LDA(At, 1, 1); PG8_STAGE(PG8_SB(1, 0), b3, voffB); PG8_STAGE(PG8_SB(1, 1), b3 + hstep, voffB); PG8_STAGE(PG8_SA(1, 0), a3, voffA);
            PG8_WAIT_V(8); PG8_WAIT_L(0); PG8_BAR; PG8_MMA(1, 0, At, B0); PG8_MMA(1, 1, At, B1); PG8_BAR; PG8_SCHED;
            } else {
            PG8_LDB(B0, 0, 0); PG8_SCHED; PG8_LDA(At, 0, 0); PG8_STAGE(PG8_SA(1, 1), a1 + hstep, voffA);
            PG8_WAIT_L(8); PG8_BAR; PG8_WAIT_L(0); PG8_MMA(0, 0, At, B0); PG8_BAR; PG8_SCHED;
            PG8_LDB(B1, 0, 1); PG8_STAGE(PG8_SB(0, 0), b2, voffB);
            PG8_BAR; PG8_WAIT_L(0); PG8_MMA(0, 1, At, B1); PG8_BAR;
            PG8_LDA(At, 0, 1); PG8_STAGE(PG8_SA(0, 0), a2, voffA);
            PG8_BAR; PG8_WAIT_L(0); PG8_MMA(1, 0, At, B0); PG8_BAR; PG8_SCHED;
            PG8_STAGE(PG8_SB(0, 1), b2 + hstep, voffB);
            PG8_WAIT_V(6); PG8_BAR; PG8_MMA(1, 1, At, B1); PG8_BAR;
            PG8_LDB(B0, 1, 0); PG8_SCHED; PG8_LDA(At, 1, 0); PG8_STAGE(PG8_SA(0, 1), a2 + hstep, voffA);
            PG8_WAIT_L(8); PG8_BAR; PG8_WAIT_L(0); PG8_MMA(0, 0, At, B0); PG8_BAR; PG8_SCHED;
            PG8_LDB(B1, 1, 1); PG8_STAGE(PG8_SB(1, 0), b3, voffB);
            PG8_BAR; PG8_WAIT_L(0); PG8_MMA(0, 1, At, B1); PG8_BAR;
            PG8_LDA(At, 1, 1); PG8_STAGE(PG8_SA(1, 0), a3, voffA);
            PG8_BAR; PG8_WAIT_L(0); PG8_MMA(1, 0, At, B0); PG8_BAR; PG8_SCHED;
            PG8_STAGE(PG8_SB(1, 1), b3 + hstep, voffB);
            PG8_WAIT_V(6); PG8_BAR; PG8_MMA(1, 1, At, B1); PG8_BAR;
            }
        }
        if constexpr (ALIGN_EPI) { if (wr == 0) PG8_BAR; }
        if constexpr (!Epi::AFTER_DRAIN) { E(acc, cur, wr, wc, fr, fq); S.done(cur); }
        if (!has_next) break;
#pragma unroll
        for (int a = 0; a < 2; ++a)
#pragma unroll
            for (int b = 0; b < 2; ++b)
#pragma unroll
                for (int m = 0; m < 4; ++m)
#pragma unroll
                    for (int n = 0; n < 2; ++n) acc[a][b][m][n] = (f32x4){0.f, 0.f, 0.f, 0.f};
        cur = nxt; cA = nA; cB = nB; ++ui;
        if constexpr (ALIGN_EPI) { if (wr == 1) PG8_BAR; }
    }
    PG8_WAIT_V(0);
    if constexpr (!ALIGN_EPI) { if (wr == 0) PG8_BAR; }
    PG8_BAR;
    if constexpr (Epi::AFTER_DRAIN) { E.fused(acc, cur, wr, wc, fr, fq, lds, wid, lane); S.done(cur); }
#undef PG8_SA
#undef PG8_SB
#undef PG8_STAGE
#undef PG8_LDA
#undef PG8_LDB
#undef PG8_MMA
#undef PG8_WAIT_V
#undef PG8_WAIT_L
#undef PG8_BAR
#undef PG8_SCHED
}
}

constexpr int NB = 4, SEQ = 8192, DM = 2048, DFF = 8192, NPROJ = 6144, PLE = 256, DEPTH = 4;
constexpr int M_TOK = NB * SEQ;
constexpr int EV_IN_W = 6160;
constexpr float RMS_EPS = 1e-6f, GN_EPS = 1e-5f;
constexpr float SC128 = 0.08838834764831845f;
constexpr int NWAVES = 8;
#ifndef LAYER_HI
#define LAYER_HI DEPTH
#endif

constexpr size_t MiB = 1u << 20;
constexpr size_t WS_CTL = 0, CTL_ZERO_BYTES = 1 * MiB;
constexpr size_t WS_WIN = WS_CTL + CTL_ZERO_BYTES;
constexpr size_t WS_WOUT = WS_WIN + (size_t)NPROJ * DM * 2;
constexpr size_t WS_WUP = WS_WOUT + (size_t)DM * DM * 2;
constexpr size_t WS_WDOWN = WS_WUP + (size_t)DFF * DM * 2;
constexpr size_t WS_WGATE = WS_WDOWN + (size_t)DM * DFF * 2;
constexpr size_t WS_WPP = WS_WGATE + (size_t)DM * DM * 2;
constexpr size_t WS_PB = WS_WPP + (size_t)DM * PLE * 2;
constexpr size_t WS_GB = WS_PB + (size_t)M_TOK * PLE * 2;
constexpr size_t WS_HN = WS_GB + (size_t)M_TOK * 16 * 4;
constexpr size_t WS_MIX = WS_HN + (size_t)M_TOK * DM * 2;
constexpr size_t WS_BIG = WS_MIX + (size_t)M_TOK * DM * 2;
constexpr size_t WS_PPB = WS_BIG + (size_t)M_TOK * DFF * 2;
constexpr size_t WS_LSUM = WS_PPB + (size_t)M_TOK * DM * 2;
constexpr size_t WS_LCIN = WS_LSUM + (size_t)NB * 256 * 1024 * 8;
constexpr size_t WS_DQK = WS_LCIN + (size_t)NB * 256 * 1024 * 4;
constexpr size_t WS_DGT = WS_DQK + (size_t)4096 * 64 * 64 * 2;
constexpr size_t WS_WLT = WS_DGT + 4096 * 4;
constexpr size_t WS_PP2 = WS_WLT + 8 * 256 * 128 * 2;
constexpr size_t WS_WIN2 = WS_PP2 + (size_t)M_TOK * DM * 2;
constexpr size_t WS_SS = WS_WIN2 + (size_t)NPROJ * DM * 2;
constexpr size_t WS_END = WS_SS + (size_t)2 * M_TOK * 32 * 4;
static_assert(WS_END <= 1286087808ull, "workspace map exceeds the guaranteed d_ws size (sum of inputs)");
constexpr int CW_BAR = 4096;

constexpr int RING_OFF = 0, RING_BYTES = 131072;
constexpr int LDS_BYTES = 163840;
constexpr int LDSCTL_OFF = LDS_BYTES - 1024, MISC_OFF = LDSCTL_OFF + 320;

#define GAS __attribute__((address_space(1)))
#define LAS __attribute__((address_space(3)))
typedef unsigned short bf16;
typedef unsigned v4u __attribute__((ext_vector_type(4)));
typedef unsigned v2u __attribute__((ext_vector_type(2)));
typedef float f32x4 __attribute__((ext_vector_type(4)));
typedef float f32x2 __attribute__((ext_vector_type(2)));
#define LDS_WAIT() asm volatile("s_waitcnt lgkmcnt(0)" ::: "memory")
#define LDS_BARRIER() do { asm volatile("s_waitcnt lgkmcnt(0)" ::: "memory"); __builtin_amdgcn_s_barrier(); asm volatile("" ::: "memory"); } while (0)
__device__ __forceinline__ unsigned f2bf(float f) { unsigned u = __float_as_uint(f); return (u + 0x7fffu + ((u >> 16) & 1u)) >> 16; }
__device__ __forceinline__ unsigned pk2(float lo, float hi) { return f2bf(lo) | (f2bf(hi) << 16); }
typedef __bf16 bf16v2_t __attribute__((ext_vector_type(2)));
__device__ __forceinline__ unsigned pkbf(float lo, float hi) { const f32x2 v = {lo, hi}; return __builtin_bit_cast(unsigned, __builtin_convertvector(v, bf16v2_t)); }
__device__ __forceinline__ float bflo(unsigned u) { return __uint_as_float(u << 16); }
__device__ __forceinline__ float bfhi(unsigned u) { return __uint_as_float(u & 0xffff0000u); }
__device__ __forceinline__ float bf2f(bf16 b) { return __uint_as_float((unsigned)b << 16); }
__device__ __forceinline__ float sigmoidf_(float x) { return 1.0f / (1.0f + __expf(-x)); }
__device__ __forceinline__ float siluf_(float x) { return x / (1.0f + __expf(-x)); }
__device__ __forceinline__ float softplusf_(float x) { return x > 20.f ? x : log1pf(expf(x)); }
__device__ __forceinline__ float neg_expm1f_(float x) { const float p = x * (1.f + x * 0.5f * (1.f + x * (1.f / 3.f) * (1.f + x * 0.25f * (1.f + x * 0.2f * (1.f + x * (1.f / 6.f) * (1.f + x * (1.f / 7.f))))))); return x > -0.35f ? -p : 1.0f - __expf(x); }
__device__ __forceinline__ float gelu_tanh(float x) { const float z = 0.7978845608028654f * (x + 0.044715f * x * x * x); const float th = 1.0f - 2.0f / (__expf(2.0f * z) + 1.0f); return 0.5f * x * (1.0f + th); }
__device__ __forceinline__ float wave_sum(float v) {
#pragma unroll
    for (int o = 1; o < 64; o <<= 1) v += __shfl_xor(v, o);
    return v;
}
__device__ __forceinline__ float wave_max(float v) {
#pragma unroll
    for (int o = 1; o < 64; o <<= 1) v = fmaxf(v, __shfl_xor(v, o));
    return v;
}
#define DPP_ADD(v, ctrl) ((v) + __int_as_float(__builtin_amdgcn_update_dpp(0, __float_as_int(v), (ctrl), 0xF, 0xF, true)))
__device__ __forceinline__ float row16_sum(float v) {
    v = DPP_ADD(v, 0xB1);
    v = DPP_ADD(v, 0x4E);
    v = DPP_ADD(v, 0x141);
    v = DPP_ADD(v, 0x140);
    return v;
}

__device__ __forceinline__ float row8_sum(float v) { v = DPP_ADD(v, 0xB1); v = DPP_ADD(v, 0x4E); v = DPP_ADD(v, 0x141); return v; }
__device__ __forceinline__ void unpack8(const v4u x, float* o) { o[0] = bflo(x.x); o[1] = bfhi(x.x); o[2] = bflo(x.y); o[3] = bfhi(x.y); o[4] = bflo(x.z); o[5] = bfhi(x.z); o[6] = bflo(x.w); o[7] = bfhi(x.w); }
__device__ __forceinline__ v4u pack8(const float* a) { v4u w; w.x = pkbf(a[0], a[1]); w.y = pkbf(a[2], a[3]); w.z = pkbf(a[4], a[5]); w.w = pkbf(a[6], a[7]); return w; }

#define XB_TMO      128
#define XB_XCNT(j)  (256  + 64 * (j))
#define XB_XSUB(j)  (1280 + 64 * (j))
#define XB_XGEN(j)  (2304 + 64 * (j))
#define XB_TOP      3328
#define XB_TOPGEN   3392
#define XCD_BAR_WORDS 3456
#define XB_SPIN_CAP (1u << 20)

__device__ __forceinline__ unsigned xb_ld(unsigned* p)              { return __hip_atomic_load(p, __ATOMIC_RELAXED, __HIP_MEMORY_SCOPE_AGENT); }
__device__ __forceinline__ unsigned xb_add(unsigned* p, unsigned v) { return __hip_atomic_fetch_add(p, v, __ATOMIC_RELAXED, __HIP_MEMORY_SCOPE_AGENT); }
__device__ __forceinline__ unsigned xb_xcc_id() { return (unsigned)__builtin_amdgcn_s_getreg((3 << 11) | 20) & 0xFu; }
#define XB_SPIN(cond, bar) do { unsigned _sp = 0; while (cond) { __builtin_amdgcn_s_sleep(1); \
    if ((++_sp & 255u) == 0u) { if (xb_ld(&(bar)[XB_TMO])) break; if (_sp > XB_SPIN_CAP) { atomicAdd(&(bar)[XB_TMO], 1u); break; } } } } while (0)

struct XcdBarrier { unsigned* bar; unsigned x; volatile LAS unsigned* st; };

__device__ __forceinline__ XcdBarrier xcd_barrier_post(unsigned* bar, volatile LAS unsigned* st) {
    XcdBarrier b; b.bar = bar; b.x = xb_xcc_id(); b.st = st;
    if (threadIdx.x == 0) (void)xb_add(&bar[XB_XCNT(b.x)], 1u);
    return b;
}
__device__ __forceinline__ void xcd_barrier_complete(unsigned* bar, unsigned x, unsigned& nloc, unsigned& nx) {
    const unsigned G = gridDim.x * gridDim.y * gridDim.z;
    unsigned sum, cnt, mine, sp = 0u;
    for (;;) {
        sum = 0u; cnt = 0u; mine = 0u;
#pragma unroll
        for (unsigned j = 0; j < 16; ++j) { const unsigned c = xb_ld(&bar[XB_XCNT(j)]); sum += c; cnt += (c > 0u) ? 1u : 0u; mine = (j == x) ? c : mine; }
        if (sum == G) break;
        __builtin_amdgcn_s_sleep(1);
        if ((++sp & 255u) == 0u) { if (xb_ld(&bar[XB_TMO])) break; if (sp > XB_SPIN_CAP) { atomicAdd(&bar[XB_TMO], 1u); break; } }
    }
    nloc = mine > 0u ? mine : 1u; nx = cnt > 0u ? cnt : 1u;
}
__device__ __forceinline__ void xcd_barrier(const XcdBarrier& b) {
    asm volatile("s_waitcnt vmcnt(0)" ::: "memory");
    __syncthreads();
    if (threadIdx.x == 0) {
        unsigned* bar = b.bar;
        __builtin_amdgcn_s_waitcnt(0);
        unsigned nloc = b.st[0], nx = b.st[1];
        if (nloc == 0u) { xcd_barrier_complete(bar, b.x, nloc, nx); b.st[0] = nloc; b.st[1] = nx; }
        const unsigned old = xb_add(&bar[XB_XSUB(b.x)], 1u);
        const unsigned gen = old / nloc;
        if (old + 1u == (gen + 1u) * nloc) {
            __builtin_amdgcn_fence(__ATOMIC_RELEASE, "agent");
            asm volatile("s_waitcnt vmcnt(0)" ::: "memory");
            const unsigned og = xb_add(&bar[XB_TOP], 1u);
            const unsigned tg = og / nx;
            if (og + 1u == (tg + 1u) * nx) xb_add(&bar[XB_TOPGEN], 1u);
            else XB_SPIN(xb_ld(&bar[XB_TOPGEN]) == tg, bar);
            __builtin_amdgcn_fence(__ATOMIC_ACQUIRE, "agent");
            xb_add(&bar[XB_XGEN(b.x)], 1u);
            asm volatile("s_waitcnt vmcnt(0)" ::: "memory");
        } else {
            XB_SPIN(xb_ld(&bar[XB_XGEN(b.x)]) == gen, bar);
            __builtin_amdgcn_fence(__ATOMIC_ACQUIRE, "agent");
            asm volatile("s_waitcnt vmcnt(0)" ::: "memory");
        }
    }
    __syncthreads();
}

struct Args { const float* in[25]; float* out; unsigned char* ws; int ph_lo, ph_hi; };
struct Frame {
    LAS unsigned char* lds;
    int tid, lane, wave, bx, G;
    const float* const* in;
    float* out;
    bf16 *WIN, *WOUT, *WUP, *WDOWN, *WGATE, *WPP, *PB, *HN, *MIX, *BIG, *PPB;
    float* GB; unsigned char* ws; bf16* PP2; bf16* H16;
};

__device__ __forceinline__ void tr_item(const float* W, int ldw, int c0, int K, bf16* WT, int r0, int nblk, LAS float* scr, int item, int lane, const float* kscale) {
    const int kb = item / nblk, nb = item % nblk, k0 = 64 * kb, n0 = 32 * nb;
    {   float wv[32];
#pragma unroll
        for (int i = 0; i < 32; ++i) wv[i] = W[(size_t)(k0 + 2 * i + (lane >> 5)) * ldw + c0 + n0 + (lane & 31)];
        __builtin_amdgcn_sched_barrier(0);
#pragma unroll
        for (int i = 0; i < 32; ++i) { const int kk = 2 * i + (lane >> 5); const float sc = kscale ? kscale[k0 + kk] : 1.0f; scr[kk * 33 + (lane & 31)] = wv[i] * sc; } }
    LDS_WAIT(); asm volatile("" ::: "memory");
    const int c = lane & 7;
#pragma unroll
    for (int j = 0; j < 4; ++j) { const int n = (lane >> 3) + 8 * j; const LAS float* s = scr + (8 * c) * 33 + n;
        v4u o; o.x = pk2(s[0 * 33], s[1 * 33]); o.y = pk2(s[2 * 33], s[3 * 33]); o.z = pk2(s[4 * 33], s[5 * 33]); o.w = pk2(s[6 * 33], s[7 * 33]);
        *(v4u*)(WT + (size_t)(r0 + n0 + n) * K + k0 + 8 * c) = o; }
    LDS_WAIT(); asm volatile("" ::: "memory");
}
__device__ __forceinline__ void tr_matrix(Frame& F, const float* W, int ldw, int c0, int K, bf16* WT, int r0, int ncols, int wg0 = 0, const float* kscale = nullptr) {
    LAS float* scr = (LAS float*)(F.lds + RING_OFF + F.wave * 16384);
    const int gw = (F.bx - wg0) * NWAVES + F.wave, NGW = (F.G - wg0) * NWAVES, nblk = ncols / 32, nitems = (K / 64) * nblk;
    for (int it = gw; it < nitems; it += NGW) tr_item(W, ldw, c0, K, WT, r0, nblk, scr, it, F.lane, kscale);
}

template <bool GBV, bool SRC16>
__device__ __forceinline__ void rms_rows(Frame& F, const void* hsrcv, const float* lnw, bf16* HN, float* GB) {
    const float* hsrc = (const float*)hsrcv; const bf16* hsrc16 = (const bf16*)hsrcv;
    const int gw = F.bx * NWAVES + F.wave, NGW = F.G * NWAVES, lane = F.lane;
    const LAS float* wabT = (const LAS float*)(F.lds + RING_OFF);
    f32x4 lw[8];
#pragma unroll
    for (int j = 0; j < 8; ++j) lw[j] = ((const f32x4*)lnw)[lane + 64 * j];
    for (int pi = gw; pi < M_TOK / 2; pi += NGW) {
        f32x4 y[2][8];
        if (SRC16) { v2u w_[2][8];
#pragma unroll
            for (int r = 0; r < 2; ++r)
#pragma unroll
                for (int j = 0; j < 8; ++j) w_[r][j] = ((const v2u*)(hsrc16 + ((size_t)2 * pi + r) * DM))[lane + 64 * j];
            __builtin_amdgcn_sched_barrier(0);
#pragma unroll
            for (int r = 0; r < 2; ++r)
#pragma unroll
                for (int j = 0; j < 8; ++j) y[r][j] = (f32x4){bflo(w_[r][j].x), bfhi(w_[r][j].x), bflo(w_[r][j].y), bfhi(w_[r][j].y)};
        } else {
#pragma unroll
            for (int r = 0; r < 2; ++r)
#pragma unroll
                for (int j = 0; j < 8; ++j) y[r][j] = ((const f32x4*)(hsrc + ((size_t)2 * pi + r) * DM))[lane + 64 * j];
            __builtin_amdgcn_sched_barrier(0);
        }
#pragma unroll
        for (int r = 0; r < 2; ++r) {
            const size_t row = (size_t)2 * pi + r;
            float ss = 0.f;
#pragma unroll
            for (int j = 0; j < 8; ++j) ss += (y[r][j].x * y[r][j].x + y[r][j].y * y[r][j].y) + (y[r][j].z * y[r][j].z + y[r][j].w * y[r][j].w);
            ss = wave_sum(ss);
            const float rstd = 1.0f / sqrtf(ss * (1.0f / DM) + RMS_EPS);
            v2u* dst = (v2u*)(HN + row * DM) + lane;
#pragma unroll
            for (int j = 0; j < 8; ++j) { y[r][j] = y[r][j] * rstd * lw[j];
                v2u o; o.x = pkbf(y[r][j].x, y[r][j].y); o.y = pkbf(y[r][j].z, y[r][j].w); dst[64 * j] = o; }
        }
        if (GBV) {
            float keep0 = 0.f, keep1 = 0.f;
#pragma unroll 1
            for (int c = 0; c < 16; ++c) {
                float a0 = 0.f, a1 = 0.f;
                const LAS f32x4* wp = (const LAS f32x4*)(wabT + c * DM) + lane;
#pragma unroll
                for (int j = 0; j < 8; ++j) { const f32x4 w = wp[64 * j];
                    a0 += (y[0][j].x * w.x + y[0][j].y * w.y) + (y[0][j].z * w.z + y[0][j].w * w.w);
                    a1 += (y[1][j].x * w.x + y[1][j].y * w.y) + (y[1][j].z * w.z + y[1][j].w * w.w); }
                a0 = wave_sum(a0); a1 = wave_sum(a1);
                if (lane == c) { keep0 = a0; keep1 = a1; }
            }
            if (lane < 16) { GB[((size_t)2 * pi) * 16 + lane] = keep0; GB[((size_t)2 * pi + 1) * 16 + lane] = keep1; }
        }
    }
}

__device__ __forceinline__ void convert_w_in(Frame& F, int layer, int wg0) {
    const int j = layer >> 1; bf16* dst = (layer & 1) ? (bf16*)(F.ws + WS_WIN2) : F.WIN;
    if ((layer & 1) == 0) { const float* w = F.in[10] + (size_t)j * DM * EV_IN_W;
        tr_matrix(F, w, EV_IN_W, 0, DM, dst, 0, 4096, wg0); tr_matrix(F, w, EV_IN_W, 4112, DM, dst, 4096, 2048, wg0);
    } else tr_matrix(F, F.in[23] + (size_t)j * DM * NPROJ, NPROJ, 0, DM, dst, 0, NPROJ, wg0);
}
__device__ __forceinline__ void convert_w_rest(Frame& F, int layer, int wg0) {
    const int j = layer >> 1;
    tr_matrix(F, ((layer & 1) ? F.in[24] : F.in[11]) + (size_t)j * DM * DM, DM, 0, DM, F.WOUT, 0, DM, wg0);
    tr_matrix(F, F.in[5] + (size_t)layer * DM * DFF, DFF, 0, DM, F.WUP, 0, DFF, wg0, F.in[3] + (size_t)layer * DM);
    tr_matrix(F, F.in[6] + (size_t)layer * DFF * DM, DM, 0, DFF, F.WDOWN, 0, DM, wg0);
    tr_matrix(F, F.in[8] + (size_t)layer * DM * DM, DM, 0, DM, F.WGATE, 0, DM, wg0, F.in[4] + (size_t)layer * DM);
}
__device__ __forceinline__ void phase_t1(Frame& F, int layer) {
    const int j = layer >> 1; const bool even = (layer & 1) == 0;
    if (layer == 0) convert_w_in(F, 0, 0);
    tr_matrix(F, F.in[7] + (size_t)layer * PLE * DM, DM, 0, PLE, F.WPP, 0, DM);
    if (even) {
        bf16* WLT = (bf16*)(F.ws + WS_WLT); const float* wa = F.in[18] + (size_t)j * 8 * 128 * 128; const float* wx = F.in[20] + (size_t)j * 8 * 128 * 128;
        for (int i = F.bx * 512 + F.tid; i < 8 * 256 * 16; i += F.G * 512) { const int o = i & 255, gi = i >> 8; const int gg = gi >> 4, in0 = (gi & 15) * 8;
            const float* src = (o < 128 ? wa : wx) + ((size_t)gg * 128 + in0) * 128 + (o & 127);
            v4u w; w.x = pk2(src[0], src[128]); w.y = pk2(src[256], src[384]); w.z = pk2(src[512], src[640]); w.w = pk2(src[768], src[896]);
            *(v4u*)(WLT + ((size_t)gg * 256 + o) * 128 + in0) = w; }
    }
    {
        const f32x4* src = (const f32x4*)(F.in[1] + (size_t)layer * M_TOK * PLE);
        const size_t n8 = (size_t)M_TOK * PLE / 8, stride = (size_t)F.G * 512;
        for (size_t i = (size_t)F.bx * 512 + F.tid; i < n8; i += 4 * stride) { f32x4 a[4], b[4];
#pragma unroll
            for (int u = 0; u < 4; ++u) { a[u] = src[2 * (i + u * stride)]; b[u] = src[2 * (i + u * stride) + 1]; }
            __builtin_amdgcn_sched_barrier(0);
#pragma unroll
            for (int u = 0; u < 4; ++u) { v4u o; o.x = pkbf(a[u].x, a[u].y); o.y = pkbf(a[u].z, a[u].w); o.z = pkbf(b[u].x, b[u].y); o.w = pkbf(b[u].z, b[u].w); ((v4u*)F.PB)[i + u * stride] = o; } }
    }
    const void* hsrc = (layer == 0) ? (const void*)F.in[0] : (const void*)F.H16;
    const float* lnw = F.in[2] + (size_t)layer * DM;
    if (even) {
        __syncthreads();
        LAS float* wabT = (LAS float*)(F.lds + RING_OFF);
        const float* w = F.in[10] + (size_t)j * DM * EV_IN_W + 4096;
        for (int i = F.tid; i < 16 * DM; i += 512) { const int k = i >> 4, c = i & 15; wabT[c * DM + k] = w[(size_t)k * EV_IN_W + c]; }
        __syncthreads();
        if (layer == 0) rms_rows<true, false>(F, hsrc, lnw, F.HN, F.GB); else rms_rows<true, true>(F, hsrc, lnw, F.HN, F.GB);
        __syncthreads();
    } else rms_rows<false, true>(F, hsrc, lnw, F.HN, nullptr);
}

__device__ __forceinline__ void lru_carry(Frame& F, int id) {
    const int b = id >> 10, ch = id & 1023;
    const f32x2* LSUM = (const f32x2*)(F.ws + WS_LSUM) + (size_t)b * 128 * 1024 + ch; float* LCIN = (float*)(F.ws + WS_LCIN) + (size_t)b * 128 * 1024 + ch;
    float carry = 0.f;
    for (int t0 = 0; t0 < 128; t0 += 8) { f32x2 s[8];
#pragma unroll
        for (int i = 0; i < 8; ++i) s[i] = LSUM[(size_t)(t0 + i) * 1024];
#pragma unroll
        for (int i = 0; i < 8; ++i) { LCIN[(size_t)(t0 + i) * 1024] = carry; carry = s[i].x * carry + s[i].y; } }
}

__device__ __forceinline__ void lru_final(Frame& F) {
    const bf16* HL = F.HN; const bf16* PC = F.HN + (size_t)M_TOK * 1024; const bf16* PROJ = F.BIG; const float* LCIN = (const float*)(F.ws + WS_LCIN);
    const size_t n8 = (size_t)M_TOK * 1024 / 8, stride = (size_t)F.G * 512;
    for (size_t i = (size_t)F.bx * 512 + F.tid; i < n8; i += stride) {
        const size_t m = i >> 7; const int c0 = (int)(i & 127) * 8; const size_t tile = m >> 6;
        const v4u hw = *(const v4u*)(HL + m * 1024 + c0), pw = *(const v4u*)(PC + m * 1024 + c0), yw = *(const v4u*)(PROJ + m * NPROJ + 5120 + c0);
        const f32x4 ca = *(const f32x4*)(LCIN + tile * 1024 + c0), cb = *(const f32x4*)(LCIN + tile * 1024 + c0 + 4); __builtin_amdgcn_sched_barrier(0);
        v4u o;
        o.x = pk2((bflo(hw.x) + bflo(pw.x) * ca.x) * gelu_tanh(bflo(yw.x)), (bfhi(hw.x) + bfhi(pw.x) * ca.y) * gelu_tanh(bfhi(yw.x)));
        o.y = pk2((bflo(hw.y) + bflo(pw.y) * ca.z) * gelu_tanh(bflo(yw.y)), (bfhi(hw.y) + bfhi(pw.y) * ca.w) * gelu_tanh(bfhi(yw.y)));
        o.z = pk2((bflo(hw.z) + bflo(pw.z) * cb.x) * gelu_tanh(bflo(yw.z)), (bfhi(hw.z) + bfhi(pw.z) * cb.y) * gelu_tanh(bfhi(yw.z)));
        o.w = pk2((bflo(hw.w) + bflo(pw.w) * cb.z) * gelu_tanh(bflo(yw.w)), (bfhi(hw.w) + bfhi(pw.w) * cb.w) * gelu_tanh(bfhi(yw.w)));
        *(v4u*)(F.MIX + m * DM + 1024 + c0) = o;
    }
}

__device__ __forceinline__ void dn_final(Frame& F, int j) {
    const int gw = F.bx * NWAVES + F.wave, NGW = F.G * NWAVES, lane = F.lane; const int h = lane >> 3, c0 = (lane & 7) * 16;
    const bf16* PROJ = F.BIG; const float* nw = F.in[15] + j * 128 + c0;
    float wv[16];
#pragma unroll
    for (int i = 0; i < 4; ++i) { const f32x4 w4 = *(const f32x4*)(nw + 4 * i); wv[4 * i] = w4.x; wv[4 * i + 1] = w4.y; wv[4 * i + 2] = w4.z; wv[4 * i + 3] = w4.w; }
    for (int m = gw; m < M_TOK; m += NGW) {
        v4u* op = (v4u*)(F.MIX + (size_t)m * DM + h * 128 + c0); const v4u* zp = (const v4u*)(PROJ + (size_t)m * NPROJ + 3072 + h * 128 + c0);
        const v4u o0 = op[0], o1 = op[1], z0 = zp[0], z1 = zp[1]; __builtin_amdgcn_sched_barrier(0);
        float o[16], z[16]; unpack8(o0, o); unpack8(o1, o + 8); unpack8(z0, z); unpack8(z1, z + 8);
        float ss = 0.f;
#pragma unroll
        for (int i = 0; i < 16; ++i) ss += o[i] * o[i];
        ss = row8_sum(ss); const float r = 1.0f / sqrtf(ss * (1.0f / 128.0f) + RMS_EPS);
#pragma unroll
        for (int i = 0; i < 16; ++i) o[i] = o[i] * r * wv[i] * siluf_(z[i]);
        op[0] = pack8(o); op[1] = pack8(o + 8);
    }
}
typedef short bf16x8 __attribute__((ext_vector_type(8)));
typedef short s16x4 __attribute__((ext_vector_type(4)));
typedef float f32x16 __attribute__((ext_vector_type(16)));
#define MFMA32(a, b, c) __builtin_amdgcn_mfma_f32_32x32x16_bf16((a), (b), (c), 0, 0, 0)
#define TR16(p) __builtin_amdgcn_ds_read_tr16_b64_v4i16((LAS s16x4*)(p))
__device__ __forceinline__ bf16x8 pack_acc8(const f32x16& x, int s) {
    v4u p; p.x = pkbf(x[8 * s + 0], x[8 * s + 1]); p.y = pkbf(x[8 * s + 2], x[8 * s + 3]); p.z = pkbf(x[8 * s + 4], x[8 * s + 5]); p.w = pkbf(x[8 * s + 6], x[8 * s + 7]);
    return __builtin_bit_cast(bf16x8, p);
}
__device__ __forceinline__ v4u scale8(v4u x, float sc) {
    v4u o; o.x = pkbf(bflo(x.x) * sc, bfhi(x.x) * sc); o.y = pkbf(bflo(x.y) * sc, bfhi(x.y) * sc); o.z = pkbf(bflo(x.z) * sc, bfhi(x.z) * sc); o.w = pkbf(bflo(x.w) * sc, bfhi(x.w) * sc); return o;
}
constexpr int RT_QS = 272, RT_VS = 320, RT_S8 = 264;
constexpr int RT_QL = 0, RT_KL = 64 * RT_QS, RT_QD = 2 * 64 * RT_QS, RT_KT = RT_QD + 64 * RT_S8, RT_VL = RT_KT + 64 * RT_VS, RT_VSC = RT_VL + 64 * RT_VS, RT_PSH = RT_VSC + 64 * RT_VS;
static_assert(RT_PSH + 6 * 1024 <= LDSCTL_OFF, "retention LDS map");
__device__ __forceinline__ void ret_chunk(Frame& F, int wg) {
    const int tid = F.tid, lane = F.lane, wave = F.wave;
    const int bh = wg >> 1, b = bh >> 2, h = bh & 3, half = wg & 1;
    const bf16* PROJ = F.BIG; float* ORET = (float*)F.HN;
    LAS unsigned char* L = F.lds + RING_OFF;
    const float lg = log2f(1.0f - exp2f(-5.0f - (float)h));
    const float g64 = exp2f(64.0f * lg);
    const int r = lane & 31, hh = lane >> 5, q4 = (lane & 15) >> 2, p4 = lane & 3, cb = (lane >> 4) & 1;
    const int srow = (tid & 255) >> 4, sch = tid & 15;
    v4u pq[2][4], pk[2][4], pv[2][4];
    const size_t mrow0 = (size_t)b * SEQ;
#define RT_ISSUE(SET_, n_) do { _Pragma("unroll") for (int u = 0; u < 4; ++u) { const bf16* rp = PROJ + (mrow0 + (size_t)(n_) * 64 + srow + 16 * u) * NPROJ; \
            pq[SET_][u] = *(const v4u*)(rp + 3072 + h * 128 + sch * 8); pk[SET_][u] = *(const v4u*)(rp + 3584 + h * 128 + sch * 8); pv[SET_][u] = *(const v4u*)(rp + 4096 + h * 256 + half * 128 + sch * 8); } } while (0)
#define RT_COMMIT_A(SET_) do { _Pragma("unroll") for (int u = 0; u < 4; ++u) { const int row = srow + 16 * u; \
            *(LAS v4u*)(L + RT_QL + row * RT_QS + sch * 16) = pq[SET_][u]; *(LAS v4u*)(L + RT_KL + row * RT_QS + sch * 16) = pk[SET_][u]; } } while (0)
#define RT_COMMIT_B(SET_) do { _Pragma("unroll") for (int u = 0; u < 4; ++u) { const int row = srow + 16 * u; \
            { const v4u qd_ = scale8(pq[SET_][u], exp2f((float)(row + 1) * lg)); *(LAS v2u*)(L + RT_QD + row * RT_S8 + sch * 16) = (v2u){qd_.x, qd_.y}; *(LAS v2u*)(L + RT_QD + row * RT_S8 + sch * 16 + 8) = (v2u){qd_.z, qd_.w}; } \
            *(LAS v4u*)(L + RT_KT + row * RT_VS + sch * 16) = pk[SET_][u]; \
            *(LAS v4u*)(L + RT_VL + row * RT_VS + sch * 16) = pv[SET_][u]; \
            *(LAS v4u*)(L + RT_VSC + row * RT_VS + sch * 16) = scale8(pv[SET_][u], exp2f((float)(63 - row) * lg) * SC128); } } while (0)
    f32x16 S[4];
#pragma unroll
    for (int t = 0; t < 4; ++t)
#pragma unroll
        for (int e = 0; e < 16; ++e) S[t][e] = 0.f;
    if (wave >= 4) {
        RT_ISSUE(0, 0); RT_COMMIT_A(0); RT_COMMIT_B(0); RT_ISSUE(1, 1); RT_ISSUE(0, 2);
        LDS_BARRIER();
        v4u qdx[4], vsx[4];
#define RT_SCALE_B(SET_) do { _Pragma("unroll") for (int u = 0; u < 4; ++u) { const int row = srow + 16 * u; qdx[u] = scale8(pq[SET_][u], exp2f((float)(row + 1) * lg)); vsx[u] = scale8(pv[SET_][u], exp2f((float)(63 - row) * lg) * SC128); asm volatile("" : "+v"(qdx[u]), "+v"(vsx[u])); } } while (0)
#define RT_WRITE_B(SET_) do { _Pragma("unroll") for (int u = 0; u < 4; ++u) { const int row = srow + 16 * u; \
            *(LAS v2u*)(L + RT_QD + row * RT_S8 + sch * 16) = (v2u){qdx[u].x, qdx[u].y}; *(LAS v2u*)(L + RT_QD + row * RT_S8 + sch * 16 + 8) = (v2u){qdx[u].z, qdx[u].w}; \
            *(LAS v4u*)(L + RT_KT + row * RT_VS + sch * 16) = pk[SET_][u]; \
            *(LAS v4u*)(L + RT_VL + row * RT_VS + sch * 16) = pv[SET_][u]; \
            *(LAS v4u*)(L + RT_VSC + row * RT_VS + sch * 16) = vsx[u]; } } while (0)
        for (int n = 0; n < SEQ / 64; n += 2) {
            LDS_BARRIER(); RT_COMMIT_A(1); RT_SCALE_B(1);
            LDS_BARRIER(); RT_WRITE_B(1); if (n + 3 < SEQ / 64) RT_ISSUE(1, n + 3);
            LDS_BARRIER(); if (n + 2 < SEQ / 64) { RT_COMMIT_A(0); RT_SCALE_B(0); }
            LDS_BARRIER(); if (n + 2 < SEQ / 64) { RT_WRITE_B(0); if (n + 4 < SEQ / 64) RT_ISSUE(0, n + 4); }
        }
#undef RT_SCALE_B
#undef RT_WRITE_B
    } else {
    __builtin_amdgcn_s_setprio(3);
    LDS_BARRIER();
    for (int n = 0; n < SEQ / 64; ++n) {
        {
            const int w = wave;
            if (w < 3) {
                f32x16 pt;
#pragma unroll
                for (int e = 0; e < 16; ++e) pt[e] = 0.f;
                const int krow = (w == 2 ? 32 : 0) + r, qrow = (w == 0 ? 0 : 32) + r;
                bf16x8 kq[3][2];
#define RT_PT_RD(s_, b_) do { kq[b_][0] = *(const LAS bf16x8*)(L + RT_KL + krow * RT_QS + (16 * (s_) + 8 * hh) * 2); kq[b_][1] = *(const LAS bf16x8*)(L + RT_QL + qrow * RT_QS + (16 * (s_) + 8 * hh) * 2); } while (0)
                RT_PT_RD(0, 0); RT_PT_RD(1, 1);
#pragma unroll
                for (int s = 0; s < 8; ++s) {
                    if (s + 2 < 8) RT_PT_RD(s + 2, (s + 2) % 3);
                    __builtin_amdgcn_sched_barrier(0);
                    pt = MFMA32(kq[s % 3][0], kq[s % 3][1], pt);
                    __builtin_amdgcn_sched_barrier(0);
                }
#undef RT_PT_RD
#pragma unroll
                for (int e = 0; e < 16; ++e) { const int jr = (e & 3) + 8 * (e >> 2) + 4 * hh; const int dd = r - jr;
                    const float fd = (w == 1) ? exp2f((float)(dd + 32) * lg) * SC128 : (dd >= 0 ? exp2f((float)dd * lg) * SC128 : 0.f);
                    pt[e] *= fd; }
                *(LAS bf16x8*)(L + RT_PSH + (2 * w) * 1024 + lane * 16) = pack_acc8(pt, 0);
                *(LAS bf16x8*)(L + RT_PSH + (2 * w + 1) * 1024 + lane * 16) = pack_acc8(pt, 1);
            }
            LDS_BARRIER();
            bf16x8 pf[3][2];
#pragma unroll
            for (int t = 0; t < 3; ++t) { pf[t][0] = *(const LAS bf16x8*)(L + RT_PSH + (2 * t) * 1024 + lane * 16); pf[t][1] = *(const LAS bf16x8*)(L + RT_PSH + (2 * t + 1) * 1024 + lane * 16); }
            const LAS unsigned char* vb = L + RT_VL + (4 * hh + q4) * RT_VS + (32 * w + 16 * cb + 4 * p4) * 2;
            s16x4 vr[2][4];
#pragma unroll
            for (int s = 0; s < 2; ++s) { vr[s][0] = TR16(vb + (16 * s) * RT_VS); vr[s][1] = TR16(vb + (16 * s + 8) * RT_VS); vr[s][2] = TR16(vb + (32 + 16 * s) * RT_VS); vr[s][3] = TR16(vb + (32 + 16 * s + 8) * RT_VS); }
            s16x4 qd[3][4];
#define RT_QD_RD(i_, b_) do { const LAS unsigned char* qa = L + RT_QD + r * RT_S8 + (32 * ((i_) >> 1) + 16 * ((i_) & 1) + 4 * hh) * 2; \
                qd[b_][0] = *(const LAS s16x4*)(qa); qd[b_][1] = *(const LAS s16x4*)(qa + 16); qd[b_][2] = *(const LAS s16x4*)(qa + 32 * RT_S8); qd[b_][3] = *(const LAS s16x4*)(qa + 32 * RT_S8 + 16); } while (0)
            RT_QD_RD(0, 0); RT_QD_RD(1, 1);
            __builtin_amdgcn_sched_barrier(0);
            f32x16 o0, o1;
#pragma unroll
            for (int e = 0; e < 16; ++e) { o0[e] = 0.f; o1[e] = 0.f; }
#pragma unroll
            for (int s = 0; s < 2; ++s) {
                const bf16x8 v0 = __builtin_shufflevector(vr[s][0], vr[s][1], 0, 1, 2, 3, 4, 5, 6, 7);
                const bf16x8 v1 = __builtin_shufflevector(vr[s][2], vr[s][3], 0, 1, 2, 3, 4, 5, 6, 7);
                o0 = MFMA32(pf[0][s], v0, o0);
                o1 = MFMA32(pf[1][s], v0, o1);
                o1 = MFMA32(pf[2][s], v1, o1);
            }
            const LAS unsigned char* kb = L + RT_KT + (8 * hh + q4) * RT_VS + (16 * cb + 4 * p4) * 2;
            const LAS unsigned char* sb2 = L + RT_VSC + (8 * hh + q4) * RT_VS + (32 * w + 16 * cb + 4 * p4) * 2;
            s16x4 ks[2][10];
#define RT_SU_RD(sp_, b_) do { ks[b_][0] = TR16(sb2 + (16 * (sp_)) * RT_VS); ks[b_][1] = TR16(sb2 + (16 * (sp_) + 4) * RT_VS); \
                _Pragma("unroll") for (int t = 0; t < 4; ++t) { ks[b_][2 + 2 * t] = TR16(kb + (16 * (sp_)) * RT_VS + 64 * t); ks[b_][3 + 2 * t] = TR16(kb + (16 * (sp_) + 4) * RT_VS + 64 * t); } } while (0)
#pragma unroll
            for (int i = 0; i < 8; ++i) {
                if (i + 2 < 8) RT_QD_RD(i + 2, (i + 2) % 3); else if (i == 6) RT_SU_RD(0, 0);
                __builtin_amdgcn_sched_barrier(0);
                const bf16x8 sb = pack_acc8(S[i >> 1], i & 1);
                o0 = MFMA32(__builtin_shufflevector(qd[i % 3][0], qd[i % 3][1], 0, 1, 2, 3, 4, 5, 6, 7), sb, o0);
                o1 = MFMA32(__builtin_shufflevector(qd[i % 3][2], qd[i % 3][3], 0, 1, 2, 3, 4, 5, 6, 7), sb, o1);
                __builtin_amdgcn_sched_barrier(0);
            }
#undef RT_QD_RD
            {   float* op = ORET + (mrow0 + (size_t)n * 64) * 1024 + h * 256 + half * 128 + 32 * w + r;
#pragma unroll
                for (int e = 0; e < 16; ++e) { const int ir = (e & 3) + 8 * (e >> 2) + 4 * hh; op[(size_t)ir * 1024] = o0[e]; op[(size_t)(32 + ir) * 1024] = o1[e]; } }
#pragma unroll
            for (int t = 0; t < 4; ++t)
#pragma unroll
                for (int e = 0; e < 16; ++e) S[t][e] *= g64;
#pragma unroll
            for (int sp = 0; sp < 4; ++sp) {
                if (sp + 1 < 4) RT_SU_RD(sp + 1, (sp + 1) & 1);
                __builtin_amdgcn_sched_barrier(0);
                const bf16x8 bv = __builtin_shufflevector(ks[sp & 1][0], ks[sp & 1][1], 0, 1, 2, 3, 4, 5, 6, 7);
#pragma unroll
                for (int t = 0; t < 4; ++t) S[t] = MFMA32(__builtin_shufflevector(ks[sp & 1][2 + 2 * t], ks[sp & 1][3 + 2 * t], 0, 1, 2, 3, 4, 5, 6, 7), bv, S[t]);
                __builtin_amdgcn_sched_barrier(0);
            }
#undef RT_SU_RD
        }
        LDS_BARRIER();
    }
    __builtin_amdgcn_s_setprio(0);
    }
#undef RT_ISSUE
#undef RT_COMMIT_A
#undef RT_COMMIT_B
}

constexpr int LG_XA = 0, LG_XF = 64 * 272, LG_LA = LG_XF + 64 * 132 * 4, LG_SUM = LG_LA + 64 * 132 * 4;
__device__ __forceinline__ void lru_gates_mfma(Frame& F, int j) {
    const int lane = F.lane, wave = F.wave; const int r = lane & 31, hh = lane >> 5;
    const bf16* PROJ = F.BIG; bf16* HL = F.HN; bf16* PC = F.HN + (size_t)M_TOK * 1024; f32x2* LSUM = (f32x2*)(F.ws + WS_LSUM);
    LAS unsigned char* L = F.lds + RING_OFF; LAS float* XF = (LAS float*)(L + LG_XF); LAS float* LA = (LAS float*)(L + LG_LA); LAS f32x2* SUMS = (LAS f32x2*)(L + LG_SUM);
    const int g = F.bx & 7; const int it = wave & 1, ct = wave >> 1;
    const bf16* WLT = (const bf16*)(F.ws + WS_WLT) + (size_t)g * 256 * 128;
    const float* convw = F.in[16] + (size_t)j * 4 * 1024 + g * 128; const float* convb = F.in[17] + (size_t)j * 1024 + g * 128;
    bf16x8 waf[8], wxf[8];
#pragma unroll
    for (int s = 0; s < 8; ++s) { waf[s] = *(const bf16x8*)(WLT + (32 * ct + r) * 128 + 16 * s + 8 * hh); wxf[s] = *(const bf16x8*)(WLT + (128 + 32 * ct + r) * 128 + 16 * s + 8 * hh); }
    const int chl = 32 * ct + r, chg = g * 128 + chl;
    const float ba_c = F.in[19][(size_t)j * 1024 + chg], bx_c = F.in[21][(size_t)j * 1024 + chg], sp8 = 8.0f * softplusf_(-F.in[22][(size_t)j * 1024 + chg]);
    for (int tile = F.bx >> 3; tile < M_TOK / 64; tile += F.G >> 3) {
        const int m0 = tile * 64;
        int tid = F.tid; asm volatile("" : "+v"(tid));
        {   const int tok = tid >> 3, c0 = (tid & 7) * 16; const int m = m0 + tok, t = m & (SEQ - 1);
            float a[16];
#pragma unroll
            for (int i = 0; i < 4; ++i) { const f32x4 b4 = *(const f32x4*)(convb + c0 + 4 * i); a[4 * i] = b4.x; a[4 * i + 1] = b4.y; a[4 * i + 2] = b4.z; a[4 * i + 3] = b4.w; }
            v4u xq[4][2];
#pragma unroll
            for (int jj = 0; jj < 4; ++jj) { const bool ok = (t - 3 + jj) >= 0; const v4u* xp = (const v4u*)(PROJ + (size_t)(ok ? m - 3 + jj : m) * NPROJ + 4096 + g * 128 + c0); xq[jj][0] = xp[0]; xq[jj][1] = xp[1]; }
            __builtin_amdgcn_sched_barrier(0);
#pragma unroll
            for (int jj = 0; jj < 4; ++jj) { const float fz = (t - 3 + jj) >= 0 ? 1.0f : 0.0f; const v4u x0 = xq[jj][0], x1 = xq[jj][1];
                const unsigned xw[8] = {x0.x, x0.y, x0.z, x0.w, x1.x, x1.y, x1.z, x1.w};
#pragma unroll
                for (int i = 0; i < 4; ++i) { const f32x4 w4 = *(const f32x4*)(convw + jj * 1024 + c0 + 4 * i) * fz;
                    a[4 * i] += w4.x * bflo(xw[2 * i]); a[4 * i + 1] += w4.y * bfhi(xw[2 * i]); a[4 * i + 2] += w4.z * bflo(xw[2 * i + 1]); a[4 * i + 3] += w4.w * bfhi(xw[2 * i + 1]); } }
            v4u w0, w1; w0.x = pkbf(a[0], a[1]); w0.y = pkbf(a[2], a[3]); w0.z = pkbf(a[4], a[5]); w0.w = pkbf(a[6], a[7]); w1.x = pkbf(a[8], a[9]); w1.y = pkbf(a[10], a[11]); w1.z = pkbf(a[12], a[13]); w1.w = pkbf(a[14], a[15]);
            *(LAS v4u*)(L + LG_XA + tok * 272 + c0 * 2) = w0; *(LAS v4u*)(L + LG_XA + tok * 272 + c0 * 2 + 16) = w1;
#pragma unroll
            for (int i = 0; i < 4; ++i) *(LAS f32x4*)(XF + tok * 132 + c0 + 4 * i) = (f32x4){a[4 * i], a[4 * i + 1], a[4 * i + 2], a[4 * i + 3]};
        }
        LDS_BARRIER();
        {   f32x16 aa, ax;
#pragma unroll
            for (int e = 0; e < 16; ++e) { aa[e] = 0.f; ax[e] = 0.f; }
#pragma unroll
            for (int s = 0; s < 8; ++s) { const bf16x8 af = *(const LAS bf16x8*)(L + LG_XA + (32 * it + r) * 272 + (16 * s + 8 * hh) * 2); aa = MFMA32(af, waf[s], aa); ax = MFMA32(af, wxf[s], ax); }
#pragma unroll
            for (int e = 0; e < 16; ++e) { const int tok = 32 * it + (e & 3) + 8 * (e >> 2) + 4 * hh;
                const float rr = sigmoidf_(aa[e] + ba_c), ii = sigmoidf_(ax[e] + bx_c); const float la = -rr * sp8; const float x = XF[tok * 132 + chl];
                LA[tok * 132 + chl] = la; XF[tok * 132 + chl] = sqrtf(neg_expm1f_(2.0f * la)) * (ii * x); }
        }
        LDS_BARRIER();
        {
            const int ch = tid & 127, seg = tid >> 7; float hl[16], pl[16]; float hs = 0.f, pr = 1.f;
#pragma unroll
            for (int k = 0; k < 16; ++k) { const int tok = 16 * seg + k; const float a = __expf(LA[tok * 132 + ch]); hs = a * hs + XF[tok * 132 + ch]; pr *= a; hl[k] = hs; pl[k] = pr; }
            SUMS[seg * 128 + ch] = (f32x2){pr, hs};
            LDS_BARRIER();
            float carry = 0.f, pp = 1.f;
            for (int s2 = 0; s2 < seg; ++s2) { const f32x2 sv = SUMS[s2 * 128 + ch]; carry = sv.x * carry + sv.y; pp *= sv.x; }
            bf16* hp = HL + (size_t)(m0 + 16 * seg) * 1024 + g * 128 + ch; bf16* pq = PC + (size_t)(m0 + 16 * seg) * 1024 + g * 128 + ch;
#pragma unroll
            for (int k = 0; k < 16; ++k) { hp[(size_t)k * 1024] = (bf16)f2bf(hl[k] + pl[k] * carry); pq[(size_t)k * 1024] = (bf16)f2bf(pl[k] * pp); }
            if (seg == 3) LSUM[(size_t)tile * 1024 + g * 128 + ch] = (f32x2){pl[15] * pp, hl[15] + pl[15] * carry};
        }
        LDS_BARRIER();
    }
}

constexpr int DP_KH = 0, DP_QH = 64 * 272, DP_KB = 2 * 64 * 272, DP_VB = DP_KB + 64 * 320, DP_MT = DP_VB + 64 * 320, DP_TL = DP_MT + 64 * 272, DP_SC = DP_TL + 64 * 144, DP_CW = DP_SC + 1024;
static_assert(DP_CW + 4 * 3072 * 4 <= LDSCTL_OFF, "DeltaNet prep LDS map");
__device__ __forceinline__ void dn_chunk_prep(Frame& F, int j, int n_lo, int n_hi, int wg0) {
    const int wave = F.wave;
    const bf16* PROJ = F.BIG;
    bf16* NWg = F.BIG + (size_t)M_TOK * NPROJ; bf16* QDg = NWg + (size_t)M_TOK * 1024; bf16* KDg = F.PPB; bf16* Ug = F.PPB + (size_t)M_TOK * 1024;
    bf16* QKg = (bf16*)(F.ws + WS_DQK); float* GTg = (float*)(F.ws + WS_DGT);
    const float* cw = F.in[12] + (size_t)j * 4 * 3072; const float* a_log = F.in[13] + j * 8; const float* dtb = F.in[14] + j * 8;
    LAS unsigned char* L = F.lds + RING_OFF;
    LAS float* Mt = (LAS float*)(L + DP_MT);
    LAS float* bet = (LAS float*)(L + DP_SC); LAS float* gl = bet + 64; LAS float* gcl = gl + 64;
    LAS float* cwl = (LAS float*)(L + DP_CW);
    {   f32x4 wq[6];
#pragma unroll
        for (int u = 0; u < 6; ++u) wq[u] = *(const f32x4*)(cw + 4 * (F.tid + 512 * u));
#pragma unroll
        for (int u = 0; u < 6; ++u) *(LAS f32x4*)(cwl + 4 * (F.tid + 512 * u)) = wq[u]; }
    v4u rg[7];
#define DP_RAWLOAD(idx_, tidp_) do { const int bh_ = (idx_) & 31, n_ = n_lo + ((idx_) >> 5); const size_t m0_ = (size_t)(bh_ >> 3) * SEQ + (size_t)n_ * 64; const int h_ = bh_ & 7; \
        _Pragma("unroll") for (int u = 0; u < 7; ++u) { const int id = (tidp_) + 512 * u; const int row = id / 48, ch = id - row * 48; rg[u] = (v4u){0u, 0u, 0u, 0u}; \
            if (id < 67 * 48 && (n_ > 0 || row >= 3)) rg[u] = *(const v4u*)(PROJ + (m0_ + row - 3) * NPROJ + (ch >> 4) * 1024 + h_ * 128 + (ch & 15) * 8); } } while (0)
    if (F.bx - wg0 < 32 * (n_hi - n_lo)) { int tp = F.tid; asm volatile("" : "+v"(tp)); DP_RAWLOAD(F.bx - wg0, tp); }
    for (int idx = F.bx - wg0; idx < 32 * (n_hi - n_lo); idx += F.G - wg0) {
        const int bh = idx & 31, n = n_lo + (idx >> 5); const int chunk = bh * 128 + n; const int b = bh >> 3, h = bh & 7;
        int tid = F.tid; asm volatile("" : "+v"(tid));
        const int lane = tid & 63; const int r = lane & 31, hh = lane >> 5, q4 = (lane & 15) >> 2, p4 = lane & 3, cb = (lane >> 4) & 1;
        const size_t m0 = (size_t)b * SEQ + (size_t)n * 64;
        const int tok = tid >> 3, c0 = (tid & 7) * 16; const size_t m = m0 + tok; const int t = (int)(m & (SEQ - 1));
        float qv[16], kv[16], vv[16];
        LDS_BARRIER();
        {   LAS unsigned char* raw = L + DP_KB;
#pragma unroll
            for (int u = 0; u < 7; ++u) { const int id = tid + 512 * u; const int row = id / 48, ch = id - row * 48; if (id < 67 * 48) *(LAS v4u*)(raw + row * 784 + ch * 16) = rg[u]; }
            LDS_BARRIER();
#pragma unroll
            for (int ten = 0; ten < 3; ++ten) {
                float a[16];
#pragma unroll
                for (int i = 0; i < 16; ++i) a[i] = 0.f;
                const int col = ten * 1024 + h * 128 + c0;
#pragma unroll 1
                for (int jj = 0; jj < 4; ++jj) { const LAS v4u* xp = (const LAS v4u*)(raw + (tok + jj) * 784 + ten * 256 + c0 * 2); const v4u x0 = xp[0], x1 = xp[1];
                    const unsigned xw[8] = {x0.x, x0.y, x0.z, x0.w, x1.x, x1.y, x1.z, x1.w};
#pragma unroll
                    for (int i = 0; i < 4; ++i) { const f32x4 w4 = *(const LAS f32x4*)(cwl + jj * 3072 + col + 4 * i);
                        a[4 * i] += w4.x * bflo(xw[2 * i]); a[4 * i + 1] += w4.y * bfhi(xw[2 * i]); a[4 * i + 2] += w4.z * bflo(xw[2 * i + 1]); a[4 * i + 3] += w4.w * bfhi(xw[2 * i + 1]); } }
#pragma unroll
                for (int i = 0; i < 16; ++i) { const float s = siluf_(a[i]); if (ten == 0) qv[i] = s; else if (ten == 1) kv[i] = s; else vv[i] = s; }
            }
        }
        {   float sq = 0.f, sk = 0.f;
#pragma unroll
            for (int i = 0; i < 16; ++i) { sq += qv[i] * qv[i]; sk += kv[i] * kv[i]; }
            sq += __shfl_xor(sq, 1); sq += __shfl_xor(sq, 2); sq += __shfl_xor(sq, 4);
            sk += __shfl_xor(sk, 1); sk += __shfl_xor(sk, 2); sk += __shfl_xor(sk, 4);
            const float fq = SC128 / sqrtf(sq + 1e-6f), fk = 1.0f / sqrtf(sk + 1e-6f);
#pragma unroll
            for (int i = 0; i < 16; ++i) { qv[i] *= fq; kv[i] *= fk; } }
        LDS_BARRIER();
        if ((tid & 7) == 0) { const float braw = F.GB[m * 16 + h], araw = F.GB[m * 16 + 8 + h];
            bet[tok] = sigmoidf_(braw); gl[tok] = -expf(a_log[h]) * softplusf_(araw + dtb[h]); }
        {
            v4u w0, w1;
            w0.x = pkbf(kv[0], kv[1]); w0.y = pkbf(kv[2], kv[3]); w0.z = pkbf(kv[4], kv[5]); w0.w = pkbf(kv[6], kv[7]); w1.x = pkbf(kv[8], kv[9]); w1.y = pkbf(kv[10], kv[11]); w1.z = pkbf(kv[12], kv[13]); w1.w = pkbf(kv[14], kv[15]);
            *(LAS v4u*)(L + DP_KH + tok * 272 + c0 * 2) = w0; *(LAS v4u*)(L + DP_KH + tok * 272 + c0 * 2 + 16) = w1;
            w0.x = pkbf(qv[0], qv[1]); w0.y = pkbf(qv[2], qv[3]); w0.z = pkbf(qv[4], qv[5]); w0.w = pkbf(qv[6], qv[7]); w1.x = pkbf(qv[8], qv[9]); w1.y = pkbf(qv[10], qv[11]); w1.z = pkbf(qv[12], qv[13]); w1.w = pkbf(qv[14], qv[15]);
            *(LAS v4u*)(L + DP_QH + tok * 272 + c0 * 2) = w0; *(LAS v4u*)(L + DP_QH + tok * 272 + c0 * 2 + 16) = w1; }
        LDS_BARRIER();
        if (wave == 0) { float v = gl[lane];
#pragma unroll
            for (int o = 1; o < 64; o <<= 1) { const float u = __shfl_up(v, o); if (lane >= o) v += u; }
            gcl[lane] = v; }
        LDS_BARRIER();
        {
            const float gct = gcl[tok], gclast = gcl[63], bt = bet[tok]; const float eg = __expf(gct), egl = __expf(gclast - gct), kbs = bt * eg;
            v4u w0, w1;
#define DP_PACK16(arr, sc) do { w0.x = pkbf(arr[0] * (sc), arr[1] * (sc)); w0.y = pkbf(arr[2] * (sc), arr[3] * (sc)); w0.z = pkbf(arr[4] * (sc), arr[5] * (sc)); w0.w = pkbf(arr[6] * (sc), arr[7] * (sc)); \
            w1.x = pkbf(arr[8] * (sc), arr[9] * (sc)); w1.y = pkbf(arr[10] * (sc), arr[11] * (sc)); w1.z = pkbf(arr[12] * (sc), arr[13] * (sc)); w1.w = pkbf(arr[14] * (sc), arr[15] * (sc)); } while (0)
            DP_PACK16(qv, eg); { v4u* gp = (v4u*)(QDg + m * 1024 + h * 128 + c0); gp[0] = w0; gp[1] = w1; }
            DP_PACK16(kv, egl); { v4u* gp = (v4u*)(KDg + m * 1024 + h * 128 + c0); gp[0] = w0; gp[1] = w1; }
            DP_PACK16(kv, kbs); *(LAS v4u*)(L + DP_KB + tok * 320 + c0 * 2) = w0; *(LAS v4u*)(L + DP_KB + tok * 320 + c0 * 2 + 16) = w1;
            DP_PACK16(vv, bt); *(LAS v4u*)(L + DP_VB + tok * 320 + c0 * 2) = w0; *(LAS v4u*)(L + DP_VB + tok * 320 + c0 * 2 + 16) = w1;
#undef DP_PACK16
            if (tid == 0) GTg[chunk] = __expf(gclast);
        }
        if (wave < 3) { const int it = wave == 0 ? 0 : 1, jt = wave == 2 ? 1 : 0;
            f32x16 acc;
#pragma unroll
            for (int e = 0; e < 16; ++e) acc[e] = 0.f;
#pragma unroll
            for (int s = 0; s < 8; ++s) { const bf16x8 a = *(const LAS bf16x8*)(L + DP_KH + (32 * it + r) * 272 + (16 * s + 8 * hh) * 2), bb = *(const LAS bf16x8*)(L + DP_KH + (32 * jt + r) * 272 + (16 * s + 8 * hh) * 2);
                acc = MFMA32(a, bb, acc); }
            const int jg = 32 * jt + r; const float gcj = gcl[jg];
#pragma unroll
            for (int g4 = 0; g4 < 4; ++g4) { f32x4 o;
#pragma unroll
                for (int e = 0; e < 4; ++e) { const int ig = 32 * it + 8 * g4 + 4 * hh + e; o[e] = ig > jg ? bet[ig] * acc[4 * g4 + e] * __expf(gcl[ig] - gcj) : 0.f; }
                *(LAS f32x4*)(Mt + jg * 68 + 32 * it + 8 * g4 + 4 * hh) = o; }
        } else if (wave == 3) {
#pragma unroll
            for (int g4 = 0; g4 < 4; ++g4) *(LAS f32x4*)(Mt + (32 + r) * 68 + 8 * g4 + 4 * hh) = (f32x4){0.f, 0.f, 0.f, 0.f};
        } else if (wave < 7) { const int jt = wave == 6 ? 1 : 0, it = wave == 4 ? 0 : 1;
            f32x16 acc;
#pragma unroll
            for (int e = 0; e < 16; ++e) acc[e] = 0.f;
#pragma unroll
            for (int s = 0; s < 8; ++s) { const bf16x8 a = *(const LAS bf16x8*)(L + DP_KH + (32 * jt + r) * 272 + (16 * s + 8 * hh) * 2), bb = *(const LAS bf16x8*)(L + DP_QH + (32 * it + r) * 272 + (16 * s + 8 * hh) * 2);
                acc = MFMA32(a, bb, acc); }
            const int ig = 32 * it + r; const float gci = gcl[ig];
#pragma unroll
            for (int g4 = 0; g4 < 4; ++g4) { float o[4];
#pragma unroll
                for (int e = 0; e < 4; ++e) { const int jg = 32 * jt + 8 * g4 + 4 * hh + e; o[e] = ig >= jg ? acc[4 * g4 + e] * __expf(gci - gcl[jg]) : 0.f; }
                v2u w; w.x = pkbf(o[0], o[1]); w.y = pkbf(o[2], o[3]);
                *(v2u*)(QKg + (size_t)chunk * 4096 + ig * 64 + 32 * jt + 8 * g4 + 4 * hh) = w; }
        }
        LDS_BARRIER();
        { const int nidx = idx + F.G - wg0; if (nidx < 32 * (n_hi - n_lo)) DP_RAWLOAD(nidx, tid); }
        if (wave == 0) {
            int ln = lane; asm volatile("" : "+v"(ln));
            const LAS float* MtO; { unsigned mo = (unsigned)(size_t)Mt; asm volatile("" : "+v"(mo)); MtO = (const LAS float*)(size_t)mo; }
            float tr[64];
#pragma unroll
            for (int k = 0; k < 64; ++k) tr[k] = (k == ln) ? 1.f : 0.f;
#pragma unroll
            for (int jc = 62; jc >= 0; --jc) {
                float s0 = 0.f, s1 = 0.f, s2 = 0.f, s3 = 0.f;
#pragma unroll
                for (int k4 = ((jc + 1) & ~3); k4 < 64; k4 += 4) { const f32x4 mv = *(const LAS f32x4*)(MtO + jc * 68 + k4);
                    s0 += tr[k4] * mv.x; s1 += tr[k4 + 1] * mv.y; s2 += tr[k4 + 2] * mv.z; s3 += tr[k4 + 3] * mv.w; }
                tr[jc] -= (s0 + s1) + (s2 + s3);
                asm volatile("" : "+v"(tr[jc]));
            }
#pragma unroll
            for (int k8 = 0; k8 < 8; ++k8) { v4u w; w.x = pkbf(tr[8 * k8], tr[8 * k8 + 1]); w.y = pkbf(tr[8 * k8 + 2], tr[8 * k8 + 3]); w.z = pkbf(tr[8 * k8 + 4], tr[8 * k8 + 5]); w.w = pkbf(tr[8 * k8 + 6], tr[8 * k8 + 7]);
                *(LAS v4u*)(L + DP_TL + ln * 144 + k8 * 16) = w; }
        }
        LDS_BARRIER();
#pragma unroll
        for (int jb = 0; jb < 2; ++jb) { const int job = 2 * wave + jb; const int mat = job >> 3, ft = (job >> 1) & 3, it = job & 1;
            f32x16 acc;
#pragma unroll
            for (int e = 0; e < 16; ++e) acc[e] = 0.f;
            const LAS unsigned char* rb = L + (mat ? DP_VB : DP_KB) + (8 * hh + q4) * 320 + (32 * ft + 16 * cb + 4 * p4) * 2;
#pragma unroll
            for (int s = 0; s < 4; ++s) { const s16x4 al = TR16(rb + (16 * s) * 320), ah = TR16(rb + (16 * s + 4) * 320);
                const bf16x8 tb = *(const LAS bf16x8*)(L + DP_TL + (32 * it + r) * 144 + (16 * s + 8 * hh) * 2);
                acc = MFMA32(__builtin_shufflevector(al, ah, 0, 1, 2, 3, 4, 5, 6, 7), tb, acc); }
            const float sg = mat ? 1.f : -1.f; bf16* dst = (mat ? Ug : NWg) + (m0 + 32 * it + r) * 1024 + h * 128 + 32 * ft + 4 * hh;
#pragma unroll
            for (int g4 = 0; g4 < 4; ++g4) { v2u w; w.x = pkbf(sg * acc[4 * g4], sg * acc[4 * g4 + 1]); w.y = pkbf(sg * acc[4 * g4 + 2], sg * acc[4 * g4 + 3]); *(v2u*)(dst + 8 * g4) = w; }
        }
    }
}
#undef DP_RAWLOAD

constexpr int DR_S8 = 264, DR_ST = 320, DR_SQ = 136;
constexpr int DR_NW = 0, DR_QD = 64 * DR_S8, DR_KD = 2 * 64 * DR_S8, DR_QK = DR_KD + 64 * DR_ST, DR_U = DR_QK + 64 * DR_SQ;
constexpr int DN_C1 = 40, DN_C2 = 84;
__device__ __forceinline__ void dn_chunk_recur(Frame& F, int wg, int n_lo, int n_hi) {
    const int tid = F.tid, lane = F.lane, wave = F.wave; const int b = wg >> 3, h = wg & 7;
    const bf16* NWg = F.BIG + (size_t)M_TOK * NPROJ; const bf16* QDg = NWg + (size_t)M_TOK * 1024; const bf16* KDg = F.PPB; const bf16* Ug = F.PPB + (size_t)M_TOK * 1024;
    const bf16* QKg = (const bf16*)(F.ws + WS_DQK) + (size_t)wg * 128 * 4096; const float* GTg = (const float*)(F.ws + WS_DGT) + wg * 128;
    LAS unsigned char* L = F.lds + RING_OFF;
    const int r = lane & 31, hh = lane >> 5, q4 = (lane & 15) >> 2, p4 = lane & 3, cb = (lane >> 4) & 1;
    const size_t mrow0 = (size_t)b * SEQ;
    const int srow = (tid & 255) >> 4, sch = tid & 15;
    v4u pa[2][4], pb[2][4], pc[2][4], pd[2][4], pe[2][2];
#define DR_ISSUE(SET_, n_) do { _Pragma("unroll") for (int u = 0; u < 4; ++u) { const size_t o = (mrow0 + (size_t)(n_) * 64 + srow + 16 * u) * 1024 + h * 128 + sch * 8; \
            pa[SET_][u] = *(const v4u*)(NWg + o); pb[SET_][u] = *(const v4u*)(QDg + o); pc[SET_][u] = *(const v4u*)(KDg + o); pd[SET_][u] = *(const v4u*)(Ug + o); } \
        _Pragma("unroll") for (int u = 0; u < 2; ++u) pe[SET_][u] = *(const v4u*)(QKg + (size_t)(n_) * 4096 + ((tid & 255) + 256 * u) * 8); } while (0)
#define DR_COMMIT_A(SET_) do { _Pragma("unroll") for (int u = 0; u < 4; ++u) { const int row = srow + 16 * u; \
            *(LAS v2u*)(L + DR_NW + row * DR_S8 + sch * 16) = (v2u){pa[SET_][u].x, pa[SET_][u].y}; *(LAS v2u*)(L + DR_NW + row * DR_S8 + sch * 16 + 8) = (v2u){pa[SET_][u].z, pa[SET_][u].w}; \
            *(LAS v2u*)(L + DR_QD + row * DR_S8 + sch * 16) = (v2u){pb[SET_][u].x, pb[SET_][u].y}; *(LAS v2u*)(L + DR_QD + row * DR_S8 + sch * 16 + 8) = (v2u){pb[SET_][u].z, pb[SET_][u].w}; \
            *(LAS v4u*)(L + DR_U + row * DR_ST + sch * 16) = pd[SET_][u]; } } while (0)
#define DR_COMMIT_B(SET_) do { _Pragma("unroll") for (int u = 0; u < 4; ++u) { const int row = srow + 16 * u; *(LAS v4u*)(L + DR_KD + row * DR_ST + sch * 16) = pc[SET_][u]; } \
        _Pragma("unroll") for (int u = 0; u < 2; ++u) { const int id = (tid & 255) + 256 * u; *(LAS v2u*)(L + DR_QK + (id >> 3) * DR_SQ + (id & 7) * 16) = (v2u){pe[SET_][u].x, pe[SET_][u].y}; *(LAS v2u*)(L + DR_QK + (id >> 3) * DR_SQ + (id & 7) * 16 + 8) = (v2u){pe[SET_][u].z, pe[SET_][u].w}; } } while (0)
    if (wave >= 4) {
        DR_ISSUE(0, n_lo); DR_COMMIT_A(0); DR_COMMIT_B(0); DR_ISSUE(1, n_lo + 1); if (n_lo + 2 < n_hi) DR_ISSUE(0, n_lo + 2);
        LDS_BARRIER();
        for (int n = n_lo; n < n_hi; n += 2) {
            LDS_BARRIER(); DR_COMMIT_A(1);
            LDS_BARRIER(); DR_COMMIT_B(1); if (n + 3 < n_hi) DR_ISSUE(1, n + 3);
            LDS_BARRIER(); if (n + 2 < n_hi) DR_COMMIT_A(0);
            LDS_BARRIER(); if (n + 2 < n_hi) { DR_COMMIT_B(0); if (n + 4 < n_hi) DR_ISSUE(0, n + 4); }
        }
    } else {
        __builtin_amdgcn_s_setprio(3);
        const int w = wave;
        f32x16 S[4];
        float* ssave = (float*)(F.ws + WS_LSUM) + (size_t)1024 * 1024 + ((size_t)(wg * 4 + w) * 64) * 64 + lane;
#pragma unroll
        for (int t = 0; t < 4; ++t)
#pragma unroll
            for (int e = 0; e < 16; ++e) S[t][e] = n_lo > 0 ? ssave[(t * 16 + e) * 64] : 0.f;
        const float gtl = GTg[lane], gth = GTg[64 + lane];
        LDS_BARRIER();
        for (int n = n_lo; n < n_hi; ++n) {
            const float gt = __int_as_float(__builtin_amdgcn_readlane(__float_as_int(n < 64 ? gtl : gth), n & 63));
#define DR_AFR(dst_, base_) do { const LAS unsigned char* p_ = (base_); const s16x4 l0_ = *(const LAS s16x4*)(p_), h0_ = *(const LAS s16x4*)(p_ + 16), l1_ = *(const LAS s16x4*)(p_ + 32 * DR_S8), h1_ = *(const LAS s16x4*)(p_ + 32 * DR_S8 + 16); \
                dst_[0] = __builtin_shufflevector(l0_, h0_, 0, 1, 2, 3, 4, 5, 6, 7); dst_[1] = __builtin_shufflevector(l1_, h1_, 0, 1, 2, 3, 4, 5, 6, 7); } while (0)
            const LAS unsigned char* wbase = L + DR_NW + r * DR_S8 + (4 * hh) * 2; const LAS unsigned char* qbase = L + DR_QD + r * DR_S8 + (4 * hh) * 2;
            bf16x8 fw[2][2], fq[2][2];
            DR_AFR(fw[0], wbase); DR_AFR(fq[0], qbase);
            f32x16 vn0, vn1;
            {   const LAS unsigned char* ub = L + DR_U + (4 * hh + q4) * DR_ST + (32 * w + 16 * cb + 4 * p4) * 2;
                s16x4 u0[4], u1[4];
#pragma unroll
                for (int g4 = 0; g4 < 4; ++g4) { u0[g4] = TR16(ub + (8 * g4) * DR_ST); u1[g4] = TR16(ub + (32 + 8 * g4) * DR_ST); }
#pragma unroll
                for (int g4 = 0; g4 < 4; ++g4)
#pragma unroll
                    for (int e = 0; e < 4; ++e) { vn0[4 * g4 + e] = bf2f((bf16)u0[g4][e]); vn1[4 * g4 + e] = bf2f((bf16)u1[g4][e]); } }
            f32x16 o0, o1;
#pragma unroll
            for (int e = 0; e < 16; ++e) { o0[e] = 0.f; o1[e] = 0.f; }
#pragma unroll
            for (int i = 0; i < 8; ++i) { const int t = i >> 1, s = i & 1;
                if (i + 1 < 8) { const int off = (32 * ((i + 1) >> 1) + 16 * ((i + 1) & 1)) * 2; DR_AFR(fw[(i + 1) & 1], wbase + off); DR_AFR(fq[(i + 1) & 1], qbase + off); }
                const bf16x8 sbv = pack_acc8(S[t], s);
                __builtin_amdgcn_sched_barrier(0);
                vn0 = MFMA32(fw[i & 1][0], sbv, vn0); vn1 = MFMA32(fw[i & 1][1], sbv, vn1);
                o0 = MFMA32(fq[i & 1][0], sbv, o0); o1 = MFMA32(fq[i & 1][1], sbv, o1);
                __builtin_amdgcn_sched_barrier(0);
            }
            LDS_BARRIER();
            bf16x8 qk00[2], qk10[2], qk11[2];
#pragma unroll
            for (int s = 0; s < 2; ++s) { const LAS unsigned char* ka = L + DR_QK + r * DR_SQ + (16 * s + 4 * hh) * 2;
                const s16x4 a00l = *(const LAS s16x4*)(ka), a00h = *(const LAS s16x4*)(ka + 16), a10l = *(const LAS s16x4*)(ka + 32 * DR_SQ), a10h = *(const LAS s16x4*)(ka + 32 * DR_SQ + 16), a11l = *(const LAS s16x4*)(ka + 32 * DR_SQ + 64), a11h = *(const LAS s16x4*)(ka + 32 * DR_SQ + 64 + 16);
                qk00[s] = __builtin_shufflevector(a00l, a00h, 0, 1, 2, 3, 4, 5, 6, 7); qk10[s] = __builtin_shufflevector(a10l, a10h, 0, 1, 2, 3, 4, 5, 6, 7); qk11[s] = __builtin_shufflevector(a11l, a11h, 0, 1, 2, 3, 4, 5, 6, 7); }
            const LAS unsigned char* kb = L + DR_KD + (4 * hh + q4) * DR_ST + (16 * cb + 4 * p4) * 2;
            bf16x8 fk[2][4];
#define DR_KFR(dst_, jt_, s_) do { _Pragma("unroll") for (int t_ = 0; t_ < 4; ++t_) { const s16x4 al_ = TR16(kb + (32 * (jt_) + 16 * (s_)) * DR_ST + 64 * t_), ah_ = TR16(kb + (32 * (jt_) + 16 * (s_) + 8) * DR_ST + 64 * t_); \
                dst_[t_] = __builtin_shufflevector(al_, ah_, 0, 1, 2, 3, 4, 5, 6, 7); } } while (0)
            DR_KFR(fk[0], 0, 0);
            bf16x8 vb[2][2];
#pragma unroll
            for (int s = 0; s < 2; ++s) { vb[0][s] = pack_acc8(vn0, s); vb[1][s] = pack_acc8(vn1, s); }
#pragma unroll
            for (int t = 0; t < 4; ++t)
#pragma unroll
                for (int e = 0; e < 16; ++e) S[t][e] *= gt;
            __builtin_amdgcn_sched_barrier(0);
#pragma unroll
            for (int s = 0; s < 2; ++s) { o0 = MFMA32(qk00[s], vb[0][s], o0); o1 = MFMA32(qk10[s], vb[0][s], o1); o1 = MFMA32(qk11[s], vb[1][s], o1); }
#pragma unroll
            for (int i = 0; i < 4; ++i) { const int jt = i >> 1, s = i & 1;
                if (i + 1 < 4) DR_KFR(fk[(i + 1) & 1], (i + 1) >> 1, (i + 1) & 1);
                __builtin_amdgcn_sched_barrier(0);
#pragma unroll
                for (int t = 0; t < 4; ++t) S[t] = MFMA32(fk[i & 1][t], vb[jt][s], S[t]);
                __builtin_amdgcn_sched_barrier(0);
            }
            {   bf16* op = F.MIX + (mrow0 + (size_t)n * 64) * DM + h * 128 + 32 * w + r;
#pragma unroll
                for (int e = 0; e < 16; ++e) { const int ir = (e & 3) + 8 * (e >> 2) + 4 * hh; op[(size_t)ir * DM] = (bf16)(pkbf(o0[e], 0.f) & 0xffffu); op[(size_t)(32 + ir) * DM] = (bf16)(pkbf(o1[e], 0.f) & 0xffffu); } }
#undef DR_AFR
#undef DR_KFR
            LDS_BARRIER();
        }
        if (n_hi < SEQ / 64) {
#pragma unroll
            for (int t = 0; t < 4; ++t)
#pragma unroll
                for (int e = 0; e < 16; ++e) ssave[(t * 16 + e) * 64] = S[t][e];
        }
        __builtin_amdgcn_s_setprio(0);
    }
#undef DR_ISSUE
#undef DR_COMMIT_A
#undef DR_COMMIT_B
}

constexpr int SWA_VSTRIDE = 288;
__device__ __forceinline__ void swa_mfma(Frame& F) {
    const int wave = F.wave;
    const bf16* PROJ = F.BIG;
    bf16* OB[3] = {F.PPB, F.PPB + (size_t)M_TOK * 1024, F.BIG + (size_t)M_TOK * NPROJ};
    float* LSE = (float*)(F.BIG + (size_t)M_TOK * NPROJ + (size_t)M_TOK * 1024);
    LAS unsigned char* vl = F.lds + RING_OFF;
    LAS unsigned char* kl = vl + 272 * SWA_VSTRIDE;
    v4u kreg[9], vreg[9]; bf16x8 qfn[4];
#define SW_LOAD(unit_, tid_) do { const int bh_ = (unit_) / 192, rem_ = (unit_) - bh_ * 192; const int br_ = rem_ >> 6, blk_ = rem_ & 63; const int b_ = bh_ >> 3, h_ = bh_ & 7; const int dsh_ = 2 * br_, d_ = 1 << dsh_; \
        const int nper_ = 64 >> dsh_; const int r_ = blk_ / nper_, n_ = blk_ - r_ * nper_; const size_t rowbase_ = (size_t)b_ * SEQ + r_; const int sub0_ = 128 * n_ - 144; \
        _Pragma("unroll") for (int u = 0; u < 9; ++u) { const int id = (tid_) + 512 * u; const int row = id >> 4, ch = id & 15; const int ks = sub0_ + row; kreg[u] = (v4u){0u, 0u, 0u, 0u}; vreg[u] = (v4u){0u, 0u, 0u, 0u}; \
            if (id < 272 * 16 && ks >= 0) { const bf16* rp = PROJ + (rowbase_ + (size_t)ks * d_) * NPROJ + h_ * 128 + ch * 8; kreg[u] = *(const v4u*)(rp + 1024); vreg[u] = *(const v4u*)(rp + 2048); } } \
        { const int lane_ = (tid_) & 63; const size_t mq_ = rowbase_ + (size_t)(128 * n_ + 16 * wave + (lane_ & 15)) * d_; const bf16* qp = PROJ + mq_ * NPROJ + h_ * 128 + 8 * (lane_ >> 4); \
          _Pragma("unroll") for (int s = 0; s < 4; ++s) qfn[s] = *(const bf16x8*)(qp + 32 * s); } } while (0)
    if (F.bx - 32 < 32 * 192) { int tp = F.tid; asm volatile("" : "+v"(tp)); SW_LOAD(F.bx - 32, tp); }
    for (int unit = F.bx - 32; unit < 32 * 192; unit += F.G - 32) {
        int tid = F.tid; asm volatile("" : "+v"(tid));
        const int lane = tid & 63; const int li = lane & 15, g = lane >> 4;
        const int bh = unit / 192, rem = unit - bh * 192; const int br = rem >> 6, blk = rem & 63;
        const int b = bh >> 3, h = bh & 7; const int dsh = 2 * br, d = 1 << dsh; const int nper = 64 >> dsh; const int r = blk / nper, n = blk - r * nper;
        const size_t rowbase = (size_t)b * SEQ + r;
        const int sub0 = 128 * n - 144;
        LDS_BARRIER();
        {
#pragma unroll
            for (int u = 0; u < 9; ++u) { const int id = tid + 512 * u; const int row = id >> 4, ch = id & 15;
                if (id < 272 * 16) { *(LAS v4u*)(kl + row * 272 + ch * 16) = kreg[u]; *(LAS v4u*)(vl + row * SWA_VSTRIDE + ch * 16) = vreg[u]; } }
        }
        bf16x8 qf[4];
#pragma unroll
        for (int s = 0; s < 4; ++s) qf[s] = qfn[s];
        LDS_BARRIER();
        { const int nu = unit + F.G - 32; if (nu < 32 * 192) SW_LOAD(nu, tid); }
        const int q0w = 128 * n + 16 * wave;
        const size_t mq = rowbase + (size_t)(q0w + li) * d;
        f32x4 sacc[10];
        {   const LAS unsigned char* kbase = kl + (16 * wave + li) * 272 + 16 * g;
#pragma unroll
            for (int kt = 0; kt < 10; ++kt) { f32x4 acc = (f32x4){0.f, 0.f, 0.f, 0.f};
#pragma unroll
                for (int s = 0; s < 4; ++s) { const bf16x8 kf = *(const LAS bf16x8*)(kbase + (16 * kt) * 272 + 64 * s); acc = __builtin_amdgcn_mfma_f32_16x16x32_bf16(kf, qf[s], acc, 0, 0, 0); }
                sacc[kt] = acc; }
        }
        const float slope_d = exp2f(-(float)(h + 1)) * (float)d;
        float mx = -INFINITY;
#pragma unroll
        for (int kt = 0; kt < 10; ++kt)
#pragma unroll
            for (int e = 0; e < 4; ++e) { const int rel = 144 + li - 16 * kt - 4 * g - e; const bool valid = (rel >= 0) && (rel <= 128) && (q0w + li - rel >= 0);
                const float sv = valid ? sacc[kt][e] * SC128 - slope_d * (float)rel : -INFINITY; sacc[kt][e] = sv; mx = fmaxf(mx, sv); }
        mx = fmaxf(mx, __shfl_xor(mx, 16)); mx = fmaxf(mx, __shfl_xor(mx, 32));
        float l = 0.f;
#pragma unroll
        for (int kt = 0; kt < 10; ++kt)
#pragma unroll
            for (int e = 0; e < 4; ++e) { const float p = __expf(sacc[kt][e] - mx); sacc[kt][e] = p; l += p; }
        l += __shfl_xor(l, 16); l += __shfl_xor(l, 32);
        f32x4 oacc[8];
#pragma unroll
        for (int dt = 0; dt < 8; ++dt) oacc[dt] = (f32x4){0.f, 0.f, 0.f, 0.f};
        const LAS unsigned char* vbase = vl + (16 * wave + 4 * g + (li >> 2)) * SWA_VSTRIDE + (li & 3) * 8;
#pragma unroll
        for (int sp = 0; sp < 5; ++sp) {
            v4u pw; pw.x = pk2(sacc[2 * sp][0], sacc[2 * sp][1]); pw.y = pk2(sacc[2 * sp][2], sacc[2 * sp][3]); pw.z = pk2(sacc[2 * sp + 1][0], sacc[2 * sp + 1][1]); pw.w = pk2(sacc[2 * sp + 1][2], sacc[2 * sp + 1][3]);
            const bf16x8 pf = __builtin_bit_cast(bf16x8, pw);
#pragma unroll
            for (int dt = 0; dt < 8; ++dt) {
                const s16x4 lo = __builtin_amdgcn_ds_read_tr16_b64_v4i16((LAS s16x4*)(vbase + (32 * sp) * SWA_VSTRIDE + dt * 32));
                const s16x4 hi = __builtin_amdgcn_ds_read_tr16_b64_v4i16((LAS s16x4*)(vbase + (32 * sp + 16) * SWA_VSTRIDE + dt * 32));
                const bf16x8 af = __builtin_shufflevector(lo, hi, 0, 1, 2, 3, 4, 5, 6, 7);
                oacc[dt] = __builtin_amdgcn_mfma_f32_16x16x32_bf16(af, pf, oacc[dt], 0, 0, 0);
            }
        }
        const float il = 1.0f / l;
        bf16* op = OB[br] + mq * 1024 + h * 128 + 4 * g;
#pragma unroll
        for (int dt = 0; dt < 8; ++dt) { v2u w; w.x = pk2(oacc[dt][0] * il, oacc[dt][1] * il); w.y = pk2(oacc[dt][2] * il, oacc[dt][3] * il); *(v2u*)(op + 16 * dt) = w; }
        if (g == 0) LSE[((size_t)br * M_TOK + mq) * 8 + h] = mx + __logf(l);
    }
}
#undef SW_LOAD

__device__ __forceinline__ void swa_merge(Frame& F) {
    const int gw = F.bx * NWAVES + F.wave, NGW = F.G * NWAVES, lane = F.lane; const int h = lane >> 3, c0 = (lane & 7) * 16;
    const bf16* OB0 = F.PPB; const bf16* OB1 = F.PPB + (size_t)M_TOK * 1024; const bf16* OB2 = F.BIG + (size_t)M_TOK * NPROJ;
    const float* LSE = (const float*)(F.BIG + (size_t)M_TOK * NPROJ + (size_t)M_TOK * 1024);
    for (int m = gw; m < M_TOK; m += NGW) {
        const size_t o = (size_t)m * 1024 + h * 128 + c0;
        const v4u a0 = *(const v4u*)(OB0 + o), a1 = *(const v4u*)(OB0 + o + 8), b0 = *(const v4u*)(OB1 + o), b1 = *(const v4u*)(OB1 + o + 8), c0v = *(const v4u*)(OB2 + o), c1v = *(const v4u*)(OB2 + o + 8);
        const float l0 = LSE[((size_t)0 * M_TOK + m) * 8 + h], l1 = LSE[((size_t)1 * M_TOK + m) * 8 + h], l2 = LSE[((size_t)2 * M_TOK + m) * 8 + h]; __builtin_amdgcn_sched_barrier(0);
        const float mx = fmaxf(l0, fmaxf(l1, l2)); float e0 = __expf(l0 - mx), e1 = __expf(l1 - mx), e2 = __expf(l2 - mx); const float inv = 1.0f / (e0 + e1 + e2); e0 *= inv; e1 *= inv; e2 *= inv;
        float x[16], y[16], z[16]; unpack8(a0, x); unpack8(a1, x + 8); unpack8(b0, y); unpack8(b1, y + 8); unpack8(c0v, z); unpack8(c1v, z + 8);
#pragma unroll
        for (int i = 0; i < 16; ++i) x[i] = e0 * x[i] + e1 * y[i] + e2 * z[i];
        v4u* dst = (v4u*)(F.MIX + (size_t)m * DM + h * 128 + c0); dst[0] = pack8(x); dst[1] = pack8(x + 8);
    }
}

__device__ __forceinline__ void ret_final(Frame& F) {
    const int gw = F.bx * NWAVES + F.wave, NGW = F.G * NWAVES, lane = F.lane; const int h = lane >> 4, c0 = (lane & 15) * 16;
    const float* ORET = (const float*)F.HN; const bf16* PROJ = F.BIG;
    for (int m = gw; m < M_TOK; m += NGW) {
        const f32x4* xp = (const f32x4*)(ORET + (size_t)m * 1024 + h * 256 + c0); const v4u* gp = (const v4u*)(PROJ + (size_t)m * NPROJ + 5120 + h * 256 + c0);
        const f32x4 x0 = xp[0], x1 = xp[1], x2 = xp[2], x3 = xp[3]; const v4u g0 = gp[0], g1 = gp[1]; __builtin_amdgcn_sched_barrier(0);
        float x[16] = {x0.x, x0.y, x0.z, x0.w, x1.x, x1.y, x1.z, x1.w, x2.x, x2.y, x2.z, x2.w, x3.x, x3.y, x3.z, x3.w}; float g[16]; unpack8(g0, g); unpack8(g1, g + 8);
        float s = 0.f;
#pragma unroll
        for (int i = 0; i < 16; ++i) s += x[i];
        const float mu = row16_sum(s) * (1.0f / 256.0f); float q = 0.f;
#pragma unroll
        for (int i = 0; i < 16; ++i) { x[i] -= mu; q += x[i] * x[i]; }
        const float r = 1.0f / sqrtf(row16_sum(q) * (1.0f / 256.0f) + GN_EPS);
#pragma unroll
        for (int i = 0; i < 16; ++i) x[i] = x[i] * r * siluf_(g[i]);
        v4u* dst = (v4u*)(F.MIX + (size_t)m * DM + 1024 + h * 256 + c0); dst[0] = pack8(x); dst[1] = pack8(x + 8);
    }
}
__device__ __forceinline__ void final_norm(Frame& F) {
    const int gw = F.bx * NWAVES + F.wave, NGW = F.G * NWAVES, lane = F.lane; const float* lnw = F.in[9];
    float* tmp = (float*)F.HN;
    f32x4 lw[8];
#pragma unroll
    for (int j = 0; j < 8; ++j) lw[j] = ((const f32x4*)lnw)[lane + 64 * j];
    for (int rp = gw; rp < M_TOK / 2; rp += NGW) {
        v2u w_[2][8];
#pragma unroll
        for (int r = 0; r < 2; ++r)
#pragma unroll
            for (int j = 0; j < 8; ++j) w_[r][j] = ((const v2u*)(F.H16 + ((size_t)2 * rp + r) * DM))[lane + 64 * j];
        __builtin_amdgcn_sched_barrier(0);
#pragma unroll
        for (int r = 0; r < 2; ++r) { const int row = 2 * rp + r; f32x4 v[8]; float ss = 0.f;
#pragma unroll
            for (int j = 0; j < 8; ++j) { v[j] = (f32x4){bflo(w_[r][j].x), bfhi(w_[r][j].x), bflo(w_[r][j].y), bfhi(w_[r][j].y)}; ss += (v[j].x * v[j].x + v[j].y * v[j].y) + (v[j].z * v[j].z + v[j].w * v[j].w); }
            ss = wave_sum(ss); const float rstd = 1.0f / sqrtf(ss * (1.0f / DM) + RMS_EPS);
            f32x4* o = (f32x4*)(F.out + (size_t)row * DM) + lane; (void)tmp;
#pragma unroll
            for (int j = 0; j < 8; ++j) o[64 * j] = v[j] * rstd * lw[j]; }
    }
}
__device__ __forceinline__ void final_copy(Frame& F) {
    const f32x4* src = (const f32x4*)F.HN; f32x4* dst = (f32x4*)(F.out + (size_t)(M_TOK / 2) * DM);
    const size_t n4 = (size_t)(M_TOK / 2) * DM / 4, stride = (size_t)F.G * 512;
    for (size_t i = (size_t)F.bx * 512 + F.tid; i < n4; i += 8 * stride) { f32x4 t_[8];
#pragma unroll
        for (int u = 0; u < 8; ++u) t_[u] = src[i + u * stride];
        __builtin_amdgcn_sched_barrier(0);
#pragma unroll
        for (int u = 0; u < 8; ++u) dst[i + u * stride] = t_[u]; }
}

#ifndef REP_T1
#define REP_T1 1
#endif
#ifndef REP_G1
#define REP_G1 1
#endif
#ifndef REP_EM1
#define REP_EM1 1
#endif
#ifndef REP_EM2
#define REP_EM2 1
#endif
#ifndef REP_OM1
#define REP_OM1 1
#endif
#ifndef REP_T2
#define REP_T2 1
#endif
#ifndef REP_G3
#define REP_G3 1
#endif
#ifndef REP_PP
#define REP_PP 1
#endif
#define REPEAT(n_) _Pragma("unroll 1") for (int rep_ = 0; rep_ < (n_); ++rep_)
#define REFRESH_F() do { int t_ = threadIdx.x; asm volatile("" : "+v"(t_)); F.tid = t_; F.lane = t_ & 63; F.wave = __builtin_amdgcn_readfirstlane(t_ >> 6); int b_ = blockIdx.x; asm volatile("" : "+s"(b_)); F.bx = b_; } while (0)
constexpr int PH_PER_LAYER = 11, NPH = DEPTH * PH_PER_LAYER + 2;
__global__ void __launch_bounds__(NWAVES * 64, 2) trunk_fwd(Args args) {
    extern __shared__ __attribute__((aligned(16))) unsigned char lds_raw[];
    Frame F;
    F.lds = (LAS unsigned char*)lds_raw;
    F.tid = threadIdx.x; F.lane = F.tid & 63; F.wave = __builtin_amdgcn_readfirstlane(F.tid >> 6);
    F.G = gridDim.x; F.bx = blockIdx.x;
    F.in = args.in; F.out = args.out;
    unsigned char* ws = args.ws; F.ws = ws; F.H16 = (bf16*)(ws + WS_PP2);
    F.PP2 = (bf16*)((unsigned char*)args.out + (size_t)M_TOK * DM * 2);
    F.WIN = (bf16*)(ws + WS_WIN); F.WOUT = (bf16*)(ws + WS_WOUT); F.WUP = (bf16*)(ws + WS_WUP); F.WDOWN = (bf16*)(ws + WS_WDOWN); F.WGATE = (bf16*)(ws + WS_WGATE); F.WPP = (bf16*)(ws + WS_WPP);
    F.PB = (bf16*)(ws + WS_PB); F.GB = (float*)(ws + WS_GB); F.HN = (bf16*)(ws + WS_HN); F.MIX = (bf16*)(ws + WS_MIX); F.BIG = (bf16*)(ws + WS_BIG); F.PPB = (bf16*)(ws + WS_PPB);
    for (int u = F.tid; u < (LDS_BYTES - LDSCTL_OFF) / 4; u += NWAVES * 64) ((LAS unsigned*)(F.lds + LDSCTL_OFF))[u] = 0u;
    __syncthreads();
    const int lo = args.ph_lo, hi = args.ph_hi;
    XcdBarrier bar; bar.bar = (unsigned*)(ws + WS_CTL) + CW_BAR; bar.x = 0; bar.st = nullptr;
    if (hi - lo > 1) bar = xcd_barrier_post((unsigned*)(ws + WS_CTL) + CW_BAR, (volatile LAS unsigned*)(F.lds + MISC_OFF) + 8);
#define IN(k) (lo <= (k) && (k) < hi)
#ifdef REP_BAR
#define SEAM(k) do { if (IN(k) && IN((k) + 1)) { xcd_barrier(bar); xcd_barrier(bar); } } while (0)
#else
#define SEAM(k) do { if (IN(k) && IN((k) + 1)) xcd_barrier(bar); } while (0)
#endif
    LAS unsigned char* ring = F.lds + RING_OFF;

    for (int layer = 0; layer < LAYER_HI; ++layer) {
        const int P = layer * PH_PER_LAYER; const int j = layer >> 1; const bool even = (layer & 1) == 0;
        { int t_ = threadIdx.x; asm volatile("" : "+v"(t_)); F.tid = t_; F.lane = t_ & 63; F.wave = __builtin_amdgcn_readfirstlane(t_ >> 6); int b_ = blockIdx.x; asm volatile("" : "+s"(b_)); F.bx = b_; }
        if (IN(P + 0)) { REPEAT(REP_T1) { phase_t1(F, layer); __syncthreads(); } } SEAM(P + 0);
        if (IN(P + 1)) REPEAT(REP_G1) { pg8::Gemm g{F.HN, even ? F.WIN : (bf16*)(F.ws + WS_WIN2), M_TOK, NPROJ, DM}; pg8::StaticOrder S; S.init(M_TOK, NPROJ, F.G, F.bx);
            pg8::EpiB16<0> E{F.BIG, NPROJ, nullptr}; pg8::gemm_phase<pg8::EpiB16<0>, pg8::StaticOrder, true, true>(ring, g, S, E); } SEAM(P + 1);
        if (IN(P + 2)) {
            if (even) {
 REPEAT(REP_EM1) { REFRESH_F(); dn_chunk_prep(F, j, 0, DN_C1, 0); __syncthreads(); lru_gates_mfma(F, j); __syncthreads(); }
 }
            else {
 REPEAT(REP_OM1) { REFRESH_F(); if (F.bx < 32) ret_chunk(F, F.bx); else { swa_mfma(F); __syncthreads(); { pg8::Gemm g{F.PB, F.WPP, M_TOK, DM, PLE}; pg8::StaticOrder S; S.init(M_TOK, DM, F.G - 32, F.bx - 32); pg8::EpiB16<0> E{F.PP2, DM, nullptr}; pg8::gemm_phase<pg8::EpiB16<0>, pg8::StaticOrder, true, true>(ring, g, S, E); } __syncthreads(); convert_w_rest(F, layer, 32); if (layer + 1 < DEPTH) convert_w_in(F, layer + 1, 32); } __syncthreads(); }
 }
        } SEAM(P + 2);
        if (IN(P + 3)) {
            if (even) {
 { int lo = 0, mid = DN_C1, hi = DN_C2;
   for (int st = 0; st < 2; ++st) { REFRESH_F(); asm volatile("" : "+s"(lo), "+s"(mid), "+s"(hi));
       if (F.bx < 32) dn_chunk_recur(F, F.bx, lo, mid); else dn_chunk_prep(F, j, mid, hi, 32);
       xcd_barrier(bar); lo = mid; mid = hi; hi = 128; } }
 REPEAT(REP_EM2) { REFRESH_F(); if (F.bx < 32) dn_chunk_recur(F, F.bx, DN_C2, 128); else { if (F.bx >= 128 && F.bx < 136) lru_carry(F, (F.bx - 128) * 512 + F.tid); __syncthreads(); { pg8::Gemm g{F.PB, F.WPP, M_TOK, DM, PLE}; pg8::StaticOrder S; S.init(M_TOK, DM, F.G - 32, F.bx - 32); pg8::EpiB16<0> E{F.PP2, DM, nullptr}; pg8::gemm_phase<pg8::EpiB16<0>, pg8::StaticOrder, true, true>(ring, g, S, E); } __syncthreads(); convert_w_rest(F, layer, 32); if (layer + 1 < DEPTH) convert_w_in(F, layer + 1, 32); } __syncthreads(); }
 }
        } if (even) SEAM(P + 3);
        if (IN(P + 4)) { if (even) { dn_final(F, j); lru_final(F); } else { ret_final(F); swa_merge(F); } } SEAM(P + 4);
        if (IN(P + 5)) {
            { pg8::Gemm g{F.MIX, F.WOUT, M_TOK, DM, DM}; pg8::StaticOrder S; S.init(M_TOK, DM, F.G, F.bx);
              pg8::EpiResid E{layer == 0 ? F.in[0] : nullptr, F.H16, F.H16, DM, (float*)(F.ws + WS_SS), nullptr}; pg8::gemm_phase<pg8::EpiResid, pg8::StaticOrder, true, true>(ring, g, S, E); }
#ifdef REP_G2
            { pg8::Gemm g{F.MIX, F.WOUT, M_TOK, DM, DM}; pg8::StaticOrder S; S.init(M_TOK, DM, F.G, F.bx); pg8::EpiResid E{F.in[0], nullptr, F.BIG, DM, nullptr, nullptr}; pg8::gemm_phase<pg8::EpiResid, pg8::StaticOrder, true, true>(ring, g, S, E); }
#endif
        } SEAM(P + 5);
        if (IN(P + 7)) REPEAT(REP_G3) { pg8::Gemm g{F.H16, F.WUP, M_TOK, DFF, DM}; pg8::StaticOrder S; S.init(M_TOK, DFF, F.G, F.bx);
            pg8::EpiB16<1> E{F.BIG, DFF, nullptr}; pg8::gemm_phase<pg8::EpiB16<1>, pg8::StaticOrder, true, true>(ring, g, S, E); } SEAM(P + 7);
        if (IN(P + 8)) { pg8::Gemm g{F.BIG, F.WDOWN, M_TOK, DM, DFF}; pg8::StaticOrder S; S.init(M_TOK, DM, F.G, F.bx);
            pg8::EpiResid E{nullptr, F.H16, F.HN, DM, (float*)(F.ws + WS_SS) + (size_t)M_TOK * 32, (const float*)(F.ws + WS_SS)}; pg8::gemm_phase<pg8::EpiResid, pg8::StaticOrder, true, true>(ring, g, S, E);
#ifdef REP_G4
            { pg8::EpiResid E2{F.in[0], nullptr, F.MIX, DM, nullptr, nullptr}; pg8::gemm_phase<pg8::EpiResid, pg8::StaticOrder, true, true>(ring, g, S, E2); }
#endif
            } SEAM(P + 8);
        if (IN(P + 10)) { pg8::Gemm g{F.HN, F.WGATE, M_TOK, DM, DM}; pg8::StaticOrder S; S.init(M_TOK, DM, F.G, F.bx);
            pg8::EpiGate E{F.HN, F.H16, F.PP2, DM, (const float*)(F.ws + WS_SS) + (size_t)M_TOK * 32}; pg8::gemm_phase<pg8::EpiGate, pg8::StaticOrder, true, true>(ring, g, S, E);
#ifdef REP_G5
            { pg8::EpiGate E2{F.HN, F.MIX, F.PP2, DM, nullptr}; pg8::gemm_phase<pg8::EpiGate, pg8::StaticOrder, true, true>(ring, g, S, E2); }
#endif
            } SEAM(P + 10);
    }
    if (IN(NPH - 2)) final_norm(F);
    SEAM(NPH - 2);
#undef IN
#undef SEAM
}

extern "C" void kernel_launch(void* const* d_in, const int* in_sizes, int n_in, void* d_out, int out_size, void* d_ws, size_t ws_size, hipStream_t stream) {
    static int grid = 0;
    if (grid == 0) {
        if (n_in != 25 || in_sizes[0] != M_TOK * DM || out_size != M_TOK * DM || ws_size < WS_END) {
            fprintf(stderr, "kernel_launch: unexpected shapes (n_in %d, in0 %d, out %d, ws %zu, need %zu); nothing launched\n", n_in, n_in > 0 ? in_sizes[0] : -1, out_size, ws_size, (size_t)WS_END); grid = -1; return; }
        int dev = 0, cus = 0;
        if (hipGetDevice(&dev) != hipSuccess || hipDeviceGetAttribute(&cus, hipDeviceAttributeMultiprocessorCount, dev) != hipSuccess) { grid = -1; return; }
        if (hipFuncSetAttribute((const void*)trunk_fwd, hipFuncAttributeMaxDynamicSharedMemorySize, LDS_BYTES) != hipSuccess) { fprintf(stderr, "kernel_launch: hipFuncSetAttribute failed\n"); grid = -1; return; }
        int per_cu = 0;
        if (hipOccupancyMaxActiveBlocksPerMultiprocessor(&per_cu, (const void*)trunk_fwd, NWAVES * 64, LDS_BYTES) != hipSuccess || per_cu < 1) { fprintf(stderr, "kernel_launch: occupancy query says %d blocks per CU\n", per_cu); }
        (void)hipGetLastError();
        grid = cus;
    }
    if (grid < 0) return;
    if (hipMemsetAsync((char*)d_ws + WS_CTL, 0, 65536, stream) != hipSuccess) return;
    Args a{};
    for (int i = 0; i < 25; ++i) a.in[i] = (const float*)d_in[i];
    a.out = (float*)d_out; a.ws = (unsigned char*)d_ws;
#if ONE_LAUNCH
    a.ph_lo = 0; a.ph_hi = NPH;
    hipLaunchKernelGGL(trunk_fwd, dim3(grid), dim3(NWAVES * 64), LDS_BYTES, stream, a);
#else
    for (int ph = 0; ph < NPH; ++ph) {
        const int pl = ph % PH_PER_LAYER, layer = ph / PH_PER_LAYER;
        if (ph < NPH - 2 && pl == 3 && (layer & 1)) continue;
        a.ph_lo = ph; a.ph_hi = ph + 1;
        hipLaunchKernelGGL(trunk_fwd, dim3(grid), dim3(NWAVES * 64), LDS_BYTES, stream, a);
    }
#endif
}
```

```cpp
#include <hip/hip_runtime.h>
#include <cstdio>
#include <cstdint>
#include <cmath>

#ifndef ONE_LAUNCH
#define ONE_LAUNCH 1
#endif

namespace pg8 {
#define PG8_LAS __attribute__((address_space(3)))
typedef unsigned short bf16_t;
typedef short bf16x8 __attribute__((ext_vector_type(8)));
typedef float f32x4 __attribute__((ext_vector_type(4)));
typedef unsigned u32x4 __attribute__((ext_vector_type(4)));
constexpr int BM = 256, BK = 64, HALF = 128, HTB = HALF * BK * 2  , STAGE_BYTES = 8 * HTB, NXCD = 8, WGM = 8;

__host__ __device__ __forceinline__ int lds_byte(int r, int c) { const int st = (r >> 4) * 2 + (c >> 5), rr = r & 15, cc = c & 31, ob = rr * 64 + cc * 2; return st * 1024 + (ob ^ (((ob >> 9) & 1) << 5)); }
__host__ __device__ __forceinline__ void stage_rc(int b, int& R, int& C) { const int st = b / 1024, sb = b % 1024, swz = sb ^ (((sb >> 9) & 1) << 5); R = (st >> 1) * 16 + swz / 64; C = (st & 1) * 32 + (swz % 64) / 2; }
__host__ __device__ __forceinline__ int perm32(int rho) { const int n = rho >> 4, i = rho & 15; return 8 * (i >> 2) + 4 * n + (i & 3); }

struct Unit { int pm, pn; };
struct Gemm { const bf16_t* A; const bf16_t* Bt; int M, N, K; };

struct StaticOrder {
    int nM, nN, nwg, G, c;
    __host__ __device__ void init(int M, int N, int G_, int c_) { nM = M / BM; nN = N / BM; nwg = nM * nN; G = G_; c = c_; }
    __host__ __device__ bool next(int i, Unit& u) const {
        const long L = (long)i * G + c; if (L >= nwg) return false;
        int wgid = (int)L; { const int q = nwg / NXCD, r = nwg % NXCD, xcd = wgid % NXCD, off = wgid / NXCD; wgid = (xcd < r ? xcd * (q + 1) : r * (q + 1) + (xcd - r) * q) + off; }
        const int nig = WGM * nN, gid = wgid / nig, fm = gid * WGM, gsz = (nM - fm) < WGM ? (nM - fm) : WGM;
        u.pm = fm + ((wgid % nig) % gsz); u.pn = (wgid % nig) / gsz; return true;
    }
    __device__ __forceinline__ void a_ready(const Unit&) const {}
    __device__ __forceinline__ void done(const Unit&) const {}
};

__device__ __forceinline__ unsigned cvt_pk_bf16(float lo, float hi) { unsigned r; asm volatile("v_cvt_pk_bf16_f32 %0, %1, %2" : "=v"(r) : "v"(lo), "v"(hi)); return r; }

__device__ __forceinline__ float row_rstd32(const float* ssp, int row, int fq) {
    const f32x4 a = *(const f32x4*)(ssp + (size_t)row * 32 + fq * 8), b = *(const f32x4*)(ssp + (size_t)row * 32 + fq * 8 + 4);
    float s = ((a[0] + a[1]) + (a[2] + a[3])) + ((b[0] + b[1]) + (b[2] + b[3]));
    s += __shfl_xor(s, 16); s += __shfl_xor(s, 32);
    return 1.0f / sqrtf(s * (1.0f / 2048.0f) + 1e-6f);
}
__device__ __forceinline__ void rows_rstd32(const float* ssp, int row0, int fq, float (&rs)[2][4]) {
    f32x4 pa[2][4][2];
#pragma unroll
    for (int ai = 0; ai < 2; ++ai)
#pragma unroll
        for (int m = 0; m < 4; ++m) { const float* p = ssp + (size_t)(row0 + ai * HALF + m * 16) * 32 + fq * 8; pa[ai][m][0] = *(const f32x4*)p; pa[ai][m][1] = *(const f32x4*)(p + 4); }
    __builtin_amdgcn_sched_barrier(0);
#pragma unroll
    for (int ai = 0; ai < 2; ++ai)
#pragma unroll
        for (int m = 0; m < 4; ++m) { const f32x4 a = pa[ai][m][0], b = pa[ai][m][1]; float s = ((a[0] + a[1]) + (a[2] + a[3])) + ((b[0] + b[1]) + (b[2] + b[3]));
            s += __shfl_xor(s, 16); s += __shfl_xor(s, 32); rs[ai][m] = 1.0f / sqrtf(s * (1.0f / 2048.0f) + 1e-6f); }
}
template <int ACT> struct EpiB16 {
    static constexpr bool PERM = true, AFTER_DRAIN = false; static constexpr int NVM = 16;
    bf16_t* O; int ldc; const float* ss;
    __device__ __forceinline__ void operator()(const f32x4 (&acc)[2][2][4][2], const Unit& u, int wr, int wc, int fr, int fq) const {
        const int row0 = u.pm * BM + wr * 64 + fr; const int col0 = u.pn * BM + wc * 32 + 8 * fq;
        float rs[2][4];
        if (ss) rows_rstd32(ss, row0, fq, rs);
        else {
#pragma unroll
            for (int ai = 0; ai < 2; ++ai)
#pragma unroll
                for (int m = 0; m < 4; ++m) rs[ai][m] = 1.0f; }
#pragma unroll
        for (int ai = 0; ai < 2; ++ai)
#pragma unroll
            for (int m = 0; m < 4; ++m) { bf16_t* rowp = O + (size_t)(row0 + ai * HALF + m * 16) * ldc + col0;
#pragma unroll
                for (int bj = 0; bj < 2; ++bj) { f32x4 v0 = acc[ai][bj][m][0] * rs[ai][m], v1 = acc[ai][bj][m][1] * rs[ai][m];
                    if (ACT == 1) {
#pragma unroll
                        for (int j = 0; j < 4; ++j) { const float a = fmaxf(v0[j], 0.f), b = fmaxf(v1[j], 0.f); v0[j] = a * a; v1[j] = b * b; } }
                    u32x4 w; w.x = cvt_pk_bf16(v0[0], v0[1]); w.y = cvt_pk_bf16(v0[2], v0[3]); w.z = cvt_pk_bf16(v1[0], v1[1]); w.w = cvt_pk_bf16(v1[2], v1[3]);
                    __builtin_nontemporal_store(w, (u32x4*)(rowp + bj * HALF)); } }
    }
};
__device__ __forceinline__ void unpack_bf8(const u32x4 w, f32x4& a, f32x4& b) {
    a = (f32x4){__uint_as_float(w.x << 16), __uint_as_float(w.x & 0xffff0000u), __uint_as_float(w.y << 16), __uint_as_float(w.y & 0xffff0000u)};
    b = (f32x4){__uint_as_float(w.z << 16), __uint_as_float(w.z & 0xffff0000u), __uint_as_float(w.w << 16), __uint_as_float(w.w & 0xffff0000u)};
}
__device__ __forceinline__ u32x4 pack_bf8(const f32x4 a, const f32x4 b) { u32x4 w; w.x = cvt_pk_bf16(a[0], a[1]); w.y = cvt_pk_bf16(a[2], a[3]); w.z = cvt_pk_bf16(b[0], b[1]); w.w = cvt_pk_bf16(b[2], b[3]); return w; }
__device__ __forceinline__ float sumsq4(const f32x4 v) { return (v[0] * v[0] + v[1] * v[1]) + (v[2] * v[2] + v[3] * v[3]); }
struct EpiResid {
    static constexpr bool PERM = true, AFTER_DRAIN = false; static constexpr int NVM = 32;
    const float* basef; const bf16_t* baseh; bf16_t* h16; int ldc; float* ss;
    const float* ssin;
    __device__ __forceinline__ void fin(const f32x4 (&acc)[2][2][4][2], const Unit& u, int q, int row0, int col0, int wc, int fq, f32x4 b0, f32x4 b1, f32x4 c0, f32x4 c1, float sc) const {
        const int ai = q >> 2, m = q & 3; const int row = row0 + ai * HALF + m * 16; const size_t off = (size_t)row * ldc + col0;
        const f32x4 v0 = b0 + acc[ai][0][m][0] * sc, v1 = b1 + acc[ai][0][m][1] * sc, v2 = c0 + acc[ai][1][m][0] * sc, v3 = c1 + acc[ai][1][m][1] * sc;
        *(u32x4*)(h16 + off) = pack_bf8(v0, v1); *(u32x4*)(h16 + off + HALF) = pack_bf8(v2, v3);
        if (ss) { float sq = (sumsq4(v0) + sumsq4(v1)) + (sumsq4(v2) + sumsq4(v3)); sq += __shfl_xor(sq, 16); sq += __shfl_xor(sq, 32);
            if (fq == 0) ss[(size_t)row * 32 + u.pn * 4 + wc] = sq; }
    }
    __device__ __forceinline__ void operator()(const f32x4 (&acc)[2][2][4][2], const Unit& u, int wr, int wc, int fr, int fq) const {
        const int row0 = u.pm * BM + wr * 64 + fr, col0 = u.pn * BM + wc * 32 + 8 * fq;
#define ER_OFF(q_) ((size_t)(row0 + ((q_) >> 2) * HALF + ((q_) & 3) * 16) * ldc + col0)
        if (basef) {
            f32x4 b[2][4];
#define ERF_LOAD(q_) do { const float* p_ = basef + ER_OFF(q_); b[(q_) & 1][0] = *(const f32x4*)p_; b[(q_) & 1][1] = *(const f32x4*)(p_ + 4); b[(q_) & 1][2] = *(const f32x4*)(p_ + HALF); b[(q_) & 1][3] = *(const f32x4*)(p_ + HALF + 4); } while (0)
            ERF_LOAD(0); ERF_LOAD(1);
            __builtin_amdgcn_sched_barrier(0);
#pragma unroll
            for (int q = 0; q < 8; ++q) {
                fin(acc, u, q, row0, col0, wc, fq, b[q & 1][0], b[q & 1][1], b[q & 1][2], b[q & 1][3], 1.0f);
                if (q + 2 < 8) ERF_LOAD(q + 2);
                asm volatile("" ::: "memory");
            }
#undef ERF_LOAD
        } else if (ssin) {
            u32x4 b[8][2]; f32x4 pa[2][4][2]; float rs2[2][4];
#define ER_BLOAD(q_) do { const bf16_t* p_ = baseh + ER_OFF(q_); b[q_][0] = *(const u32x4*)p_; b[q_][1] = *(const u32x4*)(p_ + HALF); } while (0)
#define ER_RS_LOAD(ai_) do { _Pragma("unroll") for (int m = 0; m < 4; ++m) { const float* p_ = ssin + (size_t)(row0 + (ai_) * HALF + m * 16) * 32 + fq * 8; pa[ai_][m][0] = *(const f32x4*)p_; pa[ai_][m][1] = *(const f32x4*)(p_ + 4); } } while (0)
#define ER_RS_REDUCE(ai_) do { _Pragma("unroll") for (int m = 0; m < 4; ++m) { const f32x4 a_ = pa[ai_][m][0], b_ = pa[ai_][m][1]; float s_ = ((a_[0] + a_[1]) + (a_[2] + a_[3])) + ((b_[0] + b_[1]) + (b_[2] + b_[3])); \
                s_ += __shfl_xor(s_, 16); s_ += __shfl_xor(s_, 32); rs2[ai_][m] = 1.0f / (s_ * (1.0f / 2048.0f) + 1e-6f); } } while (0)
#define ER_PROC(q_) do { f32x4 b0, b1, c0, c1; unpack_bf8(b[q_][0], b0, b1); unpack_bf8(b[q_][1], c0, c1); fin(acc, u, q_, row0, col0, wc, fq, b0, b1, c0, c1, rs2[(q_) >> 2][(q_) & 3]); asm volatile("" ::: "memory"); } while (0)
            ER_RS_LOAD(0); ER_BLOAD(0); ER_BLOAD(1); ER_BLOAD(2);
            __builtin_amdgcn_sched_barrier(0);
            ER_RS_REDUCE(0);
            ER_PROC(0); ER_RS_LOAD(1); ER_BLOAD(3); asm volatile("" ::: "memory");
            ER_PROC(1); ER_BLOAD(4); ER_BLOAD(5); asm volatile("" ::: "memory");
            ER_PROC(2); ER_BLOAD(6); ER_BLOAD(7); asm volatile("" ::: "memory");
            ER_PROC(3);
            ER_RS_REDUCE(1);
            ER_PROC(4); ER_PROC(5); ER_PROC(6); ER_PROC(7);
#undef ER_PROC
#undef ER_RS_REDUCE
#undef ER_RS_LOAD
#undef ER_BLOAD
        } else {
            u32x4 b[8][2];
#pragma unroll
            for (int q = 0; q < 8; ++q) { const bf16_t* p_ = baseh + ER_OFF(q); b[q][0] = *(const u32x4*)p_; b[q][1] = *(const u32x4*)(p_ + HALF); }
            __builtin_amdgcn_sched_barrier(0);
#pragma unroll
            for (int q = 0; q < 8; ++q) { f32x4 b0, b1, c0, c1; unpack_bf8(b[q][0], b0, b1); unpack_bf8(b[q][1], c0, c1);
                fin(acc, u, q, row0, col0, wc, fq, b0, b1, c0, c1, 1.0f);
                asm volatile("" ::: "memory"); }
        }
#undef ER_OFF
    }
};
struct EpiGate {
    static constexpr bool PERM = true, AFTER_DRAIN = false; static constexpr int NVM = 40;
    const bf16_t* hin; bf16_t* h16; const bf16_t* pp; int ldc; const float* ss;
    __device__ __forceinline__ void operator()(const f32x4 (&acc)[2][2][4][2], const Unit& u, int wr, int wc, int fr, int fq) const {
        const int row0 = u.pm * BM + wr * 64 + fr, col0 = u.pn * BM + wc * 32 + 8 * fq;
        u32x4 hw[8][2], pw[8][2];
        f32x4 pa[2][4][2];
        float rsv[2][4];
#define EG_OFF(q_) ((size_t)(row0 + ((q_) >> 2) * HALF + ((q_) & 3) * 16) * ldc + col0)
#define EG_LOAD(q_) do { const size_t off_ = EG_OFF(q_); hw[q_][0] = *(const u32x4*)(hin + off_); hw[q_][1] = *(const u32x4*)(hin + off_ + HALF); pw[q_][0] = *(const u32x4*)(pp + off_); pw[q_][1] = *(const u32x4*)(pp + off_ + HALF); } while (0)
#define EG_RS_LOAD(ai_) do { if (ss) { _Pragma("unroll") for (int m = 0; m < 4; ++m) { const float* p_ = ss + (size_t)(row0 + (ai_) * HALF + m * 16) * 32 + fq * 8; pa[ai_][m][0] = *(const f32x4*)p_; pa[ai_][m][1] = *(const f32x4*)(p_ + 4); } } } while (0)
#define EG_RS_REDUCE(ai_) do { _Pragma("unroll") for (int m = 0; m < 4; ++m) { if (ss) { const f32x4 a_ = pa[ai_][m][0], b_ = pa[ai_][m][1]; float s_ = ((a_[0] + a_[1]) + (a_[2] + a_[3])) + ((b_[0] + b_[1]) + (b_[2] + b_[3])); \
            s_ += __shfl_xor(s_, 16); s_ += __shfl_xor(s_, 32); rsv[ai_][m] = 1.0f / sqrtf(s_ * (1.0f / 2048.0f) + 1e-6f); } else rsv[ai_][m] = 1.0f; } } while (0)
#define EG_PROC(q_) do { const int ai_ = (q_) >> 2, m_ = (q_) & 3; const size_t off = EG_OFF(q_); const float rs = rsv[ai_][m_]; \
            _Pragma("unroll") for (int bj = 0; bj < 2; ++bj) { f32x4 h0, h1, p0, p1; unpack_bf8(hw[q_][bj], h0, h1); unpack_bf8(pw[q_][bj], p0, p1); \
                const f32x4 a0 = acc[ai_][bj][m_][0], a1 = acc[ai_][bj][m_][1]; f32x4 r0, r1; \
                _Pragma("unroll") for (int j = 0; j < 4; ++j) { r0[j] = h0[j] + p0[j] / (1.0f + __expf(-a0[j] * rs)); r1[j] = h1[j] + p1[j] / (1.0f + __expf(-a1[j] * rs)); } \
                *(u32x4*)(h16 + off + bj * HALF) = pack_bf8(r0, r1); } \
            asm volatile("" ::: "memory"); } while (0)
        EG_RS_LOAD(0); EG_LOAD(0); EG_LOAD(1);
        __builtin_amdgcn_sched_barrier(0);
        EG_RS_REDUCE(0);
        EG_PROC(0); EG_LOAD(2); EG_RS_LOAD(1); asm volatile("" ::: "memory");
        EG_PROC(1); EG_LOAD(3); EG_LOAD(4); asm volatile("" ::: "memory");
        EG_RS_REDUCE(1);
        EG_PROC(2); EG_LOAD(5); EG_LOAD(6); asm volatile("" ::: "memory");
        EG_PROC(3); EG_LOAD(7); asm volatile("" ::: "memory");
        EG_PROC(4); EG_PROC(5); EG_PROC(6); EG_PROC(7);
#undef EG_PROC
#undef EG_RS_REDUCE
#undef EG_RS_LOAD
#undef EG_LOAD
#undef EG_OFF
    }
};

template <class Epi, class Sched, bool ALIGN_EPI = false, bool SP2 = false>
__device__ __forceinline__ void gemm_phase(PG8_LAS unsigned char* lds, const Gemm g, const Sched& S, const Epi& E) {
    int tid = threadIdx.x; asm volatile("" : "+v"(tid));
    const int wid = __builtin_amdgcn_readfirstlane(tid >> 6), lane = tid & 63, wr = wid >> 2, wc = wid & 3, fr = lane & 15, fq = lane >> 4;
    const int K = g.K, nt = K / BK;
    unsigned voffA[2], voffB[2];
#pragma unroll
    for (int i = 0; i < 2; ++i) { int R, C; stage_rc(tid * 16 + i * 8192, R, C); const int Rb = Epi::PERM ? ((R & ~31) + perm32(R & 31)) : R;
        voffA[i] = (unsigned)(R * K + C) * 2u; voffB[i] = (unsigned)(Rb * K + C) * 2u; }
    const size_t kstep = (size_t)(BK * 2);
    const size_t hstep = (size_t)HALF * K * 2;
    const size_t tstep = 2 * hstep;
    const unsigned ldsw = (unsigned)wid * 1024u;
    const int aoff = lds_byte(wr * 64 + fr, fq * 8), boff = lds_byte(wc * 32 + fr, fq * 8);
#define PG8_SA(b, h) (((b) * 2 + (h)) * HTB)
#define PG8_SB(b, h) ((4 + (b) * 2 + (h)) * HTB)
#define PG8_STAGE(bufoff, gbase, voff) do { _Pragma("unroll") for (int _i = 0; _i < 2; ++_i) \
        __builtin_amdgcn_global_load_lds((const unsigned*)((const char*)(gbase) + (voff)[_i]), (PG8_LAS unsigned*)(lds + (bufoff) + ldsw + _i * 8192), 16, 0, 0); } while (0)
#define PG8_LDA(dst, b, h) do { _Pragma("unroll") for (int m = 0; m < 4; ++m) _Pragma("unroll") for (int k = 0; k < 2; ++k) dst[m][k] = *(const PG8_LAS bf16x8*)(lds + PG8_SA(b, h) + aoff + m * 2048 + k * 1024); } while (0)
#define PG8_LDB(dst, b, h) do { _Pragma("unroll") for (int n = 0; n < 2; ++n) _Pragma("unroll") for (int k = 0; k < 2; ++k) dst[n][k] = *(const PG8_LAS bf16x8*)(lds + PG8_SB(b, h) + boff + n * 2048 + k * 1024); } while (0)
#define PG8_MMA(ai, bj, At, Bt) do { __builtin_amdgcn_s_setprio(1); _Pragma("unroll") for (int m = 0; m < 4; ++m) _Pragma("unroll") for (int n = 0; n < 2; ++n) _Pragma("unroll") for (int k = 0; k < 2; ++k) \
        acc[ai][bj][m][n] = __builtin_amdgcn_mfma_f32_16x16x32_bf16(Bt[n][k], At[m][k], acc[ai][bj][m][n], 0, 0, 0); __builtin_amdgcn_s_setprio(0); } while (0)
#define PG8_WAIT_V(n) asm volatile("s_waitcnt vmcnt(" #n ")" ::: "memory")
#define PG8_WAIT_V_SEL(t_, ui_) asm volatile("s_cmp_lg_u32 %0, 0\n\ts_cbranch_scc1 1f\n\ts_cmp_eq_u32 %1, 0\n\ts_cbranch_scc1 1f\n\ts_waitcnt vmcnt(%2)\n\ts_branch 2f\n1:\n\ts_waitcnt vmcnt(8)\n2:" :: "s"(t_), "s"(ui_), "n"(8 + Epi::NVM) : "memory", "scc")
#define PG8_WAIT_L(n) asm volatile("s_waitcnt lgkmcnt(" #n ")" ::: "memory")
#define PG8_BAR __builtin_amdgcn_s_barrier()
#define PG8_SCHED __builtin_amdgcn_sched_barrier(0)
    Unit cur, nxt; int ui = 0;
    if (!S.next(0, cur)) return;
    f32x4 acc[2][2][4][2];
#pragma unroll
    for (int a = 0; a < 2; ++a)
#pragma unroll
        for (int b = 0; b < 2; ++b)
#pragma unroll
            for (int m = 0; m < 4; ++m)
#pragma unroll
                for (int n = 0; n < 2; ++n) acc[a][b][m][n] = (f32x4){0.f, 0.f, 0.f, 0.f};
    bf16x8 At[4][2], B0[2][2], B1[2][2];
    const char* cA = (const char*)g.A + (size_t)cur.pm * tstep; const char* cB = (const char*)g.Bt + (size_t)cur.pn * tstep;
    S.a_ready(cur);
    if constexpr (SP2) {
        PG8_STAGE(PG8_SB(0, 0), cB, voffB); PG8_STAGE(PG8_SB(0, 1), cB + hstep, voffB); PG8_STAGE(PG8_SA(0, 0), cA, voffA); PG8_STAGE(PG8_SA(0, 1), cA + hstep, voffA);
        if (wr == 1) PG8_BAR;
        PG8_WAIT_V(2); PG8_BAR;
        PG8_STAGE(PG8_SB(1, 0), cB + kstep, voffB); PG8_STAGE(PG8_SA(1, 0), cA + kstep, voffA); PG8_STAGE(PG8_SB(1, 1), cB + hstep + kstep, voffB);
        PG8_WAIT_V(6); PG8_BAR;
    } else {
        PG8_STAGE(PG8_SB(0, 0), cB, voffB); PG8_STAGE(PG8_SA(0, 0), cA, voffA); PG8_STAGE(PG8_SB(0, 1), cB + hstep, voffB); PG8_STAGE(PG8_SA(0, 1), cA + hstep, voffA);
        if (wr == 1) PG8_BAR;
        PG8_WAIT_V(4); PG8_BAR;
        PG8_STAGE(PG8_SB(1, 0), cB + kstep, voffB); PG8_STAGE(PG8_SA(1, 0), cA + kstep, voffA); PG8_STAGE(PG8_SB(1, 1), cB + hstep + kstep, voffB);
        PG8_WAIT_V(6); PG8_BAR;
    }
    for (;;) {
        const bool has_next = S.next(ui + 1, nxt);
        const char* nA = has_next ? (const char*)g.A + (size_t)nxt.pm * tstep : cA; const char* nB = has_next ? (const char*)g.Bt + (size_t)nxt.pn * tstep : cB;
        for (int t = 0; t < nt; t += 2) {
            const bool last = (t == nt - 2);
            const char* a1 = cA + (size_t)(t + 1) * kstep;
            const char* a2 = last ? nA : cA + (size_t)(t + 2) * kstep; const char* b2 = last ? nB : cB + (size_t)(t + 2) * kstep;
            const char* a3 = a2 + kstep; const char* b3 = b2 + kstep;
            if (last && has_next) S.a_ready(nxt);
            if constexpr (SP2) {
            PG8_LDB(B0, 0, 0); PG8_LDB(B1, 0, 1); PG8_SCHED; PG8_LDA(At, 0, 0); PG8_STAGE(PG8_SA(1, 1), a1 + hstep, voffA);
            PG8_WAIT_V_SEL(t, ui);
            PG8_WAIT_L(0); PG8_BAR; PG8_MMA(0, 0, At, B0); PG8_MMA(0, 1, At, B1); PG8_BAR; PG8_SCHED;
            PG8_LDA(At, 0, 1); PG8_STAGE(PG8_SB(0, 0), b2, voffB); PG8_STAGE(PG8_SB(0, 1), b2 + hstep, voffB); PG8_STAGE(PG8_SA(0, 0), a2, voffA);
            PG8_WAIT_V_SEL(t, ui);
            PG8_WAIT_L(0); PG8_BAR; PG8_MMA(1, 0, At, B0); PG8_MMA(1, 1, At, B1); PG8_BAR; PG8_SCHED;
            PG8_LDB(B0, 1, 0); PG8_LDB(B1, 1, 1); PG8_SCHED; PG8_LDA(At, 1, 0); PG8_STAGE(PG8_SA(0, 1), a2 + hstep, voffA);
            PG8_WAIT_V(8); PG8_WAIT_L(0); PG8_BAR; PG8_MMA(0, 0, At, B0); PG8_MMA(0, 1, At, B1); PG8_BAR; PG8_SCHED;
            PG8_LDA(At, 1, 1); PG8_STAGE(PG8_SB(1, 0), b3, voffB); PG8_STAGE(PG8_SB(1, 1), b3 + hstep, voffB); PG8_STAGE(PG8_SA(1, 0), a3, voffA);
            PG8_WAIT_V(8); PG8_WAIT_L(0); PG8_BAR; PG8_MMA(1, 0, At, B0); PG8_MMA(1, 1, At, B1); PG8_BAR; PG8_SCHED;
            } else {
            PG8_LDB(B0, 0, 0); PG8_SCHED; PG8_LDA(At, 0, 0); PG8_STAGE(PG8_SA(1, 1), a1 + hstep, voffA);
            PG8_WAIT_L(8); PG8_BAR; PG8_WAIT_L(0); PG8_MMA(0, 0, At, B0); PG8_BAR; PG8_SCHED;
            PG8_LDB(B1, 0, 1); PG8_STAGE(PG8_SB(0, 0), b2, voffB);
            PG8_BAR; PG8_WAIT_L(0); PG8_MMA(0, 1, At, B1); PG8_BAR;
            PG8_LDA(At, 0, 1); PG8_STAGE(PG8_SA(0, 0), a2, voffA);
            PG8_BAR; PG8_WAIT_L(0); PG8_MMA(1, 0, At, B0); PG8_BAR; PG8_SCHED;
            PG8_STAGE(PG8_SB(0, 1), b2 + hstep, voffB);
            PG8_WAIT_V(6); PG8_BAR; PG8_MMA(1, 1, At, B1); PG8_BAR;
            PG8_LDB(B0, 1, 0); PG8_SCHED; PG8_LDA(At, 1, 0); PG8_STAGE(PG8_SA(0, 1), a2 + hstep, voffA);
            PG8_WAIT_L(8); PG8_BAR; PG8_WAIT_L(0); PG8_MMA(0, 0, At, B0); PG8_BAR; PG8_SCHED;
            PG8_LDB(B1, 1, 1); PG8_STAGE(PG8_SB(1, 0), b3, voffB);
            PG8_BAR; PG8_WAIT_L(0); PG8_MMA(0, 1, At, B1); PG8_BAR;
            PG8_LDA(At, 1, 1); PG8_STAGE(PG8_SA(1, 0), a3, voffA);
            PG8_BAR; PG8_WAIT_L(0); PG8_MMA(1, 0, At, B0); PG8_BAR; PG8_SCHED;
            PG8_STAGE(PG8_SB(1, 1), b3 + hstep, voffB);
            PG8_WAIT_V(6); PG8_BAR; PG8_MMA(1, 1, At, B1); PG8_BAR;
            }
        }
        if constexpr (ALIGN_EPI) { if (wr == 0) PG8_BAR; }
        if constexpr (!Epi::AFTER_DRAIN) { E(acc, cur, wr, wc, fr, fq); S.done(cur); }
        if (!has_next) break;
#pragma unroll
        for (int a = 0; a < 2; ++a)
#pragma unroll
            for (int b = 0; b < 2; ++b)
#pragma unroll
                for (int m = 0; m < 4; ++m)
#pragma unroll
                    for (int n = 0; n < 2; ++n) acc[a][b][m][n] = (f32x4){0.f, 0.f, 0.f, 0.f};
        cur = nxt; cA = nA; cB = nB; ++ui;
        if constexpr (ALIGN_EPI) { if (wr == 1) PG8_BAR; }
    }
    PG8_WAIT_V(0);
    if constexpr (!ALIGN_EPI) { if (wr == 0) PG8_BAR; }
    PG8_BAR;
    if constexpr (Epi::AFTER_DRAIN) { E.fused(acc, cur, wr, wc, fr, fq, lds, wid, lane); S.done(cur); }
#undef PG8_SA
#undef PG8_SB
#undef PG8_STAGE
#undef PG8_LDA
#undef PG8_LDB
#undef PG8_MMA
#undef PG8_WAIT_V
#undef PG8_WAIT_L
#undef PG8_BAR
#undef PG8_SCHED
}
}

constexpr int NB = 4, SEQ = 8192, DM = 2048, DFF = 8192, NPROJ = 6144, PLE = 256, DEPTH = 4;
constexpr int M_TOK = NB * SEQ;
constexpr int EV_IN_W = 6160;
constexpr float RMS_EPS = 1e-6f, GN_EPS = 1e-5f;
constexpr float SC128 = 0.08838834764831845f;
constexpr int NWAVES = 8;
#ifndef LAYER_HI
#define LAYER_HI DEPTH
#endif

constexpr size_t MiB = 1u << 20;
constexpr size_t WS_CTL = 0, CTL_ZERO_BYTES = 1 * MiB;
constexpr size_t WS_WIN = WS_CTL + CTL_ZERO_BYTES;
constexpr size_t WS_WOUT = WS_WIN + (size_t)NPROJ * DM * 2;
constexpr size_t WS_WUP = WS_WOUT + (size_t)DM * DM * 2;
constexpr size_t WS_WDOWN = WS_WUP + (size_t)DFF * DM * 2;
constexpr size_t WS_WGATE = WS_WDOWN + (size_t)DM * DFF * 2;
constexpr size_t WS_WPP = WS_WGATE + (size_t)DM * DM * 2;
constexpr size_t WS_PB = WS_WPP + (size_t)DM * PLE * 2;
constexpr size_t WS_GB = WS_PB + (size_t)M_TOK * PLE * 2;
constexpr size_t WS_HN = WS_GB + (size_t)M_TOK * 16 * 4;
constexpr size_t WS_MIX = WS_HN + (size_t)M_TOK * DM * 2;
constexpr size_t WS_BIG = WS_MIX + (size_t)M_TOK * DM * 2;
constexpr size_t WS_PPB = WS_BIG + (size_t)M_TOK * DFF * 2;
constexpr size_t WS_LSUM = WS_PPB + (size_t)M_TOK * DM * 2;
constexpr size_t WS_LCIN = WS_LSUM + (size_t)NB * 256 * 1024 * 8;
constexpr size_t WS_DQK = WS_LCIN + (size_t)NB * 256 * 1024 * 4;
constexpr size_t WS_DGT = WS_DQK + (size_t)4096 * 64 * 64 * 2;
constexpr size_t WS_WLT = WS_DGT + 4096 * 4;
constexpr size_t WS_PP2 = WS_WLT + 8 * 256 * 128 * 2;
constexpr size_t WS_WIN2 = WS_PP2 + (size_t)M_TOK * DM * 2;
constexpr size_t WS_SS = WS_WIN2 + (size_t)NPROJ * DM * 2;
constexpr size_t WS_END = WS_SS + (size_t)2 * M_TOK * 32 * 4;
static_assert(WS_END <= 1286087808ull, "workspace map exceeds the guaranteed d_ws size (sum of inputs)");
constexpr int CW_BAR = 4096;

constexpr int RING_OFF = 0, RING_BYTES = 131072;
constexpr int LDS_BYTES = 163840;
constexpr int LDSCTL_OFF = LDS_BYTES - 1024, MISC_OFF = LDSCTL_OFF + 320;

#define GAS __attribute__((address_space(1)))
#define LAS __attribute__((address_space(3)))
typedef unsigned short bf16;
typedef unsigned v4u __attribute__((ext_vector_type(4)));
typedef unsigned v2u __attribute__((ext_vector_type(2)));
typedef float f32x4 __attribute__((ext_vector_type(4)));
typedef float f32x2 __attribute__((ext_vector_type(2)));
#define LDS_WAIT() asm volatile("s_waitcnt lgkmcnt(0)" ::: "memory")
#define LDS_BARRIER() do { asm volatile("s_waitcnt lgkmcnt(0)" ::: "memory"); __builtin_amdgcn_s_barrier(); asm volatile("" ::: "memory"); } while (0)
__device__ __forceinline__ unsigned f2bf(float f) { unsigned u = __float_as_uint(f); return (u + 0x7fffu + ((u >> 16) & 1u)) >> 16; }
__device__ __forceinline__ unsigned pk2(float lo, float hi) { return f2bf(lo) | (f2bf(hi) << 16); }
typedef __bf16 bf16v2_t __attribute__((ext_vector_type(2)));
__device__ __forceinline__ unsigned pkbf(float lo, float hi) { const f32x2 v = {lo, hi}; return __builtin_bit_cast(unsigned, __builtin_convertvector(v, bf16v2_t)); }
__device__ __forceinline__ float bflo(unsigned u) { return __uint_as_float(u << 16); }
__device__ __forceinline__ float bfhi(unsigned u) { return __uint_as_float(u & 0xffff0000u); }
__device__ __forceinline__ float bf2f(bf16 b) { return __uint_as_float((unsigned)b << 16); }
__device__ __forceinline__ float sigmoidf_(float x) { return 1.0f / (1.0f + __expf(-x)); }
__device__ __forceinline__ float siluf_(float x) { return x / (1.0f + __expf(-x)); }
__device__ __forceinline__ float softplusf_(float x) { return x > 20.f ? x : log1pf(expf(x)); }
__device__ __forceinline__ float neg_expm1f_(float x) { const float p = x * (1.f + x * 0.5f * (1.f + x * (1.f / 3.f) * (1.f + x * 0.25f * (1.f + x * 0.2f * (1.f + x * (1.f / 6.f) * (1.f + x * (1.f / 7.f))))))); return x > -0.35f ? -p : 1.0f - __expf(x); }
__device__ __forceinline__ float gelu_tanh(float x) { const float z = 0.7978845608028654f * (x + 0.044715f * x * x * x); const float th = 1.0f - 2.0f / (__expf(2.0f * z) + 1.0f); return 0.5f * x * (1.0f + th); }
__device__ __forceinline__ float wave_sum(float v) {
#pragma unroll
    for (int o = 1; o < 64; o <<= 1) v += __shfl_xor(v, o);
    return v;
}
__device__ __forceinline__ float wave_max(float v) {
#pragma unroll
    for (int o = 1; o < 64; o <<= 1) v = fmaxf(v, __shfl_xor(v, o));
    return v;
}
#define DPP_ADD(v, ctrl) ((v) + __int_as_float(__builtin_amdgcn_update_dpp(0, __float_as_int(v), (ctrl), 0xF, 0xF, true)))
__device__ __forceinline__ float row16_sum(float v) {
    v = DPP_ADD(v, 0xB1);
    v = DPP_ADD(v, 0x4E);
    v = DPP_ADD(v, 0x141);
    v = DPP_ADD(v, 0x140);
    return v;
}

__device__ __forceinline__ float row8_sum(float v) { v = DPP_ADD(v, 0xB1); v = DPP_ADD(v, 0x4E); v = DPP_ADD(v, 0x141); return v; }
__device__ __forceinline__ void unpack8(const v4u x, float* o) { o[0] = bflo(x.x); o[1] = bfhi(x.x); o[2] = bflo(x.y); o[3] = bfhi(x.y); o[4] = bflo(x.z); o[5] = bfhi(x.z); o[6] = bflo(x.w); o[7] = bfhi(x.w); }
__device__ __forceinline__ v4u pack8(const float* a) { v4u w; w.x = pkbf(a[0], a[1]); w.y = pkbf(a[2], a[3]); w.z = pkbf(a[4], a[5]); w.w = pkbf(a[6], a[7]); return w; }

#define XB_TMO      128
#define XB_XCNT(j)  (256  + 64 * (j))
#define XB_XSUB(j)  (1280 + 64 * (j))
#define XB_XGEN(j)  (2304 + 64 * (j))
#define XB_TOP      3328
#define XB_TOPGEN   3392
#define XCD_BAR_WORDS 3456
#define XB_SPIN_CAP (1u << 20)

__device__ __forceinline__ unsigned xb_ld(unsigned* p)              { return __hip_atomic_load(p, __ATOMIC_RELAXED, __HIP_MEMORY_SCOPE_AGENT); }
__device__ __forceinline__ unsigned xb_add(unsigned* p, unsigned v) { return __hip_atomic_fetch_add(p, v, __ATOMIC_RELAXED, __HIP_MEMORY_SCOPE_AGENT); }
__device__ __forceinline__ unsigned xb_xcc_id() { return (unsigned)__builtin_amdgcn_s_getreg((3 << 11) | 20) & 0xFu; }
#define XB_SPIN(cond, bar) do { unsigned _sp = 0; while (cond) { __builtin_amdgcn_s_sleep(1); \
    if ((++_sp & 255u) == 0u) { if (xb_ld(&(bar)[XB_TMO])) break; if (_sp > XB_SPIN_CAP) { atomicAdd(&(bar)[XB_TMO], 1u); break; } } } } while (0)

struct XcdBarrier { unsigned* bar; unsigned x; volatile LAS unsigned* st; };

__device__ __forceinline__ XcdBarrier xcd_barrier_post(unsigned* bar, volatile LAS unsigned* st) {
    XcdBarrier b; b.bar = bar; b.x = xb_xcc_id(); b.st = st;
    if (threadIdx.x == 0) (void)xb_add(&bar[XB_XCNT(b.x)], 1u);
    return b;
}
__device__ __forceinline__ void xcd_barrier_complete(unsigned* bar, unsigned x, unsigned& nloc, unsigned& nx) {
    const unsigned G = gridDim.x * gridDim.y * gridDim.z;
    unsigned sum, cnt, mine, sp = 0u;
    for (;;) {
        sum = 0u; cnt = 0u; mine = 0u;
#pragma unroll
        for (unsigned j = 0; j < 16; ++j) { const unsigned c = xb_ld(&bar[XB_XCNT(j)]); sum += c; cnt += (c > 0u) ? 1u : 0u; mine = (j == x) ? c : mine; }
        if (sum == G) break;
        __builtin_amdgcn_s_sleep(1);
        if ((++sp & 255u) == 0u) { if (xb_ld(&bar[XB_TMO])) break; if (sp > XB_SPIN_CAP) { atomicAdd(&bar[XB_TMO], 1u); break; } }
    }
    nloc = mine > 0u ? mine : 1u; nx = cnt > 0u ? cnt : 1u;
}
__device__ __forceinline__ void xcd_barrier(const XcdBarrier& b) {
    asm volatile("s_waitcnt vmcnt(0)" ::: "memory");
    __syncthreads();
    if (threadIdx.x == 0) {
        unsigned* bar = b.bar;
        __builtin_amdgcn_s_waitcnt(0);
        unsigned nloc = b.st[0], nx = b.st[1];
        if (nloc == 0u) { xcd_barrier_complete(bar, b.x, nloc, nx); b.st[0] = nloc; b.st[1] = nx; }
        const unsigned old = xb_add(&bar[XB_XSUB(b.x)], 1u);
        const unsigned gen = old / nloc;
        if (old + 1u == (gen + 1u) * nloc) {
            __builtin_amdgcn_fence(__ATOMIC_RELEASE, "agent");
            asm volatile("s_waitcnt vmcnt(0)" ::: "memory");
            const unsigned og = xb_add(&bar[XB_TOP], 1u);
            const unsigned tg = og / nx;
            if (og + 1u == (tg + 1u) * nx) xb_add(&bar[XB_TOPGEN], 1u);
            else XB_SPIN(xb_ld(&bar[XB_TOPGEN]) == tg, bar);
            __builtin_amdgcn_fence(__ATOMIC_ACQUIRE, "agent");
            xb_add(&bar[XB_XGEN(b.x)], 1u);
            asm volatile("s_waitcnt vmcnt(0)" ::: "memory");
        } else {
            XB_SPIN(xb_ld(&bar[XB_XGEN(b.x)]) == gen, bar);
            __builtin_amdgcn_fence(__ATOMIC_ACQUIRE, "agent");
            asm volatile("s_waitcnt vmcnt(0)" ::: "memory");
        }
    }
    __syncthreads();
}

struct Args { const float* in[25]; float* out; unsigned char* ws; int ph_lo, ph_hi; };
struct Frame {
    LAS unsigned char* lds;
    int tid, lane, wave, bx, G;
    const float* const* in;
    float* out;
    bf16 *WIN, *WOUT, *WUP, *WDOWN, *WGATE, *WPP, *PB, *HN, *MIX, *BIG, *PPB;
    float* GB; unsigned char* ws; bf16* PP2; bf16* H16;
};

__device__ __forceinline__ void tr_item(const float* W, int ldw, int c0, int K, bf16* WT, int r0, int nblk, LAS float* scr, int item, int lane, const float* kscale) {
    const int kb = item / nblk, nb = item % nblk, k0 = 64 * kb, n0 = 32 * nb;
    {   float wv[32];
#pragma unroll
        for (int i = 0; i < 32; ++i) wv[i] = W[(size_t)(k0 + 2 * i + (lane >> 5)) * ldw + c0 + n0 + (lane & 31)];
        __builtin_amdgcn_sched_barrier(0);
#pragma unroll
        for (int i = 0; i < 32; ++i) { const int kk = 2 * i + (lane >> 5); const float sc = kscale ? kscale[k0 + kk] : 1.0f; scr[kk * 33 + (lane & 31)] = wv[i] * sc; } }
    LDS_WAIT(); asm volatile("" ::: "memory");
    const int c = lane & 7;
#pragma unroll
    for (int j = 0; j < 4; ++j) { const int n = (lane >> 3) + 8 * j; const LAS float* s = scr + (8 * c) * 33 + n;
        v4u o; o.x = pk2(s[0 * 33], s[1 * 33]); o.y = pk2(s[2 * 33], s[3 * 33]); o.z = pk2(s[4 * 33], s[5 * 33]); o.w = pk2(s[6 * 33], s[7 * 33]);
        *(v4u*)(WT + (size_t)(r0 + n0 + n) * K + k0 + 8 * c) = o; }
    LDS_WAIT(); asm volatile("" ::: "memory");
}
__device__ __forceinline__ void tr_matrix(Frame& F, const float* W, int ldw, int c0, int K, bf16* WT, int r0, int ncols, int wg0 = 0, const float* kscale = nullptr) {
    LAS float* scr = (LAS float*)(F.lds + RING_OFF + F.wave * 16384);
    const int gw = (F.bx - wg0) * NWAVES + F.wave, NGW = (F.G - wg0) * NWAVES, nblk = ncols / 32, nitems = (K / 64) * nblk;
    for (int it = gw; it < nitems; it += NGW) tr_item(W, ldw, c0, K, WT, r0, nblk, scr, it, F.lane, kscale);
}

template <bool GBV, bool SRC16>
__device__ __forceinline__ void rms_rows(Frame& F, const void* hsrcv, const float* lnw, bf16* HN, float* GB) {
    const float* hsrc = (const float*)hsrcv; const bf16* hsrc16 = (const bf16*)hsrcv;
    const int gw = F.bx * NWAVES + F.wave, NGW = F.G * NWAVES, lane = F.lane;
    const LAS float* wabT = (const LAS float*)(F.lds + RING_OFF);
    f32x4 lw[8];
#pragma unroll
    for (int j = 0; j < 8; ++j) lw[j] = ((const f32x4*)lnw)[lane + 64 * j];
    for (int pi = gw; pi < M_TOK / 2; pi += NGW) {
        f32x4 y[2][8];
        if (SRC16) { v2u w_[2][8];
#pragma unroll
            for (int r = 0; r < 2; ++r)
#pragma unroll
                for (int j = 0; j < 8; ++j) w_[r][j] = ((const v2u*)(hsrc16 + ((size_t)2 * pi + r) * DM))[lane + 64 * j];
            __builtin_amdgcn_sched_barrier(0);
#pragma unroll
            for (int r = 0; r < 2; ++r)
#pragma unroll
                for (int j = 0; j < 8; ++j) y[r][j] = (f32x4){bflo(w_[r][j].x), bfhi(w_[r][j].x), bflo(w_[r][j].y), bfhi(w_[r][j].y)};
        } else {
#pragma unroll
            for (int r = 0; r < 2; ++r)
#pragma unroll
                for (int j = 0; j < 8; ++j) y[r][j] = ((const f32x4*)(hsrc + ((size_t)2 * pi + r) * DM))[lane + 64 * j];
            __builtin_amdgcn_sched_barrier(0);
        }
#pragma unroll
        for (int r = 0; r < 2; ++r) {
            const size_t row = (size_t)2 * pi + r;
            float ss = 0.f;
#pragma unroll
            for (int j = 0; j < 8; ++j) ss += (y[r][j].x * y[r][j].x + y[r][j].y * y[r][j].y) + (y[r][j].z * y[r][j].z + y[r][j].w * y[r][j].w);
            ss = wave_sum(ss);
            const float rstd = 1.0f / sqrtf(ss * (1.0f / DM) + RMS_EPS);
            v2u* dst = (v2u*)(HN + row * DM) + lane;
#pragma unroll
            for (int j = 0; j < 8; ++j) { y[r][j] = y[r][j] * rstd * lw[j];
                v2u o; o.x = pkbf(y[r][j].x, y[r][j].y); o.y = pkbf(y[r][j].z, y[r][j].w); dst[64 * j] = o; }
        }
        if (GBV) {
            float keep0 = 0.f, keep1 = 0.f;
#pragma unroll 1
            for (int c = 0; c < 16; ++c) {
                float a0 = 0.f, a1 = 0.f;
                const LAS f32x4* wp = (const LAS f32x4*)(wabT + c * DM) + lane;
#pragma unroll
                for (int j = 0; j < 8; ++j) { const f32x4 w = wp[64 * j];
                    a0 += (y[0][j].x * w.x + y[0][j].y * w.y) + (y[0][j].z * w.z + y[0][j].w * w.w);
                    a1 += (y[1][j].x * w.x + y[1][j].y * w.y) + (y[1][j].z * w.z + y[1][j].w * w.w); }
                a0 = wave_sum(a0); a1 = wave_sum(a1);
                if (lane == c) { keep0 = a0; keep1 = a1; }
            }
            if (lane < 16) { GB[((size_t)2 * pi) * 16 + lane] = keep0; GB[((size_t)2 * pi + 1) * 16 + lane] = keep1; }
        }
    }
}

__device__ __forceinline__ void convert_w_in(Frame& F, int layer, int wg0) {
    const int j = layer >> 1; bf16* dst = (layer & 1) ? (bf16*)(F.ws + WS_WIN2) : F.WIN;
    if ((layer & 1) == 0) { const float* w = F.in[10] + (size_t)j * DM * EV_IN_W;
        tr_matrix(F, w, EV_IN_W, 0, DM, dst, 0, 4096, wg0); tr_matrix(F, w, EV_IN_W, 4112, DM, dst, 4096, 2048, wg0);
    } else tr_matrix(F, F.in[23] + (size_t)j * DM * NPROJ, NPROJ, 0, DM, dst, 0, NPROJ, wg0);
}
__device__ __forceinline__ void convert_w_rest(Frame& F, int layer, int wg0) {
    const int j = layer >> 1;
    tr_matrix(F, ((layer & 1) ? F.in[24] : F.in[11]) + (size_t)j * DM * DM, DM, 0, DM, F.WOUT, 0, DM, wg0);
    tr_matrix(F, F.in[5] + (size_t)layer * DM * DFF, DFF, 0, DM, F.WUP, 0, DFF, wg0, F.in[3] + (size_t)layer * DM);
    tr_matrix(F, F.in[6] + (size_t)layer * DFF * DM, DM, 0, DFF, F.WDOWN, 0, DM, wg0);
    tr_matrix(F, F.in[8] + (size_t)layer * DM * DM, DM, 0, DM, F.WGATE, 0, DM, wg0, F.in[4] + (size_t)layer * DM);
}
__device__ __forceinline__ void phase_t1(Frame& F, int layer) {
    const int j = layer >> 1; const bool even = (layer & 1) == 0;
    if (layer == 0) convert_w_in(F, 0, 0);
    tr_matrix(F, F.in[7] + (size_t)layer * PLE * DM, DM, 0, PLE, F.WPP, 0, DM);
    if (even) {
        bf16* WLT = (bf16*)(F.ws + WS_WLT); const float* wa = F.in[18] + (size_t)j * 8 * 128 * 128; const float* wx = F.in[20] + (size_t)j * 8 * 128 * 128;
        for (int i = F.bx * 512 + F.tid; i < 8 * 256 * 16; i += F.G * 512) { const int o = i & 255, gi = i >> 8; const int gg = gi >> 4, in0 = (gi & 15) * 8;
            const float* src = (o < 128 ? wa : wx) + ((size_t)gg * 128 + in0) * 128 + (o & 127);
            v4u w; w.x = pk2(src[0], src[128]); w.y = pk2(src[256], src[384]); w.z = pk2(src[512], src[640]); w.w = pk2(src[768], src[896]);
            *(v4u*)(WLT + ((size_t)gg * 256 + o) * 128 + in0) = w; }
    }
    {
        const f32x4* src = (const f32x4*)(F.in[1] + (size_t)layer * M_TOK * PLE);
        const size_t n8 = (size_t)M_TOK * PLE / 8, stride = (size_t)F.G * 512;
        for (size_t i = (size_t)F.bx * 512 + F.tid; i < n8; i += 4 * stride) { f32x4 a[4], b[4];
#pragma unroll
            for (int u = 0; u < 4; ++u) { a[u] = src[2 * (i + u * stride)]; b[u] = src[2 * (i + u * stride) + 1]; }
            __builtin_amdgcn_sched_barrier(0);
#pragma unroll
            for (int u = 0; u < 4; ++u) { v4u o; o.x = pkbf(a[u].x, a[u].y); o.y = pkbf(a[u].z, a[u].w); o.z = pkbf(b[u].x, b[u].y); o.w = pkbf(b[u].z, b[u].w); ((v4u*)F.PB)[i + u * stride] = o; } }
    }
    const void* hsrc = (layer == 0) ? (const void*)F.in[0] : (const void*)F.H16;
    const float* lnw = F.in[2] + (size_t)layer * DM;
    if (even) {
        __syncthreads();
        LAS float* wabT = (LAS float*)(F.lds + RING_OFF);
        const float* w = F.in[10] + (size_t)j * DM * EV_IN_W + 4096;
        for (int i = F.tid; i < 16 * DM; i += 512) { const int k = i >> 4, c = i & 15; wabT[c * DM + k] = w[(size_t)k * EV_IN_W + c]; }
        __syncthreads();
        if (layer == 0) rms_rows<true, false>(F, hsrc, lnw, F.HN, F.GB); else rms_rows<true, true>(F, hsrc, lnw, F.HN, F.GB);
        __syncthreads();
    } else rms_rows<false, true>(F, hsrc, lnw, F.HN, nullptr);
}

__device__ __forceinline__ void lru_carry(Frame& F, int id) {
    const int b = id >> 10, ch = id & 1023;
    const f32x2* LSUM = (const f32x2*)(F.ws + WS_LSUM) + (size_t)b * 128 * 1024 + ch; float* LCIN = (float*)(F.ws + WS_LCIN) + (size_t)b * 128 * 1024 + ch;
    float carry = 0.f;
    for (int t0 = 0; t0 < 128; t0 += 8) { f32x2 s[8];
#pragma unroll
        for (int i = 0; i < 8; ++i) s[i] = LSUM[(size_t)(t0 + i) * 1024];
#pragma unroll
        for (int i = 0; i < 8; ++i) { LCIN[(size_t)(t0 + i) * 1024] = carry; carry = s[i].x * carry + s[i].y; } }
}

__device__ __forceinline__ void lru_final(Frame& F) {
    const bf16* HL = F.HN; const bf16* PC = F.HN + (size_t)M_TOK * 1024; const bf16* PROJ = F.BIG; const float* LCIN = (const float*)(F.ws + WS_LCIN);
    const size_t n8 = (size_t)M_TOK * 1024 / 8, stride = (size_t)F.G * 512;
    for (size_t i = (size_t)F.bx * 512 + F.tid; i < n8; i += stride) {
        const size_t m = i >> 7; const int c0 = (int)(i & 127) * 8; const size_t tile = m >> 6;
        const v4u hw = *(const v4u*)(HL + m * 1024 + c0), pw = *(const v4u*)(PC + m * 1024 + c0), yw = *(const v4u*)(PROJ + m * NPROJ + 5120 + c0);
        const f32x4 ca = *(const f32x4*)(LCIN + tile * 1024 + c0), cb = *(const f32x4*)(LCIN + tile * 1024 + c0 + 4); __builtin_amdgcn_sched_barrier(0);
        v4u o;
        o.x = pk2((bflo(hw.x) + bflo(pw.x) * ca.x) * gelu_tanh(bflo(yw.x)), (bfhi(hw.x) + bfhi(pw.x) * ca.y) * gelu_tanh(bfhi(yw.x)));
        o.y = pk2((bflo(hw.y) + bflo(pw.y) * ca.z) * gelu_tanh(bflo(yw.y)), (bfhi(hw.y) + bfhi(pw.y) * ca.w) * gelu_tanh(bfhi(yw.y)));
        o.z = pk2((bflo(hw.z) + bflo(pw.z) * cb.x) * gelu_tanh(bflo(yw.z)), (bfhi(hw.z) + bfhi(pw.z) * cb.y) * gelu_tanh(bfhi(yw.z)));
        o.w = pk2((bflo(hw.w) + bflo(pw.w) * cb.z) * gelu_tanh(bflo(yw.w)), (bfhi(hw.w) + bfhi(pw.w) * cb.w) * gelu_tanh(bfhi(yw.w)));
        *(v4u*)(F.MIX + m * DM + 1024 + c0) = o;
    }
}

__device__ __forceinline__ void dn_final(Frame& F, int j) {
    const int gw = F.bx * NWAVES + F.wave, NGW = F.G * NWAVES, lane = F.lane; const int h = lane >> 3, c0 = (lane & 7) * 16;
    const bf16* PROJ = F.BIG; const float* nw = F.in[15] + j * 128 + c0;
    float wv[16];
#pragma unroll
    for (int i = 0; i < 4; ++i) { const f32x4 w4 = *(const f32x4*)(nw + 4 * i); wv[4 * i] = w4.x; wv[4 * i + 1] = w4.y; wv[4 * i + 2] = w4.z; wv[4 * i + 3] = w4.w; }
    for (int m = gw; m < M_TOK; m += NGW) {
        v4u* op = (v4u*)(F.MIX + (size_t)m * DM + h * 128 + c0); const v4u* zp = (const v4u*)(PROJ + (size_t)m * NPROJ + 3072 + h * 128 + c0);
        const v4u o0 = op[0], o1 = op[1], z0 = zp[0], z1 = zp[1]; __builtin_amdgcn_sched_barrier(0);
        float o[16], z[16]; unpack8(o0, o); unpack8(o1, o + 8); unpack8(z0, z); unpack8(z1, z + 8);
        float ss = 0.f;
#pragma unroll
        for (int i = 0; i < 16; ++i) ss += o[i] * o[i];
        ss = row8_sum(ss); const float r = 1.0f / sqrtf(ss * (1.0f / 128.0f) + RMS_EPS);
#pragma unroll
        for (int i = 0; i < 16; ++i) o[i] = o[i] * r * wv[i] * siluf_(z[i]);
        op[0] = pack8(o); op[1] = pack8(o + 8);
    }
}
typedef short bf16x8 __attribute__((ext_vector_type(8)));
typedef short s16x4 __attribute__((ext_vector_type(4)));
typedef float f32x16 __attribute__((ext_vector_type(16)));
#define MFMA32(a, b, c) __builtin_amdgcn_mfma_f32_32x32x16_bf16((a), (b), (c), 0, 0, 0)
#define TR16(p) __builtin_amdgcn_ds_read_tr16_b64_v4i16((LAS s16x4*)(p))
__device__ __forceinline__ bf16x8 pack_acc8(const f32x16& x, int s) {
    v4u p; p.x = pkbf(x[8 * s + 0], x[8 * s + 1]); p.y = pkbf(x[8 * s + 2], x[8 * s + 3]); p.z = pkbf(x[8 * s + 4], x[8 * s + 5]); p.w = pkbf(x[8 * s + 6], x[8 * s + 7]);
    return __builtin_bit_cast(bf16x8, p);
}
__device__ __forceinline__ v4u scale8(v4u x, float sc) {
    v4u o; o.x = pkbf(bflo(x.x) * sc, bfhi(x.x) * sc); o.y = pkbf(bflo(x.y) * sc, bfhi(x.y) * sc); o.z = pkbf(bflo(x.z) * sc, bfhi(x.z) * sc); o.w = pkbf(bflo(x.w) * sc, bfhi(x.w) * sc); return o;
}
constexpr int RT_QS = 272, RT_VS = 320, RT_S8 = 264;
constexpr int RT_QL = 0, RT_KL = 64 * RT_QS, RT_QD = 2 * 64 * RT_QS, RT_KT = RT_QD + 64 * RT_S8, RT_VL = RT_KT + 64 * RT_VS, RT_VSC = RT_VL + 64 * RT_VS, RT_PSH = RT_VSC + 64 * RT_VS;
static_assert(RT_PSH + 6 * 1024 <= LDSCTL_OFF, "retention LDS map");
__device__ __forceinline__ void ret_chunk(Frame& F, int wg) {
    const int tid = F.tid, lane = F.lane, wave = F.wave;
    const int bh = wg >> 1, b = bh >> 2, h = bh & 3, half = wg & 1;
    const bf16* PROJ = F.BIG; float* ORET = (float*)F.HN;
    LAS unsigned char* L = F.lds + RING_OFF;
    const float lg = log2f(1.0f - exp2f(-5.0f - (float)h));
    const float g64 = exp2f(64.0f * lg);
    const int r = lane & 31, hh = lane >> 5, q4 = (lane & 15) >> 2, p4 = lane & 3, cb = (lane >> 4) & 1;
    const int srow = (tid & 255) >> 4, sch = tid & 15;
    v4u pq[2][4], pk[2][4], pv[2][4];
    const size_t mrow0 = (size_t)b * SEQ;
#define RT_ISSUE(SET_, n_) do { _Pragma("unroll") for (int u = 0; u < 4; ++u) { const bf16* rp = PROJ + (mrow0 + (size_t)(n_) * 64 + srow + 16 * u) * NPROJ; \
            pq[SET_][u] = *(const v4u*)(rp + 3072 + h * 128 + sch * 8); pk[SET_][u] = *(const v4u*)(rp + 3584 + h * 128 + sch * 8); pv[SET_][u] = *(const v4u*)(rp + 4096 + h * 256 + half * 128 + sch * 8); } } while (0)
#define RT_COMMIT_A(SET_) do { _Pragma("unroll") for (int u = 0; u < 4; ++u) { const int row = srow + 16 * u; \
            *(LAS v4u*)(L + RT_QL + row * RT_QS + sch * 16) = pq[SET_][u]; *(LAS v4u*)(L + RT_KL + row * RT_QS + sch * 16) = pk[SET_][u]; } } while (0)
#define RT_COMMIT_B(SET_) do { _Pragma("unroll") for (int u = 0; u < 4; ++u) { const int row = srow + 16 * u; \
            { const v4u qd_ = scale8(pq[SET_][u], exp2f((float)(row + 1) * lg)); *(LAS v2u*)(L + RT_QD + row * RT_S8 + sch * 16) = (v2u){qd_.x, qd_.y}; *(LAS v2u*)(L + RT_QD + row * RT_S8 + sch * 16 + 8) = (v2u){qd_.z, qd_.w}; } \
            *(LAS v4u*)(L + RT_KT + row * RT_VS + sch * 16) = pk[SET_][u]; \
            *(LAS v4u*)(L + RT_VL + row * RT_VS + sch * 16) = pv[SET_][u]; \
            *(LAS v4u*)(L + RT_VSC + row * RT_VS + sch * 16) = scale8(pv[SET_][u], exp2f((float)(63 - row) * lg) * SC128); } } while (0)
    f32x16 S[4];
#pragma unroll
    for (int t = 0; t < 4; ++t)
#pragma unroll
        for (int e = 0; e < 16; ++e) S[t][e] = 0.f;
    if (wave >= 4) {
        RT_ISSUE(0, 0); RT_COMMIT_A(0); RT_COMMIT_B(0); RT_ISSUE(1, 1); RT_ISSUE(0, 2);
        LDS_BARRIER();
        v4u qdx[4], vsx[4];
#define RT_SCALE_B(SET_) do { _Pragma("unroll") for (int u = 0; u < 4; ++u) { const int row = srow + 16 * u; qdx[u] = scale8(pq[SET_][u], exp2f((float)(row + 1) * lg)); vsx[u] = scale8(pv[SET_][u], exp2f((float)(63 - row) * lg) * SC128); asm volatile("" : "+v"(qdx[u]), "+v"(vsx[u])); } } while (0)
#define RT_WRITE_B(SET_) do { _Pragma("unroll") for (int u = 0; u < 4; ++u) { const int row = srow + 16 * u; \
            *(LAS v2u*)(L + RT_QD + row * RT_S8 + sch * 16) = (v2u){qdx[u].x, qdx[u].y}; *(LAS v2u*)(L + RT_QD + row * RT_S8 + sch * 16 + 8) = (v2u){qdx[u].z, qdx[u].w}; \
            *(LAS v4u*)(L + RT_KT + row * RT_VS + sch * 16) = pk[SET_][u]; \
            *(LAS v4u*)(L + RT_VL + row * RT_VS + sch * 16) = pv[SET_][u]; \
            *(LAS v4u*)(L + RT_VSC + row * RT_VS + sch * 16) = vsx[u]; } } while (0)
        for (int n = 0; n < SEQ / 64; n += 2) {
            LDS_BARRIER(); RT_COMMIT_A(1); RT_SCALE_B(1);
            LDS_BARRIER(); RT_WRITE_B(1); if (n + 3 < SEQ / 64) RT_ISSUE(1, n + 3);
            LDS_BARRIER(); if (n + 2 < SEQ / 64) { RT_COMMIT_A(0); RT_SCALE_B(0); }
            LDS_BARRIER(); if (n + 2 < SEQ / 64) { RT_WRITE_B(0); if (n + 4 < SEQ / 64) RT_ISSUE(0, n + 4); }
        }
#undef RT_SCALE_B
#undef RT_WRITE_B
    } else {
    __builtin_amdgcn_s_setprio(3);
    LDS_BARRIER();
    for (int n = 0; n < SEQ / 64; ++n) {
        {
            const int w = wave;
            if (w < 3) {
                f32x16 pt;
#pragma unroll
                for (int e = 0; e < 16; ++e) pt[e] = 0.f;
                const int krow = (w == 2 ? 32 : 0) + r, qrow = (w == 0 ? 0 : 32) + r;
                bf16x8 kq[3][2];
#define RT_PT_RD(s_, b_) do { kq[b_][0] = *(const LAS bf16x8*)(L + RT_KL + krow * RT_QS + (16 * (s_) + 8 * hh) * 2); kq[b_][1] = *(const LAS bf16x8*)(L + RT_QL + qrow * RT_QS + (16 * (s_) + 8 * hh) * 2); } while (0)
                RT_PT_RD(0, 0); RT_PT_RD(1, 1);
#pragma unroll
                for (int s = 0; s < 8; ++s) {
                    if (s + 2 < 8) RT_PT_RD(s + 2, (s + 2) % 3);
                    __builtin_amdgcn_sched_barrier(0);
                    pt = MFMA32(kq[s % 3][0], kq[s % 3][1], pt);
                    __builtin_amdgcn_sched_barrier(0);
                }
#undef RT_PT_RD
#pragma unroll
                for (int e = 0; e < 16; ++e) { const int jr = (e & 3) + 8 * (e >> 2) + 4 * hh; const int dd = r - jr;
                    const float fd = (w == 1) ? exp2f((float)(dd + 32) * lg) * SC128 : (dd >= 0 ? exp2f((float)dd * lg) * SC128 : 0.f);
                    pt[e] *= fd; }
                *(LAS bf16x8*)(L + RT_PSH + (2 * w) * 1024 + lane * 16) = pack_acc8(pt, 0);
                *(LAS bf16x8*)(L + RT_PSH + (2 * w + 1) * 1024 + lane * 16) = pack_acc8(pt, 1);
            }
            LDS_BARRIER();
            bf16x8 pf[3][2];
#pragma unroll
            for (int t = 0; t < 3; ++t) { pf[t][0] = *(const LAS bf16x8*)(L + RT_PSH + (2 * t) * 1024 + lane * 16); pf[t][1] = *(const LAS bf16x8*)(L + RT_PSH + (2 * t + 1) * 1024 + lane * 16); }
            const LAS unsigned char* vb = L + RT_VL + (4 * hh + q4) * RT_VS + (32 * w + 16 * cb + 4 * p4) * 2;
            s16x4 vr[2][4];
#pragma unroll
            for (int s = 0; s < 2; ++s) { vr[s][0] = TR16(vb + (16 * s) * RT_VS); vr[s][1] = TR16(vb + (16 * s + 8) * RT_VS); vr[s][2] = TR16(vb + (32 + 16 * s) * RT_VS); vr[s][3] = TR16(vb + (32 + 16 * s + 8) * RT_VS); }
            s16x4 qd[3][4];
#define RT_QD_RD(i_, b_) do { const LAS unsigned char* qa = L + RT_QD + r * RT_S8 + (32 * ((i_) >> 1) + 16 * ((i_) & 1) + 4 * hh) * 2; \
                qd[b_][0] = *(const LAS s16x4*)(qa); qd[b_][1] = *(const LAS s16x4*)(qa + 16); qd[b_][2] = *(const LAS s16x4*)(qa + 32 * RT_S8); qd[b_][3] = *(const LAS s16x4*)(qa + 32 * RT_S8 + 16); } while (0)
            RT_QD_RD(0, 0); RT_QD_RD(1, 1);
            __builtin_amdgcn_sched_barrier(0);
            f32x16 o0, o1;
#pragma unroll
            for (int e = 0; e < 16; ++e) { o0[e] = 0.f; o1[e] = 0.f; }
#pragma unroll
            for (int s = 0; s < 2; ++s) {
                const bf16x8 v0 = __builtin_shufflevector(vr[s][0], vr[s][1], 0, 1, 2, 3, 4, 5, 6, 7);
                const bf16x8 v1 = __builtin_shufflevector(vr[s][2], vr[s][3], 0, 1, 2, 3, 4, 5, 6, 7);
                o0 = MFMA32(pf[0][s], v0, o0);
                o1 = MFMA32(pf[1][s], v0, o1);
                o1 = MFMA32(pf[2][s], v1, o1);
            }
            const LAS unsigned char* kb = L + RT_KT + (8 * hh + q4) * RT_VS + (16 * cb + 4 * p4) * 2;
            const LAS unsigned char* sb2 = L + RT_VSC + (8 * hh + q4) * RT_VS + (32 * w + 16 * cb + 4 * p4) * 2;
            s16x4 ks[2][10];
#define RT_SU_RD(sp_, b_) do { ks[b_][0] = TR16(sb2 + (16 * (sp_)) * RT_VS); ks[b_][1] = TR16(sb2 + (16 * (sp_) + 4) * RT_VS); \
                _Pragma("unroll") for (int t = 0; t < 4; ++t) { ks[b_][2 + 2 * t] = TR16(kb + (16 * (sp_)) * RT_VS + 64 * t); ks[b_][3 + 2 * t] = TR16(kb + (16 * (sp_) + 4) * RT_VS + 64 * t); } } while (0)
#pragma unroll
            for (int i = 0; i < 8; ++i) {
                if (i + 2 < 8) RT_QD_RD(i + 2, (i + 2) % 3); else if (i == 6) RT_SU_RD(0, 0);
                __builtin_amdgcn_sched_barrier(0);
                const bf16x8 sb = pack_acc8(S[i >> 1], i & 1);
                o0 = MFMA32(__builtin_shufflevector(qd[i % 3][0], qd[i % 3][1], 0, 1, 2, 3, 4, 5, 6, 7), sb, o0);
                o1 = MFMA32(__builtin_shufflevector(qd[i % 3][2], qd[i % 3][3], 0, 1, 2, 3, 4, 5, 6, 7), sb, o1);
                __builtin_amdgcn_sched_barrier(0);
            }
#undef RT_QD_RD
            {   float* op = ORET + (mrow0 + (size_t)n * 64) * 1024 + h * 256 + half * 128 + 32 * w + r;
#pragma unroll
                for (int e = 0; e < 16; ++e) { const int ir = (e & 3) + 8 * (e >> 2) + 4 * hh; op[(size_t)ir * 1024] = o0[e]; op[(size_t)(32 + ir) * 1024] = o1[e]; } }
#pragma unroll
            for (int t = 0; t < 4; ++t)
#pragma unroll
                for (int e = 0; e < 16; ++e) S[t][e] *= g64;
#pragma unroll
            for (int sp = 0; sp < 4; ++sp) {
                if (sp + 1 < 4) RT_SU_RD(sp + 1, (sp + 1) & 1);
                __builtin_amdgcn_sched_barrier(0);
                const bf16x8 bv = __builtin_shufflevector(ks[sp & 1][0], ks[sp & 1][1], 0, 1, 2, 3, 4, 5, 6, 7);
#pragma unroll
                for (int t = 0; t < 4; ++t) S[t] = MFMA32(__builtin_shufflevector(ks[sp & 1][2 + 2 * t], ks[sp & 1][3 + 2 * t], 0, 1, 2, 3, 4, 5, 6, 7), bv, S[t]);
                __builtin_amdgcn_sched_barrier(0);
            }
#undef RT_SU_RD
        }
        LDS_BARRIER();
    }
    __builtin_amdgcn_s_setprio(0);
    }
#undef RT_ISSUE
#undef RT_COMMIT_A
#undef RT_COMMIT_B
}

constexpr int LG_XA = 0, LG_XF = 64 * 272, LG_LA = LG_XF + 64 * 132 * 4, LG_SUM = LG_LA + 64 * 132 * 4;
__device__ __forceinline__ void lru_gates_mfma(Frame& F, int j) {
    const int lane = F.lane, wave = F.wave; const int r = lane & 31, hh = lane >> 5;
    const bf16* PROJ = F.BIG; bf16* HL = F.HN; bf16* PC = F.HN + (size_t)M_TOK * 1024; f32x2* LSUM = (f32x2*)(F.ws + WS_LSUM);
    LAS unsigned char* L = F.lds + RING_OFF; LAS float* XF = (LAS float*)(L + LG_XF); LAS float* LA = (LAS float*)(L + LG_LA); LAS f32x2* SUMS = (LAS f32x2*)(L + LG_SUM);
    const int g = F.bx & 7; const int it = wave & 1, ct = wave >> 1;
    const bf16* WLT = (const bf16*)(F.ws + WS_WLT) + (size_t)g * 256 * 128;
    const float* convw = F.in[16] + (size_t)j * 4 * 1024 + g * 128; const float* convb = F.in[17] + (size_t)j * 1024 + g * 128;
    bf16x8 waf[8], wxf[8];
#pragma unroll
    for (int s = 0; s < 8; ++s) { waf[s] = *(const bf16x8*)(WLT + (32 * ct + r) * 128 + 16 * s + 8 * hh); wxf[s] = *(const bf16x8*)(WLT + (128 + 32 * ct + r) * 128 + 16 * s + 8 * hh); }
    const int chl = 32 * ct + r, chg = g * 128 + chl;
    const float ba_c = F.in[19][(size_t)j * 1024 + chg], bx_c = F.in[21][(size_t)j * 1024 + chg], sp8 = 8.0f * softplusf_(-F.in[22][(size_t)j * 1024 + chg]);
    for (int tile = F.bx >> 3; tile < M_TOK / 64; tile += F.G >> 3) {
        const int m0 = tile * 64;
        int tid = F.tid; asm volatile("" : "+v"(tid));
        {   const int tok = tid >> 3, c0 = (tid & 7) * 16; const int m = m0 + tok, t = m & (SEQ - 1);
            float a[16];
#pragma unroll
            for (int i = 0; i < 4; ++i) { const f32x4 b4 = *(const f32x4*)(convb + c0 + 4 * i); a[4 * i] = b4.x; a[4 * i + 1] = b4.y; a[4 * i + 2] = b4.z; a[4 * i + 3] = b4.w; }
            v4u xq[4][2];
#pragma unroll
            for (int jj = 0; jj < 4; ++jj) { const bool ok = (t - 3 + jj) >= 0; const v4u* xp = (const v4u*)(PROJ + (size_t)(ok ? m - 3 + jj : m) * NPROJ + 4096 + g * 128 + c0); xq[jj][0] = xp[0]; xq[jj][1] = xp[1]; }
            __builtin_amdgcn_sched_barrier(0);
#pragma unroll
            for (int jj = 0; jj < 4; ++jj) { const float fz = (t - 3 + jj) >= 0 ? 1.0f : 0.0f; const v4u x0 = xq[jj][0], x1 = xq[jj][1];
                const unsigned xw[8] = {x0.x, x0.y, x0.z, x0.w, x1.x, x1.y, x1.z, x1.w};
#pragma unroll
                for (int i = 0; i < 4; ++i) { const f32x4 w4 = *(const f32x4*)(convw + jj * 1024 + c0 + 4 * i) * fz;
                    a[4 * i] += w4.x * bflo(xw[2 * i]); a[4 * i + 1] += w4.y * bfhi(xw[2 * i]); a[4 * i + 2] += w4.z * bflo(xw[2 * i + 1]); a[4 * i + 3] += w4.w * bfhi(xw[2 * i + 1]); } }
            v4u w0, w1; w0.x = pkbf(a[0], a[1]); w0.y = pkbf(a[2], a[3]); w0.z = pkbf(a[4], a[5]); w0.w = pkbf(a[6], a[7]); w1.x = pkbf(a[8], a[9]); w1.y = pkbf(a[10], a[11]); w1.z = pkbf(a[12], a[13]); w1.w = pkbf(a[14], a[15]);
            *(LAS v4u*)(L + LG_XA + tok * 272 + c0 * 2) = w0; *(LAS v4u*)(L + LG_XA + tok * 272 + c0 * 2 + 16) = w1;
#pragma unroll
            for (int i = 0; i < 4; ++i) *(LAS f32x4*)(XF + tok * 132 + c0 + 4 * i) = (f32x4){a[4 * i], a[4 * i + 1], a[4 * i + 2], a[4 * i + 3]};
        }
        LDS_BARRIER();
        {   f32x16 aa, ax;
#pragma unroll
            for (int e = 0; e < 16; ++e) { aa[e] = 0.f; ax[e] = 0.f; }
#pragma unroll
            for (int s = 0; s < 8; ++s) { const bf16x8 af = *(const LAS bf16x8*)(L + LG_XA + (32 * it + r) * 272 + (16 * s + 8 * hh) * 2); aa = MFMA32(af, waf[s], aa); ax = MFMA32(af, wxf[s], ax); }
#pragma unroll
            for (int e = 0; e < 16; ++e) { const int tok = 32 * it + (e & 3) + 8 * (e >> 2) + 4 * hh;
                const float rr = sigmoidf_(aa[e] + ba_c), ii = sigmoidf_(ax[e] + bx_c); const float la = -rr * sp8; const float x = XF[tok * 132 + chl];
                LA[tok * 132 + chl] = la; XF[tok * 132 + chl] = sqrtf(neg_expm1f_(2.0f * la)) * (ii * x); }
        }
        LDS_BARRIER();
        {
            const int ch = tid & 127, seg = tid >> 7; float hl[16], pl[16]; float hs = 0.f, pr = 1.f;
#pragma unroll
            for (int k = 0; k < 16; ++k) { const int tok = 16 * seg + k; const float a = __expf(LA[tok * 132 + ch]); hs = a * hs + XF[tok * 132 + ch]; pr *= a; hl[k] = hs; pl[k] = pr; }
            SUMS[seg * 128 + ch] = (f32x2){pr, hs};
            LDS_BARRIER();
            float carry = 0.f, pp = 1.f;
            for (int s2 = 0; s2 < seg; ++s2) { const f32x2 sv = SUMS[s2 * 128 + ch]; carry = sv.x * carry + sv.y; pp *= sv.x; }
            bf16* hp = HL + (size_t)(m0 + 16 * seg) * 1024 + g * 128 + ch; bf16* pq = PC + (size_t)(m0 + 16 * seg) * 1024 + g * 128 + ch;
#pragma unroll
            for (int k = 0; k < 16; ++k) { hp[(size_t)k * 1024] = (bf16)f2bf(hl[k] + pl[k] * carry); pq[(size_t)k * 1024] = (bf16)f2bf(pl[k] * pp); }
            if (seg == 3) LSUM[(size_t)tile * 1024 + g * 128 + ch] = (f32x2){pl[15] * pp, hl[15] + pl[15] * carry};
        }
        LDS_BARRIER();
    }
}

constexpr int DP_KH = 0, DP_QH = 64 * 272, DP_KB = 2 * 64 * 272, DP_VB = DP_KB + 64 * 320, DP_MT = DP_VB + 64 * 320, DP_TL = DP_MT + 64 * 272, DP_SC = DP_TL + 64 * 144, DP_CW = DP_SC + 1024;
static_assert(DP_CW + 4 * 3072 * 4 <= LDSCTL_OFF, "DeltaNet prep LDS map");
__device__ __forceinline__ void dn_chunk_prep(Frame& F, int j, int n_lo, int n_hi, int wg0) {
    const int wave = F.wave;
    const bf16* PROJ = F.BIG;
    bf16* NWg = F.BIG + (size_t)M_TOK * NPROJ; bf16* QDg = NWg + (size_t)M_TOK * 1024; bf16* KDg = F.PPB; bf16* Ug = F.PPB + (size_t)M_TOK * 1024;
    bf16* QKg = (bf16*)(F.ws + WS_DQK); float* GTg = (float*)(F.ws + WS_DGT);
    const float* cw = F.in[12] + (size_t)j * 4 * 3072; const float* a_log = F.in[13] + j * 8; const float* dtb = F.in[14] + j * 8;
    LAS unsigned char* L = F.lds + RING_OFF;
    LAS float* Mt = (LAS float*)(L + DP_MT);
    LAS float* bet = (LAS float*)(L + DP_SC); LAS float* gl = bet + 64; LAS float* gcl = gl + 64;
    LAS float* cwl = (LAS float*)(L + DP_CW);
    {   f32x4 wq[6];
#pragma unroll
        for (int u = 0; u < 6; ++u) wq[u] = *(const f32x4*)(cw + 4 * (F.tid + 512 * u));
#pragma unroll
        for (int u = 0; u < 6; ++u) *(LAS f32x4*)(cwl + 4 * (F.tid + 512 * u)) = wq[u]; }
    v4u rg[7];
#define DP_RAWLOAD(idx_, tidp_) do { const int bh_ = (idx_) & 31, n_ = n_lo + ((idx_) >> 5); const size_t m0_ = (size_t)(bh_ >> 3) * SEQ + (size_t)n_ * 64; const int h_ = bh_ & 7; \
        _Pragma("unroll") for (int u = 0; u < 7; ++u) { const int id = (tidp_) + 512 * u; const int row = id / 48, ch = id - row * 48; rg[u] = (v4u){0u, 0u, 0u, 0u}; \
            if (id < 67 * 48 && (n_ > 0 || row >= 3)) rg[u] = *(const v4u*)(PROJ + (m0_ + row - 3) * NPROJ + (ch >> 4) * 1024 + h_ * 128 + (ch & 15) * 8); } } while (0)
    if (F.bx - wg0 < 32 * (n_hi - n_lo)) { int tp = F.tid; asm volatile("" : "+v"(tp)); DP_RAWLOAD(F.bx - wg0, tp); }
    for (int idx = F.bx - wg0; idx < 32 * (n_hi - n_lo); idx += F.G - wg0) {
        const int bh = idx & 31, n = n_lo + (idx >> 5); const int chunk = bh * 128 + n; const int b = bh >> 3, h = bh & 7;
        int tid = F.tid; asm volatile("" : "+v"(tid));
        const int lane = tid & 63; const int r = lane & 31, hh = lane >> 5, q4 = (lane & 15) >> 2, p4 = lane & 3, cb = (lane >> 4) & 1;
        const size_t m0 = (size_t)b * SEQ + (size_t)n * 64;
        const int tok = tid >> 3, c0 = (tid & 7) * 16; const size_t m = m0 + tok; const int t = (int)(m & (SEQ - 1));
        float qv[16], kv[16], vv[16];
        LDS_BARRIER();
        {   LAS unsigned char* raw = L + DP_KB;
#pragma unroll
            for (int u = 0; u < 7; ++u) { const int id = tid + 512 * u; const int row = id / 48, ch = id - row * 48; if (id < 67 * 48) *(LAS v4u*)(raw + row * 784 + ch * 16) = rg[u]; }
            LDS_BARRIER();
#pragma unroll
            for (int ten = 0; ten < 3; ++ten) {
                float a[16];
#pragma unroll
                for (int i = 0; i < 16; ++i) a[i] = 0.f;
                const int col = ten * 1024 + h * 128 + c0;
#pragma unroll 1
                for (int jj = 0; jj < 4; ++jj) { const LAS v4u* xp = (const LAS v4u*)(raw + (tok + jj) * 784 + ten * 256 + c0 * 2); const v4u x0 = xp[0], x1 = xp[1];
                    const unsigned xw[8] = {x0.x, x0.y, x0.z, x0.w, x1.x, x1.y, x1.z, x1.w};
#pragma unroll
                    for (int i = 0; i < 4; ++i) { const f32x4 w4 = *(const LAS f32x4*)(cwl + jj * 3072 + col + 4 * i);
                        a[4 * i] += w4.x * bflo(xw[2 * i]); a[4 * i + 1] += w4.y * bfhi(xw[2 * i]); a[4 * i + 2] += w4.z * bflo(xw[2 * i + 1]); a[4 * i + 3] += w4.w * bfhi(xw[2 * i + 1]); } }
#pragma unroll
                for (int i = 0; i < 16; ++i) { const float s = siluf_(a[i]); if (ten == 0) qv[i] = s; else if (ten == 1) kv[i] = s; else vv[i] = s; }
            }
        }
        {   float sq = 0.f, sk = 0.f;
#pragma unroll
            for (int i = 0; i < 16; ++i) { sq += qv[i] * qv[i]; sk += kv[i] * kv[i]; }
            sq += __shfl_xor(sq, 1); sq += __shfl_xor(sq, 2); sq += __shfl_xor(sq, 4);
            sk += __shfl_xor(sk, 1); sk += __shfl_xor(sk, 2); sk += __shfl_xor(sk, 4);
            const float fq = SC128 / sqrtf(sq + 1e-6f), fk = 1.0f / sqrtf(sk + 1e-6f);
#pragma unroll
            for (int i = 0; i < 16; ++i) { qv[i] *= fq; kv[i] *= fk; } }
        LDS_BARRIER();
        if ((tid & 7) == 0) { const float braw = F.GB[m * 16 + h], araw = F.GB[m * 16 + 8 + h];
            bet[tok] = sigmoidf_(braw); gl[tok] = -expf(a_log[h]) * softplusf_(araw + dtb[h]); }
        {
            v4u w0, w1;
            w0.x = pkbf(kv[0], kv[1]); w0.y = pkbf(kv[2], kv[3]); w0.z = pkbf(kv[4], kv[5]); w0.w = pkbf(kv[6], kv[7]); w1.x = pkbf(kv[8], kv[9]); w1.y = pkbf(kv[10], kv[11]); w1.z = pkbf(kv[12], kv[13]); w1.w = pkbf(kv[14], kv[15]);
            *(LAS v4u*)(L + DP_KH + tok * 272 + c0 * 2) = w0; *(LAS v4u*)(L + DP_KH + tok * 272 + c0 * 2 + 16) = w1;
            w0.x = pkbf(qv[0], qv[1]); w0.y = pkbf(qv[2], qv[3]); w0.z = pkbf(qv[4], qv[5]); w0.w = pkbf(qv[6], qv[7]); w1.x = pkbf(qv[8], qv[9]); w1.y = pkbf(qv[10], qv[11]); w1.z = pkbf(qv[12], qv[13]); w1.w = pkbf(qv[14], qv[15]);
            *(LAS v4u*)(L + DP_QH + tok * 272 + c0 * 2) = w0; *(LAS v4u*)(L + DP_QH + tok * 272 + c0 * 2 + 16) = w1; }
        LDS_BARRIER();
        if (wave == 0) { float v = gl[lane];
#pragma unroll
            for (int o = 1; o < 64; o <<= 1) { const float u = __shfl_up(v, o); if (lane >= o) v += u; }
            gcl[lane] = v; }
        LDS_BARRIER();
        {
            const float gct = gcl[tok], gclast = gcl[63], bt = bet[tok]; const float eg = __expf(gct), egl = __expf(gclast - gct), kbs = bt * eg;
            v4u w0, w1;
#define DP_PACK16(arr, sc) do { w0.x = pkbf(arr[0] * (sc), arr[1] * (sc)); w0.y = pkbf(arr[2] * (sc), arr[3] * (sc)); w0.z = pkbf(arr[4] * (sc), arr[5] * (sc)); w0.w = pkbf(arr[6] * (sc), arr[7] * (sc)); \
            w1.x = pkbf(arr[8] * (sc), arr[9] * (sc)); w1.y = pkbf(arr[10] * (sc), arr[11] * (sc)); w1.z = pkbf(arr[12] * (sc), arr[13] * (sc)); w1.w = pkbf(arr[14] * (sc), arr[15] * (sc)); } while (0)
            DP_PACK16(qv, eg); { v4u* gp = (v4u*)(QDg + m * 1024 + h * 128 + c0); gp[0] = w0; gp[1] = w1; }
            DP_PACK16(kv, egl); { v4u* gp = (v4u*)(KDg + m * 1024 + h * 128 + c0); gp[0] = w0; gp[1] = w1; }
            DP_PACK16(kv, kbs); *(LAS v4u*)(L + DP_KB + tok * 320 + c0 * 2) = w0; *(LAS v4u*)(L + DP_KB + tok * 320 + c0 * 2 + 16) = w1;
            DP_PACK16(vv, bt); *(LAS v4u*)(L + DP_VB + tok * 320 + c0 * 2) = w0; *(LAS v4u*)(L + DP_VB + tok * 320 + c0 * 2 + 16) = w1;
#undef DP_PACK16
            if (tid == 0) GTg[chunk] = __expf(gclast);
        }
        if (wave < 3) { const int it = wave == 0 ? 0 : 1, jt = wave == 2 ? 1 : 0;
            f32x16 acc;
#pragma unroll
            for (int e = 0; e < 16; ++e) acc[e] = 0.f;
#pragma unroll
            for (int s = 0; s < 8; ++s) { const bf16x8 a = *(const LAS bf16x8*)(L + DP_KH + (32 * it + r) * 272 + (16 * s + 8 * hh) * 2), bb = *(const LAS bf16x8*)(L + DP_KH + (32 * jt + r) * 272 + (16 * s + 8 * hh) * 2);
                acc = MFMA32(a, bb, acc); }
            const int jg = 32 * jt + r; const float gcj = gcl[jg];
#pragma unroll
            for (int g4 = 0; g4 < 4; ++g4) { f32x4 o;
#pragma unroll
                for (int e = 0; e < 4; ++e) { const int ig = 32 * it + 8 * g4 + 4 * hh + e; o[e] = ig > jg ? bet[ig] * acc[4 * g4 + e] * __expf(gcl[ig] - gcj) : 0.f; }
                *(LAS f32x4*)(Mt + jg * 68 + 32 * it + 8 * g4 + 4 * hh) = o; }
        } else if (wave == 3) {
#pragma unroll
            for (int g4 = 0; g4 < 4; ++g4) *(LAS f32x4*)(Mt + (32 + r) * 68 + 8 * g4 + 4 * hh) = (f32x4){0.f, 0.f, 0.f, 0.f};
        } else if (wave < 7) { const int jt = wave == 6 ? 1 : 0, it = wave == 4 ? 0 : 1;
            f32x16 acc;
#pragma unroll
            for (int e = 0; e < 16; ++e) acc[e] = 0.f;
#pragma unroll
            for (int s = 0; s < 8; ++s) { const bf16x8 a = *(const LAS bf16x8*)(L + DP_KH + (32 * jt + r) * 272 + (16 * s + 8 * hh) * 2), bb = *(const LAS bf16x8*)(L + DP_QH + (32 * it + r) * 272 + (16 * s + 8 * hh) * 2);
                acc = MFMA32(a, bb, acc); }
            const int ig = 32 * it + r; const float gci = gcl[ig];
#pragma unroll
            for (int g4 = 0; g4 < 4; ++g4) { float o[4];
#pragma unroll
                for (int e = 0; e < 4; ++e) { const int jg = 32 * jt + 8 * g4 + 4 * hh + e; o[e] = ig >= jg ? acc[4 * g4 + e] * __expf(gci - gcl[jg]) : 0.f; }
                v2u w; w.x = pkbf(o[0], o[1]); w.y = pkbf(o[2], o[3]);
                *(v2u*)(QKg + (size_t)chunk * 4096 + ig * 64 + 32 * jt + 8 * g4 + 4 * hh) = w; }
        }
        LDS_BARRIER();
        { const int nidx = idx + F.G - wg0; if (nidx < 32 * (n_hi - n_lo)) DP_RAWLOAD(nidx, tid); }
        if (wave == 0) {
            int ln = lane; asm volatile("" : "+v"(ln));
            const LAS float* MtO; { unsigned mo = (unsigned)(size_t)Mt; asm volatile("" : "+v"(mo)); MtO = (const LAS float*)(size_t)mo; }
            float tr[64];
#pragma unroll
            for (int k = 0; k < 64; ++k) tr[k] = (k == ln) ? 1.f : 0.f;
#pragma unroll
            for (int jc = 62; jc >= 0; --jc) {
                float s0 = 0.f, s1 = 0.f, s2 = 0.f, s3 = 0.f;
#pragma unroll
                for (int k4 = ((jc + 1) & ~3); k4 < 64; k4 += 4) { const f32x4 mv = *(const LAS f32x4*)(MtO + jc * 68 + k4);
                    s0 += tr[k4] * mv.x; s1 += tr[k4 + 1] * mv.y; s2 += tr[k4 + 2] * mv.z; s3 += tr[k4 + 3] * mv.w; }
                tr[jc] -= (s0 + s1) + (s2 + s3);
                asm volatile("" : "+v"(tr[jc]));
            }
#pragma unroll
            for (int k8 = 0; k8 < 8; ++k8) { v4u w; w.x = pkbf(tr[8 * k8], tr[8 * k8 + 1]); w.y = pkbf(tr[8 * k8 + 2], tr[8 * k8 + 3]); w.z = pkbf(tr[8 * k8 + 4], tr[8 * k8 + 5]); w.w = pkbf(tr[8 * k8 + 6], tr[8 * k8 + 7]);
                *(LAS v4u*)(L + DP_TL + ln * 144 + k8 * 16) = w; }
        }
        LDS_BARRIER();
#pragma unroll
        for (int jb = 0; jb < 2; ++jb) { const int job = 2 * wave + jb; const int mat = job >> 3, ft = (job >> 1) & 3, it = job & 1;
            f32x16 acc;
#pragma unroll
            for (int e = 0; e < 16; ++e) acc[e] = 0.f;
            const LAS unsigned char* rb = L + (mat ? DP_VB : DP_KB) + (8 * hh + q4) * 320 + (32 * ft + 16 * cb + 4 * p4) * 2;
#pragma unroll
            for (int s = 0; s < 4; ++s) { const s16x4 al = TR16(rb + (16 * s) * 320), ah = TR16(rb + (16 * s + 4) * 320);
                const bf16x8 tb = *(const LAS bf16x8*)(L + DP_TL + (32 * it + r) * 144 + (16 * s + 8 * hh) * 2);
                acc = MFMA32(__builtin_shufflevector(al, ah, 0, 1, 2, 3, 4, 5, 6, 7), tb, acc); }
            const float sg = mat ? 1.f : -1.f; bf16* dst = (mat ? Ug : NWg) + (m0 + 32 * it + r) * 1024 + h * 128 + 32 * ft + 4 * hh;
#pragma unroll
            for (int g4 = 0; g4 < 4; ++g4) { v2u w; w.x = pkbf(sg * acc[4 * g4], sg * acc[4 * g4 + 1]); w.y = pkbf(sg * acc[4 * g4 + 2], sg * acc[4 * g4 + 3]); *(v2u*)(dst + 8 * g4) = w; }
        }
    }
}
#undef DP_RAWLOAD

constexpr int DR_S8 = 264, DR_ST = 320, DR_SQ = 136;
constexpr int DR_NW = 0, DR_QD = 64 * DR_S8, DR_KD = 2 * 64 * DR_S8, DR_QK = DR_KD + 64 * DR_ST, DR_U = DR_QK + 64 * DR_SQ;
constexpr int DN_C1 = 40, DN_C2 = 84;
__device__ __forceinline__ void dn_chunk_recur(Frame& F, int wg, int n_lo, int n_hi) {
    const int tid = F.tid, lane = F.lane, wave = F.wave; const int b = wg >> 3, h = wg & 7;
    const bf16* NWg = F.BIG + (size_t)M_TOK * NPROJ; const bf16* QDg = NWg + (size_t)M_TOK * 1024; const bf16* KDg = F.PPB; const bf16* Ug = F.PPB + (size_t)M_TOK * 1024;
    const bf16* QKg = (const bf16*)(F.ws + WS_DQK) + (size_t)wg * 128 * 4096; const float* GTg = (const float*)(F.ws + WS_DGT) + wg * 128;
    LAS unsigned char* L = F.lds + RING_OFF;
    const int r = lane & 31, hh = lane >> 5, q4 = (lane & 15) >> 2, p4 = lane & 3, cb = (lane >> 4) & 1;
    const size_t mrow0 = (size_t)b * SEQ;
    const int srow = (tid & 255) >> 4, sch = tid & 15;
    v4u pa[2][4], pb[2][4], pc[2][4], pd[2][4], pe[2][2];
#define DR_ISSUE(SET_, n_) do { _Pragma("unroll") for (int u = 0; u < 4; ++u) { const size_t o = (mrow0 + (size_t)(n_) * 64 + srow + 16 * u) * 1024 + h * 128 + sch * 8; \
            pa[SET_][u] = *(const v4u*)(NWg + o); pb[SET_][u] = *(const v4u*)(QDg + o); pc[SET_][u] = *(const v4u*)(KDg + o); pd[SET_][u] = *(const v4u*)(Ug + o); } \
        _Pragma("unroll") for (int u = 0; u < 2; ++u) pe[SET_][u] = *(const v4u*)(QKg + (size_t)(n_) * 4096 + ((tid & 255) + 256 * u) * 8); } while (0)
#define DR_COMMIT_A(SET_) do { _Pragma("unroll") for (int u = 0; u < 4; ++u) { const int row = srow + 16 * u; \
            *(LAS v2u*)(L + DR_NW + row * DR_S8 + sch * 16) = (v2u){pa[SET_][u].x, pa[SET_][u].y}; *(LAS v2u*)(L + DR_NW + row * DR_S8 + sch * 16 + 8) = (v2u){pa[SET_][u].z, pa[SET_][u].w}; \
            *(LAS v2u*)(L + DR_QD + row * DR_S8 + sch * 16) = (v2u){pb[SET_][u].x, pb[SET_][u].y}; *(LAS v2u*)(L + DR_QD + row * DR_S8 + sch * 16 + 8) = (v2u){pb[SET_][u].z, pb[SET_][u].w}; \
            *(LAS v4u*)(L + DR_U + row * DR_ST + sch * 16) = pd[SET_][u]; } } while (0)
#define DR_COMMIT_B(SET_) do { _Pragma("unroll") for (int u = 0; u < 4; ++u) { const int row = srow + 16 * u; *(LAS v4u*)(L + DR_KD + row * DR_ST + sch * 16) = pc[SET_][u]; } \
        _Pragma("unroll") for (int u = 0; u < 2; ++u) { const int id = (tid & 255) + 256 * u; *(LAS v2u*)(L + DR_QK + (id >> 3) * DR_SQ + (id & 7) * 16) = (v2u){pe[SET_][u].x, pe[SET_][u].y}; *(LAS v2u*)(L + DR_QK + (id >> 3) * DR_SQ + (id & 7) * 16 + 8) = (v2u){pe[SET_][u].z, pe[SET_][u].w}; } } while (0)
    if (wave >= 4) {
        DR_ISSUE(0, n_lo); DR_COMMIT_A(0); DR_COMMIT_B(0); DR_ISSUE(1, n_lo + 1); if (n_lo + 2 < n_hi) DR_ISSUE(0, n_lo + 2);
        LDS_BARRIER();
        for (int n = n_lo; n < n_hi; n += 2) {
            LDS_BARRIER(); DR_COMMIT_A(1);
            LDS_BARRIER(); DR_COMMIT_B(1); if (n + 3 < n_hi) DR_ISSUE(1, n + 3);
            LDS_BARRIER(); if (n + 2 < n_hi) DR_COMMIT_A(0);
            LDS_BARRIER(); if (n + 2 < n_hi) { DR_COMMIT_B(0); if (n + 4 < n_hi) DR_ISSUE(0, n + 4); }
        }
    } else {
        __builtin_amdgcn_s_setprio(3);
        const int w = wave;
        f32x16 S[4];
        float* ssave = (float*)(F.ws + WS_LSUM) + (size_t)1024 * 1024 + ((size_t)(wg * 4 + w) * 64) * 64 + lane;
#pragma unroll
        for (int t = 0; t < 4; ++t)
#pragma unroll
            for (int e = 0; e < 16; ++e) S[t][e] = n_lo > 0 ? ssave[(t * 16 + e) * 64] : 0.f;
        const float gtl = GTg[lane], gth = GTg[64 + lane];
        LDS_BARRIER();
        for (int n = n_lo; n < n_hi; ++n) {
            const float gt = __int_as_float(__builtin_amdgcn_readlane(__float_as_int(n < 64 ? gtl : gth), n & 63));
#define DR_AFR(dst_, base_) do { const LAS unsigned char* p_ = (base_); const s16x4 l0_ = *(const LAS s16x4*)(p_), h0_ = *(const LAS s16x4*)(p_ + 16), l1_ = *(const LAS s16x4*)(p_ + 32 * DR_S8), h1_ = *(const LAS s16x4*)(p_ + 32 * DR_S8 + 16); \
                dst_[0] = __builtin_shufflevector(l0_, h0_, 0, 1, 2, 3, 4, 5, 6, 7); dst_[1] = __builtin_shufflevector(l1_, h1_, 0, 1, 2, 3, 4, 5, 6, 7); } while (0)
            const LAS unsigned char* wbase = L + DR_NW + r * DR_S8 + (4 * hh) * 2; const LAS unsigned char* qbase = L + DR_QD + r * DR_S8 + (4 * hh) * 2;
            bf16x8 fw[2][2], fq[2][2];
            DR_AFR(fw[0], wbase); DR_AFR(fq[0], qbase);
            f32x16 vn0, vn1;
            {   const LAS unsigned char* ub = L + DR_U + (4 * hh + q4) * DR_ST + (32 * w + 16 * cb + 4 * p4) * 2;
                s16x4 u0[4], u1[4];
#pragma unroll
                for (int g4 = 0; g4 < 4; ++g4) { u0[g4] = TR16(ub + (8 * g4) * DR_ST); u1[g4] = TR16(ub + (32 + 8 * g4) * DR_ST); }
#pragma unroll
                for (int g4 = 0; g4 < 4; ++g4)
#pragma unroll
                    for (int e = 0; e < 4; ++e) { vn0[4 * g4 + e] = bf2f((bf16)u0[g4][e]); vn1[4 * g4 + e] = bf2f((bf16)u1[g4][e]); } }
            f32x16 o0, o1;
#pragma unroll
            for (int e = 0; e < 16; ++e) { o0[e] = 0.f; o1[e] = 0.f; }
#pragma unroll
            for (int i = 0; i < 8; ++i) { const int t = i >> 1, s = i & 1;
                if (i + 1 < 8) { const int off = (32 * ((i + 1) >> 1) + 16 * ((i + 1) & 1)) * 2; DR_AFR(fw[(i + 1) & 1], wbase + off); DR_AFR(fq[(i + 1) & 1], qbase + off); }
                const bf16x8 sbv = pack_acc8(S[t], s);
                __builtin_amdgcn_sched_barrier(0);
                vn0 = MFMA32(fw[i & 1][0], sbv, vn0); vn1 = MFMA32(fw[i & 1][1], sbv, vn1);
                o0 = MFMA32(fq[i & 1][0], sbv, o0); o1 = MFMA32(fq[i & 1][1], sbv, o1);
                __builtin_amdgcn_sched_barrier(0);
            }
            LDS_BARRIER();
            bf16x8 qk00[2], qk10[2], qk11[2];
#pragma unroll
            for (int s = 0; s < 2; ++s) { const LAS unsigned char* ka = L + DR_QK + r * DR_SQ + (16 * s + 4 * hh) * 2;
                const s16x4 a00l = *(const LAS s16x4*)(ka), a00h = *(const LAS s16x4*)(ka + 16), a10l = *(const LAS s16x4*)(ka + 32 * DR_SQ), a10h = *(const LAS s16x4*)(ka + 32 * DR_SQ + 16), a11l = *(const LAS s16x4*)(ka + 32 * DR_SQ + 64), a11h = *(const LAS s16x4*)(ka + 32 * DR_SQ + 64 + 16);
                qk00[s] = __builtin_shufflevector(a00l, a00h, 0, 1, 2, 3, 4, 5, 6, 7); qk10[s] = __builtin_shufflevector(a10l, a10h, 0, 1, 2, 3, 4, 5, 6, 7); qk11[s] = __builtin_shufflevector(a11l, a11h, 0, 1, 2, 3, 4, 5, 6, 7); }
            const LAS unsigned char* kb = L + DR_KD + (4 * hh + q4) * DR_ST + (16 * cb + 4 * p4) * 2;
            bf16x8 fk[2][4];
#define DR_KFR(dst_, jt_, s_) do { _Pragma("unroll") for (int t_ = 0; t_ < 4; ++t_) { const s16x4 al_ = TR16(kb + (32 * (jt_) + 16 * (s_)) * DR_ST + 64 * t_), ah_ = TR16(kb + (32 * (jt_) + 16 * (s_) + 8) * DR_ST + 64 * t_); \
                dst_[t_] = __builtin_shufflevector(al_, ah_, 0, 1, 2, 3, 4, 5, 6, 7); } } while (0)
            DR_KFR(fk[0], 0, 0);
            bf16x8 vb[2][2];
#pragma unroll
            for (int s = 0; s < 2; ++s) { vb[0][s] = pack_acc8(vn0, s); vb[1][s] = pack_acc8(vn1, s); }
#pragma unroll
            for (int t = 0; t < 4; ++t)
#pragma unroll
                for (int e = 0; e < 16; ++e) S[t][e] *= gt;
            __builtin_amdgcn_sched_barrier(0);
#pragma unroll
            for (int s = 0; s < 2; ++s) { o0 = MFMA32(qk00[s], vb[0][s], o0); o1 = MFMA32(qk10[s], vb[0][s], o1); o1 = MFMA32(qk11[s], vb[1][s], o1); }
#pragma unroll
            for (int i = 0; i < 4; ++i) { const int jt = i >> 1, s = i & 1;
                if (i + 1 < 4) DR_KFR(fk[(i + 1) & 1], (i + 1) >> 1, (i + 1) & 1);
                __builtin_amdgcn_sched_barrier(0);
#pragma unroll
                for (int t = 0; t < 4; ++t) S[t] = MFMA32(fk[i & 1][t], vb[jt][s], S[t]);
                __builtin_amdgcn_sched_barrier(0);
            }
            {   bf16* op = F.MIX + (mrow0 + (size_t)n * 64) * DM + h * 128 + 32 * w + r;
#pragma unroll
                for (int e = 0; e < 16; ++e) { const int ir = (e & 3) + 8 * (e >> 2) + 4 * hh; op[(size_t)ir * DM] = (bf16)(pkbf(o0[e], 0.f) & 0xffffu); op[(size_t)(32 + ir) * DM] = (bf16)(pkbf(o1[e], 0.f) & 0xffffu); } }
#undef DR_AFR
#undef DR_KFR
            LDS_BARRIER();
        }
        if (n_hi < SEQ / 64) {
#pragma unroll
            for (int t = 0; t < 4; ++t)
#pragma unroll
                for (int e = 0; e < 16; ++e) ssave[(t * 16 + e) * 64] = S[t][e];
        }
        __builtin_amdgcn_s_setprio(0);
    }
#undef DR_ISSUE
#undef DR_COMMIT_A
#undef DR_COMMIT_B
}

constexpr int SWA_VSTRIDE = 288;
__device__ __forceinline__ void swa_mfma(Frame& F) {
    const int wave = F.wave;
    const bf16* PROJ = F.BIG;
    bf16* OB[3] = {F.PPB, F.PPB + (size_t)M_TOK * 1024, F.BIG + (size_t)M_TOK * NPROJ};
    float* LSE = (float*)(F.BIG + (size_t)M_TOK * NPROJ + (size_t)M_TOK * 1024);
    LAS unsigned char* vl = F.lds + RING_OFF;
    LAS unsigned char* kl = vl + 272 * SWA_VSTRIDE;
    v4u kreg[9], vreg[9]; bf16x8 qfn[4];
#define SW_LOAD(unit_, tid_) do { const int bh_ = (unit_) / 192, rem_ = (unit_) - bh_ * 192; const int br_ = rem_ >> 6, blk_ = rem_ & 63; const int b_ = bh_ >> 3, h_ = bh_ & 7; const int dsh_ = 2 * br_, d_ = 1 << dsh_; \
        const int nper_ = 64 >> dsh_; const int r_ = blk_ / nper_, n_ = blk_ - r_ * nper_; const size_t rowbase_ = (size_t)b_ * SEQ + r_; const int sub0_ = 128 * n_ - 144; \
        _Pragma("unroll") for (int u = 0; u < 9; ++u) { const int id = (tid_) + 512 * u; const int row = id >> 4, ch = id & 15; const int ks = sub0_ + row; kreg[u] = (v4u){0u, 0u, 0u, 0u}; vreg[u] = (v4u){0u, 0u, 0u, 0u}; \
            if (id < 272 * 16 && ks >= 0) { const bf16* rp = PROJ + (rowbase_ + (size_t)ks * d_) * NPROJ + h_ * 128 + ch * 8; kreg[u] = *(const v4u*)(rp + 1024); vreg[u] = *(const v4u*)(rp + 2048); } } \
        { const int lane_ = (tid_) & 63; const size_t mq_ = rowbase_ + (size_t)(128 * n_ + 16 * wave + (lane_ & 15)) * d_; const bf16* qp = PROJ + mq_ * NPROJ + h_ * 128 + 8 * (lane_ >> 4); \
          _Pragma("unroll") for (int s = 0; s < 4; ++s) qfn[s] = *(const bf16x8*)(qp + 32 * s); } } while (0)
    if (F.bx - 32 < 32 * 192) { int tp = F.tid; asm volatile("" : "+v"(tp)); SW_LOAD(F.bx - 32, tp); }
    for (int unit = F.bx - 32; unit < 32 * 192; unit += F.G - 32) {
        int tid = F.tid; asm volatile("" : "+v"(tid));
        const int lane = tid & 63; const int li = lane & 15, g = lane >> 4;
        const int bh = unit / 192, rem = unit - bh * 192; const int br = rem >> 6, blk = rem & 63;
        const int b = bh >> 3, h = bh & 7; const int dsh = 2 * br, d = 1 << dsh; const int nper = 64 >> dsh; const int r = blk / nper, n = blk - r * nper;
        const size_t rowbase = (size_t)b * SEQ + r;
        const int sub0 = 128 * n - 144;
        LDS_BARRIER();
        {
#pragma unroll
            for (int u = 0; u < 9; ++u) { const int id = tid + 512 * u; const int row = id >> 4, ch = id & 15;
                if (id < 272 * 16) { *(LAS v4u*)(kl + row * 272 + ch * 16) = kreg[u]; *(LAS v4u*)(vl + row * SWA_VSTRIDE + ch * 16) = vreg[u]; } }
        }
        bf16x8 qf[4];
#pragma unroll
        for (int s = 0; s < 4; ++s) qf[s] = qfn[s];
        LDS_BARRIER();
        { const int nu = unit + F.G - 32; if (nu < 32 * 192) SW_LOAD(nu, tid); }
        const int q0w = 128 * n + 16 * wave;
        const size_t mq = rowbase + (size_t)(q0w + li) * d;
        f32x4 sacc[10];
        {   const LAS unsigned char* kbase = kl + (16 * wave + li) * 272 + 16 * g;
#pragma unroll
            for (int kt = 0; kt < 10; ++kt) { f32x4 acc = (f32x4){0.f, 0.f, 0.f, 0.f};
#pragma unroll
                for (int s = 0; s < 4; ++s) { const bf16x8 kf = *(const LAS bf16x8*)(kbase + (16 * kt) * 272 + 64 * s); acc = __builtin_amdgcn_mfma_f32_16x16x32_bf16(kf, qf[s], acc, 0, 0, 0); }
                sacc[kt] = acc; }
        }
        const float slope_d = exp2f(-(float)(h + 1)) * (float)d;
        float mx = -INFINITY;
#pragma unroll
        for (int kt = 0; kt < 10; ++kt)
#pragma unroll
            for (int e = 0; e < 4; ++e) { const int rel = 144 + li - 16 * kt - 4 * g - e; const bool valid = (rel >= 0) && (rel <= 128) && (q0w + li - rel >= 0);
                const float sv = valid ? sacc[kt][e] * SC128 - slope_d * (float)rel : -INFINITY; sacc[kt][e] = sv; mx = fmaxf(mx, sv); }
        mx = fmaxf(mx, __shfl_xor(mx, 16)); mx = fmaxf(mx, __shfl_xor(mx, 32));
        float l = 0.f;
#pragma unroll
        for (int kt = 0; kt < 10; ++kt)
#pragma unroll
            for (int e = 0; e < 4; ++e) { const float p = __expf(sacc[kt][e] - mx); sacc[kt][e] = p; l += p; }
        l += __shfl_xor(l, 16); l += __shfl_xor(l, 32);
        f32x4 oacc[8];
#pragma unroll
        for (int dt = 0; dt < 8; ++dt) oacc[dt] = (f32x4){0.f, 0.f, 0.f, 0.f};
        const LAS unsigned char* vbase = vl + (16 * wave + 4 * g + (li >> 2)) * SWA_VSTRIDE + (li & 3) * 8;
#pragma unroll
        for (int sp = 0; sp < 5; ++sp) {
            v4u pw; pw.x = pk2(sacc[2 * sp][0], sacc[2 * sp][1]); pw.y = pk2(sacc[2 * sp][2], sacc[2 * sp][3]); pw.z = pk2(sacc[2 * sp + 1][0], sacc[2 * sp + 1][1]); pw.w = pk2(sacc[2 * sp + 1][2], sacc[2 * sp + 1][3]);
            const bf16x8 pf = __builtin_bit_cast(bf16x8, pw);
#pragma unroll
            for (int dt = 0; dt < 8; ++dt) {
                const s16x4 lo = __builtin_amdgcn_ds_read_tr16_b64_v4i16((LAS s16x4*)(vbase + (32 * sp) * SWA_VSTRIDE + dt * 32));
                const s16x4 hi = __builtin_amdgcn_ds_read_tr16_b64_v4i16((LAS s16x4*)(vbase + (32 * sp + 16) * SWA_VSTRIDE + dt * 32));
                const bf16x8 af = __builtin_shufflevector(lo, hi, 0, 1, 2, 3, 4, 5, 6, 7);
                oacc[dt] = __builtin_amdgcn_mfma_f32_16x16x32_bf16(af, pf, oacc[dt], 0, 0, 0);
            }
        }
        const float il = 1.0f / l;
        bf16* op = OB[br] + mq * 1024 + h * 128 + 4 * g;
#pragma unroll
        for (int dt = 0; dt < 8; ++dt) { v2u w; w.x = pk2(oacc[dt][0] * il, oacc[dt][1] * il); w.y = pk2(oacc[dt][2] * il, oacc[dt][3] * il); *(v2u*)(op + 16 * dt) = w; }
        if (g == 0) LSE[((size_t)br * M_TOK + mq) * 8 + h] = mx + __logf(l);
    }
}
#undef SW_LOAD

__device__ __forceinline__ void swa_merge(Frame& F) {
    const int gw = F.bx * NWAVES + F.wave, NGW = F.G * NWAVES, lane = F.lane; const int h = lane >> 3, c0 = (lane & 7) * 16;
    const bf16* OB0 = F.PPB; const bf16* OB1 = F.PPB + (size_t)M_TOK * 1024; const bf16* OB2 = F.BIG + (size_t)M_TOK * NPROJ;
    const float* LSE = (const float*)(F.BIG + (size_t)M_TOK * NPROJ + (size_t)M_TOK * 1024);
    for (int m = gw; m < M_TOK; m += NGW) {
        const size_t o = (size_t)m * 1024 + h * 128 + c0;
        const v4u a0 = *(const v4u*)(OB0 + o), a1 = *(const v4u*)(OB0 + o + 8), b0 = *(const v4u*)(OB1 + o), b1 = *(const v4u*)(OB1 + o + 8), c0v = *(const v4u*)(OB2 + o), c1v = *(const v4u*)(OB2 + o + 8);
        const float l0 = LSE[((size_t)0 * M_TOK + m) * 8 + h], l1 = LSE[((size_t)1 * M_TOK + m) * 8 + h], l2 = LSE[((size_t)2 * M_TOK + m) * 8 + h]; __builtin_amdgcn_sched_barrier(0);
        const float mx = fmaxf(l0, fmaxf(l1, l2)); float e0 = __expf(l0 - mx), e1 = __expf(l1 - mx), e2 = __expf(l2 - mx); const float inv = 1.0f / (e0 + e1 + e2); e0 *= inv; e1 *= inv; e2 *= inv;
        float x[16], y[16], z[16]; unpack8(a0, x); unpack8(a1, x + 8); unpack8(b0, y); unpack8(b1, y + 8); unpack8(c0v, z); unpack8(c1v, z + 8);
#pragma unroll
        for (int i = 0; i < 16; ++i) x[i] = e0 * x[i] + e1 * y[i] + e2 * z[i];
        v4u* dst = (v4u*)(F.MIX + (size_t)m * DM + h * 128 + c0); dst[0] = pack8(x); dst[1] = pack8(x + 8);
    }
}

__device__ __forceinline__ void ret_final(Frame& F) {
    const int gw = F.bx * NWAVES + F.wave, NGW = F.G * NWAVES, lane = F.lane; const int h = lane >> 4, c0 = (lane & 15) * 16;
    const float* ORET = (const float*)F.HN; const bf16* PROJ = F.BIG;
    for (int m = gw; m < M_TOK; m += NGW) {
        const f32x4* xp = (const f32x4*)(ORET + (size_t)m * 1024 + h * 256 + c0); const v4u* gp = (const v4u*)(PROJ + (size_t)m * NPROJ + 5120 + h * 256 + c0);
        const f32x4 x0 = xp[0], x1 = xp[1], x2 = xp[2], x3 = xp[3]; const v4u g0 = gp[0], g1 = gp[1]; __builtin_amdgcn_sched_barrier(0);
        float x[16] = {x0.x, x0.y, x0.z, x0.w, x1.x, x1.y, x1.z, x1.w, x2.x, x2.y, x2.z, x2.w, x3.x, x3.y, x3.z, x3.w}; float g[16]; unpack8(g0, g); unpack8(g1, g + 8);
        float s = 0.f;
#pragma unroll
        for (int i = 0; i < 16; ++i) s += x[i];
        const float mu = row16_sum(s) * (1.0f / 256.0f); float q = 0.f;
#pragma unroll
        for (int i = 0; i < 16; ++i) { x[i] -= mu; q += x[i] * x[i]; }
        const float r = 1.0f / sqrtf(row16_sum(q) * (1.0f / 256.0f) + GN_EPS);
#pragma unroll
        for (int i = 0; i < 16; ++i) x[i] = x[i] * r * siluf_(g[i]);
        v4u* dst = (v4u*)(F.MIX + (size_t)m * DM + 1024 + h * 256 + c0); dst[0] = pack8(x); dst[1] = pack8(x + 8);
    }
}
__device__ __forceinline__ void final_norm(Frame& F) {
    const int gw = F.bx * NWAVES + F.wave, NGW = F.G * NWAVES, lane = F.lane; const float* lnw = F.in[9];
    float* tmp = (float*)F.HN;
    f32x4 lw[8];
#pragma unroll
    for (int j = 0; j < 8; ++j) lw[j] = ((const f32x4*)lnw)[lane + 64 * j];
    for (int rp = gw; rp < M_TOK / 2; rp += NGW) {
        v2u w_[2][8];
#pragma unroll
        for (int r = 0; r < 2; ++r)
#pragma unroll
            for (int j = 0; j < 8; ++j) w_[r][j] = ((const v2u*)(F.H16 + ((size_t)2 * rp + r) * DM))[lane + 64 * j];
        __builtin_amdgcn_sched_barrier(0);
#pragma unroll
        for (int r = 0; r < 2; ++r) { const int row = 2 * rp + r; f32x4 v[8]; float ss = 0.f;
#pragma unroll
            for (int j = 0; j < 8; ++j) { v[j] = (f32x4){bflo(w_[r][j].x), bfhi(w_[r][j].x), bflo(w_[r][j].y), bfhi(w_[r][j].y)}; ss += (v[j].x * v[j].x + v[j].y * v[j].y) + (v[j].z * v[j].z + v[j].w * v[j].w); }
            ss = wave_sum(ss); const float rstd = 1.0f / sqrtf(ss * (1.0f / DM) + RMS_EPS);
            f32x4* o = (f32x4*)(F.out + (size_t)row * DM) + lane; (void)tmp;
#pragma unroll
            for (int j = 0; j < 8; ++j) o[64 * j] = v[j] * rstd * lw[j]; }
    }
}
__device__ __forceinline__ void final_copy(Frame& F) {
    const f32x4* src = (const f32x4*)F.HN; f32x4* dst = (f32x4*)(F.out + (size_t)(M_TOK / 2) * DM);
    const size_t n4 = (size_t)(M_TOK / 2) * DM / 4, stride = (size_t)F.G * 512;
    for (size_t i = (size_t)F.bx * 512 + F.tid; i < n4; i += 8 * stride) { f32x4 t_[8];
#pragma unroll
        for (int u = 0; u < 8; ++u) t_[u] = src[i + u * stride];
        __builtin_amdgcn_sched_barrier(0);
#pragma unroll
        for (int u = 0; u < 8; ++u) dst[i + u * stride] = t_[u]; }
}

#ifndef REP_T1
#define REP_T1 1
#endif
#ifndef REP_G1
#define REP_G1 1
#endif
#ifndef REP_EM1
#define REP_EM1 1
#endif
#ifndef REP_EM2
#define REP_EM2 1
#endif
#ifndef REP_OM1
#define REP_OM1 1
#endif
#ifndef REP_T2
#define REP_T2 1
#endif
#ifndef REP_G3
#define REP_G3 1
#endif
#ifndef REP_PP
#define REP_PP 1
#endif
#define REPEAT(n_) _Pragma("unroll 1") for (int rep_ = 0; rep_ < (n_); ++rep_)
#define REFRESH_F() do { int t_ = threadIdx.x; asm volatile("" : "+v"(t_)); F.tid = t_; F.lane = t_ & 63; F.wave = __builtin_amdgcn_readfirstlane(t_ >> 6); int b_ = blockIdx.x; asm volatile("" : "+s"(b_)); F.bx = b_; } while (0)
constexpr int PH_PER_LAYER = 11, NPH = DEPTH * PH_PER_LAYER + 2;
__global__ void __launch_bounds__(NWAVES * 64, 2) trunk_fwd(Args args) {
    extern __shared__ __attribute__((aligned(16))) unsigned char lds_raw[];
    Frame F;
    F.lds = (LAS unsigned char*)lds_raw;
    F.tid = threadIdx.x; F.lane = F.tid & 63; F.wave = __builtin_amdgcn_readfirstlane(F.tid >> 6);
    F.G = gridDim.x; F.bx = blockIdx.x;
    F.in = args.in; F.out = args.out;
    unsigned char* ws = args.ws; F.ws = ws; F.H16 = (bf16*)(ws + WS_PP2);
    F.PP2 = (bf16*)((unsigned char*)args.out + (size_t)M_TOK * DM * 2);
    F.WIN = (bf16*)(ws + WS_WIN); F.WOUT = (bf16*)(ws + WS_WOUT); F.WUP = (bf16*)(ws + WS_WUP); F.WDOWN = (bf16*)(ws + WS_WDOWN); F.WGATE = (bf16*)(ws + WS_WGATE); F.WPP = (bf16*)(ws + WS_WPP);
    F.PB = (bf16*)(ws + WS_PB); F.GB = (float*)(ws + WS_GB); F.HN = (bf16*)(ws + WS_HN); F.MIX = (bf16*)(ws + WS_MIX); F.BIG = (bf16*)(ws + WS_BIG); F.PPB = (bf16*)(ws + WS_PPB);
    for (int u = F.tid; u < (LDS_BYTES - LDSCTL_OFF) / 4; u += NWAVES * 64) ((LAS unsigned*)(F.lds + LDSCTL_OFF))[u] = 0u;
    __syncthreads();
    const int lo = args.ph_lo, hi = args.ph_hi;
    XcdBarrier bar; bar.bar = (unsigned*)(ws + WS_CTL) + CW_BAR; bar.x = 0; bar.st = nullptr;
    if (hi - lo > 1) bar = xcd_barrier_post((unsigned*)(ws + WS_CTL) + CW_BAR, (volatile LAS unsigned*)(F.lds + MISC_OFF) + 8);
#define IN(k) (lo <= (k) && (k) < hi)
#ifdef REP_BAR
#define SEAM(k) do { if (IN(k) && IN((k) + 1)) { xcd_barrier(bar); xcd_barrier(bar); } } while (0)
#else
#define SEAM(k) do { if (IN(k) && IN((k) + 1)) xcd_barrier(bar); } while (0)
#endif
    LAS unsigned char* ring = F.lds + RING_OFF;

    for (int layer = 0; layer < LAYER_HI; ++layer) {
        const int P = layer * PH_PER_LAYER; const int j = layer >> 1; const bool even = (layer & 1) == 0;
        { int t_ = threadIdx.x; asm volatile("" : "+v"(t_)); F.tid = t_; F.lane = t_ & 63; F.wave = __builtin_amdgcn_readfirstlane(t_ >> 6); int b_ = blockIdx.x; asm volatile("" : "+s"(b_)); F.bx = b_; }
        if (IN(P + 0)) { REPEAT(REP_T1) { phase_t1(F, layer); __syncthreads(); } } SEAM(P + 0);
        if (IN(P + 1)) REPEAT(REP_G1) { pg8::Gemm g{F.HN, even ? F.WIN : (bf16*)(F.ws + WS_WIN2), M_TOK, NPROJ, DM}; pg8::StaticOrder S; S.init(M_TOK, NPROJ, F.G, F.bx);
            pg8::EpiB16<0> E{F.BIG, NPROJ, nullptr}; pg8::gemm_phase<pg8::EpiB16<0>, pg8::StaticOrder, true, true>(ring, g, S, E); } SEAM(P + 1);
        if (IN(P + 2)) {
            if (even) {
 REPEAT(REP_EM1) { REFRESH_F(); dn_chunk_prep(F, j, 0, DN_C1, 0); __syncthreads(); lru_gates_mfma(F, j); __syncthreads(); }
 }
            else {
 REPEAT(REP_OM1) { REFRESH_F(); if (F.bx < 32) ret_chunk(F, F.bx); else { swa_mfma(F); __syncthreads(); { pg8::Gemm g{F.PB, F.WPP, M_TOK, DM, PLE}; pg8::StaticOrder S; S.init(M_TOK, DM, F.G - 32, F.bx - 32); pg8::EpiB16<0> E{F.PP2, DM, nullptr}; pg8::gemm_phase<pg8::EpiB16<0>, pg8::StaticOrder, true, true>(ring, g, S, E); } __syncthreads(); convert_w_rest(F, layer, 32); if (layer + 1 < DEPTH) convert_w_in(F, layer + 1, 32); } __syncthreads(); }
 }
        } SEAM(P + 2);
        if (IN(P + 3)) {
            if (even) {
 { int lo = 0, mid = DN_C1, hi = DN_C2;
   for (int st = 0; st < 2; ++st) { REFRESH_F(); asm volatile("" : "+s"(lo), "+s"(mid), "+s"(hi));
       if (F.bx < 32) dn_chunk_recur(F, F.bx, lo, mid); else dn_chunk_prep(F, j, mid, hi, 32);
       xcd_barrier(bar); lo = mid; mid = hi; hi = 128; } }
 REPEAT(REP_EM2) { REFRESH_F(); if (F.bx < 32) dn_chunk_recur(F, F.bx, DN_C2, 128); else { if (F.bx >= 128 && F.bx < 136) lru_carry(F, (F.bx - 128) * 512 + F.tid); __syncthreads(); { pg8::Gemm g{F.PB, F.WPP, M_TOK, DM, PLE}; pg8::StaticOrder S; S.init(M_TOK, DM, F.G - 32, F.bx - 32); pg8::EpiB16<0> E{F.PP2, DM, nullptr}; pg8::gemm_phase<pg8::EpiB16<0>, pg8::StaticOrder, true, true>(ring, g, S, E); } __syncthreads(); convert_w_rest(F, layer, 32); if (layer + 1 < DEPTH) convert_w_in(F, layer + 1, 32); } __syncthreads(); }
 }
        } if (even) SEAM(P + 3);
        if (IN(P + 4)) { if (even) { dn_final(F, j); lru_final(F); } else { ret_final(F); swa_merge(F); } } SEAM(P + 4);
        if (IN(P + 5)) {
            { pg8::Gemm g{F.MIX, F.WOUT, M_TOK, DM, DM}; pg8::StaticOrder S; S.init(M_TOK, DM, F.G, F.bx);
              pg8::EpiResid E{layer == 0 ? F.in[0] : nullptr, F.H16, F.H16, DM, (float*)(F.ws + WS_SS), nullptr}; pg8::gemm_phase<pg8::EpiResid, pg8::StaticOrder, true, true>(ring, g, S, E); }
#ifdef REP_G2
            { pg8::Gemm g{F.MIX, F.WOUT, M_TOK, DM, DM}; pg8::StaticOrder S; S.init(M_TOK, DM, F.G, F.bx); pg8::EpiResid E{F.in[0], nullptr, F.BIG, DM, nullptr, nullptr}; pg8::gemm_phase<pg8::EpiResid, pg8::StaticOrder, true, true>(ring, g, S, E); }
#endif
        } SEAM(P + 5);
        if (IN(P + 7)) REPEAT(REP_G3) { pg8::Gemm g{F.H16, F.WUP, M_TOK, DFF, DM}; pg8::StaticOrder S; S.init(M_TOK, DFF, F.G, F.bx);
            pg8::EpiB16<1> E{F.BIG, DFF, nullptr}; pg8::gemm_phase<pg8::EpiB16<1>, pg8::StaticOrder, true, true>(ring, g, S, E); } SEAM(P + 7);
        if (IN(P + 8)) { pg8::Gemm g{F.BIG, F.WDOWN, M_TOK, DM, DFF}; pg8::StaticOrder S; S.init(M_TOK, DM, F.G, F.bx);
            pg8::EpiResid E{nullptr, F.H16, F.HN, DM, (float*)(F.ws + WS_SS) + (size_t)M_TOK * 32, (const float*)(F.ws + WS_SS)}; pg8::gemm_phase<pg8::EpiResid, pg8::StaticOrder, true, true>(ring, g, S, E);
#ifdef REP_G4
            { pg8::EpiResid E2{F.in[0], nullptr, F.MIX, DM, nullptr, nullptr}; pg8::gemm_phase<pg8::EpiResid, pg8::StaticOrder, true, true>(ring, g, S, E2); }
#endif
            } SEAM(P + 8);
        if (IN(P + 10)) { pg8::Gemm g{F.HN, F.WGATE, M_TOK, DM, DM}; pg8::StaticOrder S; S.init(M_TOK, DM, F.G, F.bx);
            pg8::EpiGate E{F.HN, F.H16, F.PP2, DM, (const float*)(F.ws + WS_SS) + (size_t)M_TOK * 32}; pg8::gemm_phase<pg8::EpiGate, pg8::StaticOrder, true, true>(ring, g, S, E);
#ifdef REP_G5
            { pg8::EpiGate E2{F.HN, F.MIX, F.PP2, DM, nullptr}; pg8::gemm_phase<pg8::EpiGate, pg8::StaticOrder, true, true>(ring, g, S, E2); }
#endif
            } SEAM(P + 10);
    }
    if (IN(NPH - 2)) final_norm(F);
    SEAM(NPH - 2);
#undef IN
#undef SEAM
}

extern "C" void kernel_launch(void* const* d_in, const int* in_sizes, int n_in, void* d_out, int out_size, void* d_ws, size_t ws_size, hipStream_t stream) {
    static int grid = 0;
    if (grid == 0) {
        if (n_in != 25 || in_sizes[0] != M_TOK * DM || out_size != M_TOK * DM || ws_size < WS_END) {
            fprintf(stderr, "kernel_launch: unexpected shapes (n_in %d, in0 %d, out %d, ws %zu, need %zu); nothing launched\n", n_in, n_in > 0 ? in_sizes[0] : -1, out_size, ws_size, (size_t)WS_END); grid = -1; return; }
        int dev = 0, cus = 0;
        if (hipGetDevice(&dev) != hipSuccess || hipDeviceGetAttribute(&cus, hipDeviceAttributeMultiprocessorCount, dev) != hipSuccess) { grid = -1; return; }
        if (hipFuncSetAttribute((const void*)trunk_fwd, hipFuncAttributeMaxDynamicSharedMemorySize, LDS_BYTES) != hipSuccess) { fprintf(stderr, "kernel_launch: hipFuncSetAttribute failed\n"); grid = -1; return; }
        int per_cu = 0;
        if (hipOccupancyMaxActiveBlocksPerMultiprocessor(&per_cu, (const void*)trunk_fwd, NWAVES * 64, LDS_BYTES) != hipSuccess || per_cu < 1) { fprintf(stderr, "kernel_launch: occupancy query says %d blocks per CU\n", per_cu); }
        (void)hipGetLastError();
        grid = cus;
    }
    if (grid < 0) return;
    if (hipMemsetAsync((char*)d_ws + WS_CTL, 0, 65536, stream) != hipSuccess) return;
    Args a{};
    for (int i = 0; i < 25; ++i) a.in[i] = (const float*)d_in[i];
    a.out = (float*)d_out; a.ws = (unsigned char*)d_ws;
#if ONE_LAUNCH
    a.ph_lo = 0; a.ph_hi = NPH;
    hipLaunchKernelGGL(trunk_fwd, dim3(grid), dim3(NWAVES * 64), LDS_BYTES, stream, a);
#else
    for (int ph = 0; ph < NPH; ++ph) {
        const int pl = ph % PH_PER_LAYER, layer = ph / PH_PER_LAYER;
        if (ph < NPH - 2 && pl == 3 && (layer & 1)) continue;
        a.ph_lo = ph; a.ph_hi = ph + 1;
        hipLaunchKernelGGL(trunk_fwd, dim3(grid), dim3(NWAVES * 64), LDS_BYTES, stream, a);
    }
#endif
}
```
